# Optimizing an MI355X kernel written in HIP

```python
import jax, jax.numpy as jnp
from jax import lax
import numpy as np

D_MODEL = 1024
BATCH = 16
SEQ = 2048
DEPTH = 2

CHUNK = 64
N_PREV_CHUNKS = 8
BAND = (N_PREV_CHUNKS + 1) * CHUNK
HEAD_DIM = 64
N_HEADS_ATTN = 8
N_HEADS_RWKV = 8
D_ATTN = N_HEADS_ATTN * HEAD_DIM
D_RWKV = N_HEADS_RWKV * HEAD_DIM
REL_CLIP = 128
DECAY_LORA = 64
AAA_LORA = 64
MV_LORA = 32
GATE_LORA = 160
N_GROUPS = 4
EXPERTS_PER_GROUP = 8
N_EXPERTS = N_GROUPS * EXPERTS_PER_GROUP
TOP_K_IN_GROUP = 2
D_EXPERT = 256
D_PLE = 256
DEEPNORM_ALPHA = (2 * DEPTH) ** 0.25
DEEPNORM_BETA = (8 * DEPTH) ** -0.25
LN_EPS = 1e-5
GN_EPS = 64e-5
NEG_INF = -1e30

Q0 = 0
K0 = D_ATTN
V0 = 2 * D_ATTN
RW0 = 3 * D_ATTN
RW_COLS = 3 * D_RWKV + DECAY_LORA + AAA_LORA + GATE_LORA
GATE0 = RW0 + RW_COLS
N_IN = GATE0 + 2 * D_MODEL

kernel_name = "hybrid_chunkattn_rwkv7_hiermoe_deepnorm"


def layer_norm(x, g, b):
    x32 = x.astype(jnp.float32)
    mu = jnp.mean(x32, axis=-1, keepdims=True)
    var = jnp.mean(jnp.square(x32 - mu), axis=-1, keepdims=True)
    y = (x32 - mu) * lax.rsqrt(var + LN_EPS)
    return (y * g.astype(jnp.float32) + b.astype(jnp.float32)).astype(x.dtype)


def chunked_band_attention(q, k, v, rel_bias):
    B, S, _ = q.shape
    nc = S // CHUNK
    q = q.reshape(B, nc, CHUNK, N_HEADS_ATTN, HEAD_DIM)
    pad = ((0, 0), (N_PREV_CHUNKS * CHUNK, 0), (0, 0))
    kp = jnp.pad(k, pad).reshape(B, nc + N_PREV_CHUNKS, CHUNK, N_HEADS_ATTN, HEAD_DIM)
    vp = jnp.pad(v, pad).reshape(B, nc + N_PREV_CHUNKS, CHUNK, N_HEADS_ATTN, HEAD_DIM)
    kb = jnp.concatenate([kp[:, j:j + nc] for j in range(N_PREV_CHUNKS + 1)], axis=2)
    vb = jnp.concatenate([vp[:, j:j + nc] for j in range(N_PREV_CHUNKS + 1)], axis=2)
    scores = jnp.einsum("bcqhd,bckhd->bhcqk", q, kb).astype(jnp.float32) * (HEAD_DIM ** -0.5)
    qi = jnp.arange(CHUNK)[:, None]
    kj = jnp.arange(BAND)[None, :]
    dist = qi - (kj - N_PREV_CHUNKS * CHUNK)
    idx = jnp.clip(dist, -REL_CLIP, REL_CLIP) + REL_CLIP
    bias = rel_bias[:, idx].astype(jnp.float32)
    key_chunk = jnp.arange(nc)[:, None] - N_PREV_CHUNKS + (jnp.arange(BAND) // CHUNK)[None, :]
    valid = key_chunk >= 0
    scores = jnp.where(valid[None, None, :, None, :], scores + bias[None, :, None], NEG_INF)
    prob = jax.nn.softmax(scores, axis=-1).astype(v.dtype)
    out = jnp.einsum("bhcqk,bckhd->bcqhd", prob, vb)
    return out.reshape(B, S, D_ATTN)


def rwkv7_scan(r, w, k, v, a, b):
    B, S, H, N = r.shape
    xs = tuple(jnp.swapaxes(t.astype(jnp.float32), 0, 1) for t in (r, w, k, v, a, b))

    def step(state, inp):
        rt, wt, kt, vt, at, bt = inp
        sa = jnp.einsum("bhij,bhj->bhi", state, at)
        state = state * wt[:, :, None, :] + sa[..., None] * bt[:, :, None, :] + vt[..., None] * kt[:, :, None, :]
        return state, jnp.einsum("bhij,bhj->bhi", state, rt)

    state0 = jnp.zeros((B, H, N, N), jnp.float32)
    _, ys = lax.scan(step, state0, xs)
    return jnp.swapaxes(ys, 0, 1)


def rwkv7_time_mix(cols, mu, v_first, decay_base, decay_up, aaa_base, aaa_up, gate_up,
                   k_k, k_a, r_k, gn_g, gn_b, vres):
    B, S, _ = cols.shape
    prev = jnp.pad(cols, ((0, 0), (1, 0), (0, 0)))[:, :-1]
    cols = cols + (prev - cols) * mu
    splits = [D_RWKV, 2 * D_RWKV, 3 * D_RWKV, 3 * D_RWKV + DECAY_LORA, 3 * D_RWKV + DECAY_LORA + AAA_LORA]
    r, k, v, wd, ad, gd = jnp.split(cols, splits, axis=-1)
    w_log = -jax.nn.softplus(-(decay_base + jnp.tanh(wd) @ decay_up)) - 0.5
    decay = jnp.exp(-jnp.exp(w_log.astype(jnp.float32)))
    a = jax.nn.sigmoid(aaa_base + ad @ aaa_up)
    g = jax.nn.sigmoid(gd) @ gate_up
    heads = lambda t: t.reshape(B, S, N_HEADS_RWKV, HEAD_DIM)
    kk = heads(k * k_k).astype(jnp.float32)
    kk = kk * lax.rsqrt(jnp.maximum(jnp.sum(kk * kk, axis=-1, keepdims=True), 1e-24))
    k = k * (1.0 + (a - 1.0) * k_a)
    if vres is None:
        v_first = v
    else:
        vres_base, vres_down, vres_up = vres
        v = v + (v_first - v) * jax.nn.sigmoid(vres_base + (v @ vres_down) @ vres_up)
    r_h, k_h, v_h, a_h = heads(r), heads(k), heads(v), heads(a)
    y = rwkv7_scan(r_h, heads(decay), k_h, v_h, -kk, kk * a_h.astype(jnp.float32))
    m = jnp.mean(y, axis=-1, keepdims=True)
    var = jnp.mean(jnp.square(y - m), axis=-1, keepdims=True)
    yn = ((y - m) * lax.rsqrt(var + GN_EPS)).reshape(B, S, D_RWKV)
    yn = yn * gn_g.astype(jnp.float32) + gn_b.astype(jnp.float32)
    bonus = (jnp.sum(r_h * k_h * r_k, axis=-1, keepdims=True) * v_h).reshape(B, S, D_RWKV)
    out = (yn.astype(cols.dtype) + bonus) * g
    return out, v_first


def hier_moe(x, w_grp, b_grp, w_exp, b_exp, e_gate, e_up, e_down):
    B, S, D = x.shape
    T = B * S
    xt = x.reshape(T, D)
    glog = (xt @ w_grp + b_grp).astype(jnp.float32)
    gprob = jax.nn.softmax(glog, axis=-1)
    grp = jnp.argmax(glog, axis=-1)
    g_gate = jnp.take_along_axis(gprob, grp[:, None], axis=1)
    elog = (xt @ w_exp + b_exp).astype(jnp.float32).reshape(T, N_GROUPS, EXPERTS_PER_GROUP)
    sel = jnp.take_along_axis(elog, grp[:, None, None], axis=1)[:, 0]
    top_v, top_i = lax.top_k(sel, TOP_K_IN_GROUP)
    wk = jax.nn.softmax(top_v, axis=-1) * g_gate
    eid = grp[:, None] * EXPERTS_PER_GROUP + top_i
    comb = jnp.sum(jax.nn.one_hot(eid, N_EXPERTS, dtype=jnp.float32) * wk[..., None], axis=1).astype(x.dtype)
    out = jnp.zeros_like(xt)
    for e in range(N_EXPERTS):
        h = jax.nn.silu(xt @ e_gate[e]) * (xt @ e_up[e])
        out = out + (h * comb[:, e:e + 1]) @ e_down[e]
    return out.reshape(B, S, D)


def setup_inputs(seed: int = 0) -> dict:
    key = jax.random.key(seed)
    keys = iter(jax.random.split(key, 48))
    nrm = lambda shape, s: jax.random.normal(next(keys), shape, jnp.float32) * s
    uni = lambda shape, lo, hi: jax.random.uniform(next(keys), shape, jnp.float32, lo, hi)
    col_scale = jnp.ones((N_IN,), jnp.float32)
    col_scale = col_scale.at[V0:RW0].set(DEEPNORM_BETA)
    col_scale = col_scale.at[RW0 + 2 * D_RWKV:RW0 + 3 * D_RWKV].set(DEEPNORM_BETA)
    return {
        "x": nrm((BATCH, SEQ, D_MODEL), 1.0),
        "p": nrm((DEPTH, BATCH, SEQ, D_PLE), 1.0),
        "ln_in_g": 1.0 + nrm((D_MODEL,), 0.02),
        "ln_in_b": nrm((D_MODEL,), 0.02),
        "rel_bias": nrm((N_HEADS_ATTN, 2 * REL_CLIP + 1), 0.1),
        "w_in": nrm((DEPTH, D_MODEL, N_IN), D_MODEL ** -0.5) * col_scale,
        "tok_mix": uni((DEPTH, RW_COLS), 0.0, 1.0),
        "decay_base": uni((DEPTH, D_RWKV), -6.0, -1.0),
        "decay_up": nrm((DEPTH, DECAY_LORA, D_RWKV), DECAY_LORA ** -0.5),
        "aaa_base": nrm((DEPTH, D_RWKV), 0.1),
        "aaa_up": nrm((DEPTH, AAA_LORA, D_RWKV), AAA_LORA ** -0.5),
        "gate_up": nrm((DEPTH, GATE_LORA, D_RWKV), GATE_LORA ** -0.5),
        "k_k": 0.85 + nrm((DEPTH, D_RWKV), 0.02),
        "k_a": 1.0 + nrm((DEPTH, D_RWKV), 0.02),
        "r_k": nrm((DEPTH, N_HEADS_RWKV, HEAD_DIM), 0.1),
        "vres_base": nrm((DEPTH - 1, D_RWKV), 0.1),
        "vres_down": nrm((DEPTH - 1, D_RWKV, MV_LORA), D_RWKV ** -0.5),
        "vres_up": nrm((DEPTH - 1, MV_LORA, D_RWKV), MV_LORA ** -0.5),
        "gn_g": 1.0 + nrm((DEPTH, D_RWKV), 0.02),
        "gn_b": nrm((DEPTH, D_RWKV), 0.02),
        "w_branch_attn": nrm((DEPTH, D_ATTN, D_MODEL), D_ATTN ** -0.5 * DEEPNORM_BETA),
        "w_branch_rwkv": nrm((DEPTH, D_RWKV, D_MODEL), D_RWKV ** -0.5 * DEEPNORM_BETA),
        "w_out": nrm((DEPTH, D_MODEL, D_MODEL), D_MODEL ** -0.5 * DEEPNORM_BETA),
        "router_grp": nrm((DEPTH, D_MODEL, N_GROUPS), D_MODEL ** -0.5),
        "router_grp_bias": nrm((DEPTH, N_GROUPS), 0.01),
        "router_exp": nrm((DEPTH, D_MODEL, N_EXPERTS), D_MODEL ** -0.5),
        "router_exp_bias": nrm((DEPTH, N_EXPERTS), 0.01),
        "exp_gate": nrm((DEPTH, N_EXPERTS, D_MODEL, D_EXPERT), D_MODEL ** -0.5),
        "exp_up": nrm((DEPTH, N_EXPERTS, D_MODEL, D_EXPERT), D_MODEL ** -0.5),
        "exp_down": nrm((DEPTH, N_EXPERTS, D_EXPERT, D_MODEL), D_EXPERT ** -0.5 * DEEPNORM_BETA),
        "ple_proj": nrm((DEPTH, D_PLE, D_MODEL), D_PLE ** -0.5 * DEEPNORM_BETA),
        "ple_gate": nrm((DEPTH, D_MODEL, D_MODEL), D_MODEL ** -0.5),
        "ln_g": 1.0 + nrm((DEPTH, 3, D_MODEL), 0.02),
        "ln_b": nrm((DEPTH, 3, D_MODEL), 0.02),
    }


def reference(x, p, ln_in_g, ln_in_b, rel_bias, w_in, tok_mix, decay_base, decay_up,
              aaa_base, aaa_up, gate_up, k_k, k_a, r_k, vres_base, vres_down, vres_up,
              gn_g, gn_b, w_branch_attn, w_branch_rwkv, w_out, router_grp, router_grp_bias,
              router_exp, router_exp_bias, exp_gate, exp_up, exp_down, ple_proj, ple_gate,
              ln_g, ln_b):
    x = layer_norm(x, ln_in_g, ln_in_b)
    v_first = None
    for i in range(DEPTH):
        proj = x @ w_in[i]
        y_attn = chunked_band_attention(proj[..., Q0:K0], proj[..., K0:V0], proj[..., V0:RW0], rel_bias)
        vres = None if i == 0 else (vres_base[i - 1], vres_down[i - 1], vres_up[i - 1])
        y_rwkv, v_first = rwkv7_time_mix(proj[..., RW0:GATE0], tok_mix[i], v_first, decay_base[i],
                                         decay_up[i], aaa_base[i], aaa_up[i], gate_up[i], k_k[i],
                                         k_a[i], r_k[i], gn_g[i], gn_b[i], vres)
        gate_a = jax.nn.sigmoid(proj[..., GATE0:GATE0 + D_MODEL])
        gate_b = jax.nn.sigmoid(proj[..., GATE0 + D_MODEL:])
        mixed = (gate_a * (y_attn @ w_branch_attn[i]) + gate_b * (y_rwkv @ w_branch_rwkv[i])) @ w_out[i]
        x = layer_norm(DEEPNORM_ALPHA * x + mixed, ln_g[i, 0], ln_b[i, 0])
        moe = hier_moe(x, router_grp[i], router_grp_bias[i], router_exp[i], router_exp_bias[i],
                       exp_gate[i], exp_up[i], exp_down[i])
        x = layer_norm(DEEPNORM_ALPHA * x + moe, ln_g[i, 1], ln_b[i, 1])
        ple = (p[i] @ ple_proj[i]) * jax.nn.sigmoid(x @ ple_gate[i])
        x = layer_norm(DEEPNORM_ALPHA * x + ple, ln_g[i, 2], ln_b[i, 2])
    return x
```

```cpp
#include <hip/hip_runtime.h>
#include <cstdio>
#include <cstdint>
#include <cmath>
namespace pg8 {
#define PG8_LAS __attribute__((address_space(3)))
typedef unsigned short bf16_t;
typedef short bf16x8 __attribute__((ext_vector_type(8)));
typedef float f32x4 __attribute__((ext_vector_type(4)));
typedef unsigned u32x4 __attribute__((ext_vector_type(4)));
constexpr int BM = 256, BK = 64, HALF = 128, HTB = HALF * BK * 2  , STAGE_BYTES = 8 * HTB, NXCD = 8, WGM = 8;

__host__ __device__ __forceinline__ int lds_byte(int r, int c) { const int st = (r >> 4) * 2 + (c >> 5), rr = r & 15, cc = c & 31, ob = rr * 64 + cc * 2; return st * 1024 + (ob ^ (((ob >> 9) & 1) << 5)); }
__host__ __device__ __forceinline__ void stage_rc(int b, int& R, int& C) { const int st = b / 1024, sb = b % 1024, swz = sb ^ (((sb >> 9) & 1) << 5); R = (st >> 1) * 16 + swz / 64; C = (st & 1) * 32 + (swz % 64) / 2; }
__host__ __device__ __forceinline__ int perm32(int rho) { const int n = rho >> 4, i = rho & 15; return 8 * (i >> 2) + 4 * n + (i & 3); }

struct Unit { int pm, pn; };
struct Gemm { const bf16_t* A; const bf16_t* Bt; int M, N, K; };

struct StaticOrder {
    int nM, nN, nwg, G, c;
    __host__ __device__ void init(int M, int N, int G_, int c_) { nM = M / BM; nN = N / BM; nwg = nM * nN; G = G_; c = c_; }
    __host__ __device__ bool next(int i, Unit& u) const {
        const long L = (long)i * G + c; if (L >= nwg) return false;
        int wgid = (int)L; { const int q = nwg / NXCD, r = nwg % NXCD, xcd = wgid % NXCD, off = wgid / NXCD; wgid = (xcd < r ? xcd * (q + 1) : r * (q + 1) + (xcd - r) * q) + off; }
        const int nig = WGM * nN, gid = wgid / nig, fm = gid * WGM, gsz = (nM - fm) < WGM ? (nM - fm) : WGM;
        u.pm = fm + ((wgid % nig) % gsz); u.pn = (wgid % nig) / gsz; return true;
    }
    __device__ __forceinline__ void a_ready(const Unit&) const {}
    __device__ __forceinline__ void done(const Unit&) const {}
};
__device__ __forceinline__ unsigned cvt_pk_bf16(float lo, float hi) { unsigned r; asm volatile("v_cvt_pk_bf16_f32 %0, %1, %2" : "=v"(r) : "v"(lo), "v"(hi)); return r; }
typedef float f32x2 __attribute__((ext_vector_type(2)));
typedef unsigned u32x2 __attribute__((ext_vector_type(2)));
__device__ __forceinline__ float bf_lo(unsigned w) { return __uint_as_float(w << 16); }
__device__ __forceinline__ float bf_hi(unsigned w) { return __uint_as_float(w & 0xffff0000u); }
__device__ __forceinline__ float sigm(float x) { return __builtin_amdgcn_rcpf(1.0f + __builtin_amdgcn_exp2f(-1.44269504f * x)); }

struct EpiStore {
    static constexpr bool PERM = true, AFTER_DRAIN = false;
    bf16_t* O; int ldc; int pn_mod;
    __device__ __forceinline__ void operator()(const f32x4 (&acc)[2][2][4][2], const Unit& u, int wr, int wc, int fr, int fq) const {
        const int row0 = u.pm * BM + wr * 64 + fr, col0 = (u.pn % pn_mod) * BM + wc * 32 + 8 * fq;
#pragma unroll
        for (int ai = 0; ai < 2; ++ai)
#pragma unroll
            for (int m = 0; m < 4; ++m) { bf16_t* rowp = O + (size_t)(row0 + ai * HALF + m * 16) * ldc + col0;
#pragma unroll
                for (int bj = 0; bj < 2; ++bj) { const f32x4 v0 = acc[ai][bj][m][0], v1 = acc[ai][bj][m][1];
                    u32x4 w; w.x = cvt_pk_bf16(v0[0], v0[1]); w.y = cvt_pk_bf16(v0[2], v0[3]); w.z = cvt_pk_bf16(v1[0], v1[1]); w.w = cvt_pk_bf16(v1[2], v1[3]);
                    *(u32x4*)(rowp + bj * HALF) = w; } }
    }
};
template <int MODE> struct EpiGate {
    static constexpr bool PERM = true, AFTER_DRAIN = false;
    const bf16_t* T1; const bf16_t* T2; bf16_t* O; int ldc;
    __device__ __forceinline__ void operator()(const f32x4 (&acc)[2][2][4][2], const Unit& u, int wr, int wc, int fr, int fq) const {
        const int row0 = u.pm * BM + wr * 64 + fr, col0 = u.pn * BM + wc * 32 + 8 * fq;
#pragma unroll
        for (int ai = 0; ai < 2; ++ai)
#pragma unroll
            for (int m = 0; m < 4; ++m) { const size_t off = (size_t)(row0 + ai * HALF + m * 16) * ldc + col0;
#pragma unroll
                for (int bj = 0; bj < 2; ++bj) { const f32x4 v0 = acc[ai][bj][m][0], v1 = acc[ai][bj][m][1];
                    const u32x4 a = *(const u32x4*)(T1 + off + bj * HALF);
                    float r[8];
                    if (MODE == 0) {
                        r[0] = sigm(v0[0]) * bf_lo(a.x); r[1] = sigm(v0[1]) * bf_hi(a.x); r[2] = sigm(v0[2]) * bf_lo(a.y); r[3] = sigm(v0[3]) * bf_hi(a.y);
                        r[4] = sigm(v1[0]) * bf_lo(a.z); r[5] = sigm(v1[1]) * bf_hi(a.z); r[6] = sigm(v1[2]) * bf_lo(a.w); r[7] = sigm(v1[3]) * bf_hi(a.w);
                    } else {
                        const u32x4 b = *(const u32x4*)(T2 + off + bj * HALF);
                        r[0] = bf_lo(a.x) + sigm(v0[0]) * bf_lo(b.x); r[1] = bf_hi(a.x) + sigm(v0[1]) * bf_hi(b.x); r[2] = bf_lo(a.y) + sigm(v0[2]) * bf_lo(b.y); r[3] = bf_hi(a.y) + sigm(v0[3]) * bf_hi(b.y);
                        r[4] = bf_lo(a.z) + sigm(v1[0]) * bf_lo(b.z); r[5] = bf_hi(a.z) + sigm(v1[1]) * bf_hi(b.z); r[6] = bf_lo(a.w) + sigm(v1[2]) * bf_lo(b.w); r[7] = bf_hi(a.w) + sigm(v1[3]) * bf_hi(b.w);
                    }
                    u32x4 w; w.x = cvt_pk_bf16(r[0], r[1]); w.y = cvt_pk_bf16(r[2], r[3]); w.z = cvt_pk_bf16(r[4], r[5]); w.w = cvt_pk_bf16(r[6], r[7]);
                    *(u32x4*)(O + off + bj * HALF) = w; } }
    }
};
template <int MODE> struct EpiRes {
    static constexpr bool PERM = false, AFTER_DRAIN = false;
    float* X; const bf16_t* TP; int ldc; float alpha;
    __device__ __forceinline__ void operator()(const f32x4 (&acc)[2][2][4][2], const Unit& u, int wr, int wc, int fr, int fq) const {
        const int row0 = u.pm * BM + wr * 64 + fr, col0 = u.pn * BM + wc * 32 + 4 * fq;
#pragma unroll
        for (int ai = 0; ai < 2; ++ai)
#pragma unroll
            for (int m = 0; m < 4; ++m) { const size_t off = (size_t)(row0 + ai * HALF + m * 16) * ldc + col0;
#pragma unroll
                for (int bj = 0; bj < 2; ++bj) { if (MODE == 1 && bj == 1) asm volatile("" ::: "memory");
#pragma unroll
                    for (int n = 0; n < 2; ++n) { float* p = X + off + bj * HALF + n * 16; const f32x4 x = *(const f32x4*)p; f32x4 a = acc[ai][bj][m][n];
                        if (MODE == 1) { const u32x2 t = *(const u32x2*)(TP + off + bj * HALF + n * 16);
                            a = (f32x4){bf_lo(t.x) * sigm(a[0]), bf_hi(t.x) * sigm(a[1]), bf_lo(t.y) * sigm(a[2]), bf_hi(t.y) * sigm(a[3])}; }
                        *(f32x4*)p = x * alpha + a; } }
                if (MODE == 1 || (m & 1)) asm volatile("" ::: "memory"); }
    }
};
struct EpiRouter {
    static constexpr bool PERM = false, AFTER_DRAIN = false;
    float* LOG; const float* bias;
    __device__ __forceinline__ void operator()(const f32x4 (&acc)[2][2][4][2], const Unit& u, int wr, int wc, int fr, int fq) const {
        if (wc >= 2) return;
        const int row0 = u.pm * BM + wr * 64 + fr, col0 = wc * 32 + 4 * fq;
        const f32x4 b0 = *(const f32x4*)(bias + col0), b1 = *(const f32x4*)(bias + col0 + 16);
#pragma unroll
        for (int ai = 0; ai < 2; ++ai)
#pragma unroll
            for (int m = 0; m < 4; ++m) { float* p = LOG + (size_t)(row0 + ai * HALF + m * 16) * 64 + col0;
                *(f32x4*)p = acc[ai][0][m][0] + b0; *(f32x4*)(p + 16) = acc[ai][0][m][1] + b1; }
    }
};
struct EpiSwiglu {
    static constexpr bool PERM = true, AFTER_DRAIN = false;
    bf16_t* H;
    __device__ __forceinline__ void operator()(const f32x4 (&acc)[2][2][4][2], const Unit& u, int wr, int wc, int fr, int fq) const {
        const int row0 = u.pm * BM + wr * 64 + fr, col0 = (u.pn & 1) * HALF + wc * 32 + 8 * fq;
#pragma unroll
        for (int ai = 0; ai < 2; ++ai)
#pragma unroll
            for (int m = 0; m < 4; ++m) { bf16_t* rowp = H + (size_t)(row0 + ai * HALF + m * 16) * 256 + col0;
                const f32x4 g0 = acc[ai][0][m][0], g1 = acc[ai][0][m][1], u0 = acc[ai][1][m][0], u1 = acc[ai][1][m][1];
                float r[8];
#pragma unroll
                for (int q = 0; q < 4; ++q) { r[q] = g0[q] * sigm(g0[q]) * u0[q]; r[4 + q] = g1[q] * sigm(g1[q]) * u1[q]; }
                u32x4 w; w.x = cvt_pk_bf16(r[0], r[1]); w.y = cvt_pk_bf16(r[2], r[3]); w.z = cvt_pk_bf16(r[4], r[5]); w.w = cvt_pk_bf16(r[6], r[7]);
                *(u32x4*)rowp = w; }
    }
};
struct MoeOrder {
    const int* tile_e; int nunits, npn, G, c;
    __device__ __forceinline__ void init(const int* te, int ntiles, int npn_, int G_, int c_) { tile_e = te; npn = npn_; nunits = ntiles * npn_; G = G_; c = c_; }
    __device__ __forceinline__ bool next(int i, Unit& u) const {
        const int L = i * G + c; if (L >= nunits) return false;
        const int rt = L / npn, pn = L - rt * npn;
        const int e = __builtin_amdgcn_readfirstlane(__hip_atomic_load(tile_e + rt, __ATOMIC_RELAXED, __HIP_MEMORY_SCOPE_AGENT));
        u.pm = rt; u.pn = e * npn + pn; return true;
    }
    __device__ __forceinline__ void a_ready(const Unit&) const {}
    __device__ __forceinline__ void done(const Unit&) const {}
};
template <class Epi, class Sched, bool ALIGN_EPI = false, bool SP2 = false>
__device__ __forceinline__ void gemm_phase(PG8_LAS unsigned char* lds, const Gemm g, const Sched& S, const Epi& E, const int wv) {
    int tid_ = wv * 64 + (int)__builtin_amdgcn_mbcnt_hi(~0u, __builtin_amdgcn_mbcnt_lo(~0u, 0u)); asm volatile("" : "+v"(tid_));
    const int tid = tid_, wid = __builtin_amdgcn_readfirstlane(tid >> 6), lane = tid & 63, wr = wid >> 2, wc = wid & 3, fr = lane & 15, fq = lane >> 4;
    const int K = g.K, nt = K / BK;
    unsigned voffA[2], voffB[2];
#pragma unroll
    for (int i = 0; i < 2; ++i) { int R, C; stage_rc(tid * 16 + i * 8192, R, C); const int Rb = Epi::PERM ? ((R & ~31) + perm32(R & 31)) : R;
        voffA[i] = (unsigned)(R * K + C) * 2u; voffB[i] = (unsigned)(Rb * K + C) * 2u; }
    const size_t kstep = (size_t)(BK * 2);
    const size_t hstep = (size_t)HALF * K * 2;
    const size_t tstep = 2 * hstep;
    const unsigned ldsw = (unsigned)wid * 1024u;
    const int aoff = lds_byte(wr * 64 + fr, fq * 8), boff = lds_byte(wc * 32 + fr, fq * 8);
#define PG8_SA(b, h) (((b) * 2 + (h)) * HTB)
#define PG8_SB(b, h) ((4 + (b) * 2 + (h)) * HTB)
#define PG8_STAGE(bufoff, gbase, voff) do { _Pragma("unroll") for (int _i = 0; _i < 2; ++_i) \
        __builtin_amdgcn_global_load_lds((const unsigned*)((const char*)(gbase) + (voff)[_i]), (PG8_LAS unsigned*)(lds + (bufoff) + ldsw + _i * 8192), 16, 0, 0); } while (0)
#define PG8_LDA(dst, b, h) do { _Pragma("unroll") for (int m = 0; m < 4; ++m) _Pragma("unroll") for (int k = 0; k < 2; ++k) dst[m][k] = *(const PG8_LAS bf16x8*)(lds + PG8_SA(b, h) + aoff + m * 2048 + k * 1024); } while (0)
#define PG8_LDB(dst, b, h) do { _Pragma("unroll") for (int n = 0; n < 2; ++n) _Pragma("unroll") for (int k = 0; k < 2; ++k) dst[n][k] = *(const PG8_LAS bf16x8*)(lds + PG8_SB(b, h) + boff + n * 2048 + k * 1024); } while (0)
#define PG8_MMA(ai, bj, At, Bt) do { __builtin_amdgcn_s_setprio(1); _Pragma("unroll") for (int m = 0; m < 4; ++m) _Pragma("unroll") for (int n = 0; n < 2; ++n) _Pragma("unroll") for (int k = 0; k < 2; ++k) \
        acc[ai][bj][m][n] = __builtin_amdgcn_mfma_f32_16x16x32_bf16(Bt[n][k], At[m][k], acc[ai][bj][m][n], 0, 0, 0); __builtin_amdgcn_s_setprio(0); } while (0)
#define PG8_WAIT_V(n) asm volatile("s_waitcnt vmcnt(" #n ")" ::: "memory")
#define PG8_WAIT_L(n) asm volatile("s_waitcnt lgkmcnt(" #n ")" ::: "memory")
#define PG8_BAR __builtin_amdgcn_s_barrier()
#define PG8_SCHED __builtin_amdgcn_sched_barrier(0)
    Unit cur, nxt; int ui = 0;
    if (!S.next(0, cur)) return;
    f32x4 acc[2][2][4][2];
#pragma unroll
    for (int a = 0; a < 2; ++a)
#pragma unroll
        for (int b = 0; b < 2; ++b)
#pragma unroll
            for (int m = 0; m < 4; ++m)
#pragma unroll
                for (int n = 0; n < 2; ++n) acc[a][b][m][n] = (f32x4){0.f, 0.f, 0.f, 0.f};
    bf16x8 At[4][2], B0[2][2], B1[2][2];
    const char* cA = (const char*)g.A + (size_t)cur.pm * tstep; const char* cB = (const char*)g.Bt + (size_t)cur.pn * tstep;
    S.a_ready(cur);
    if constexpr (SP2) {
        PG8_STAGE(PG8_SB(0, 0), cB, voffB); PG8_STAGE(PG8_SB(0, 1), cB + hstep, voffB); PG8_STAGE(PG8_SA(0, 0), cA, voffA); PG8_STAGE(PG8_SA(0, 1), cA + hstep, voffA);
        if (wr == 1) PG8_BAR;
        PG8_WAIT_V(2); PG8_BAR;
        PG8_STAGE(PG8_SB(1, 0), cB + kstep, voffB); PG8_STAGE(PG8_SA(1, 0), cA + kstep, voffA); PG8_STAGE(PG8_SB(1, 1), cB + hstep + kstep, voffB);
        PG8_WAIT_V(6); PG8_BAR;
    } else {
        PG8_STAGE(PG8_SB(0, 0), cB, voffB); PG8_STAGE(PG8_SA(0, 0), cA, voffA); PG8_STAGE(PG8_SB(0, 1), cB + hstep, voffB); PG8_STAGE(PG8_SA(0, 1), cA + hstep, voffA);
        if (wr == 1) PG8_BAR;
        PG8_WAIT_V(4); PG8_BAR;
        PG8_STAGE(PG8_SB(1, 0), cB + kstep, voffB); PG8_STAGE(PG8_SA(1, 0), cA + kstep, voffA); PG8_STAGE(PG8_SB(1, 1), cB + hstep + kstep, voffB);
        PG8_WAIT_V(6); PG8_BAR;
    }
    for (;;) {
        const bool has_next = S.next(ui + 1, nxt);
        const char* nA = has_next ? (const char*)g.A + (size_t)nxt.pm * tstep : cA; const char* nB = has_next ? (const char*)g.Bt + (size_t)nxt.pn * tstep : cB;
        for (int t = 0; t < nt; t += 2) {
            const bool last = (t == nt - 2);
            const char* a1 = cA + (size_t)(t + 1) * kstep;
            const char* a2 = last ? nA : cA + (size_t)(t + 2) * kstep; const char* b2 = last ? nB : cB + (size_t)(t + 2) * kstep;
            const char* a3 = a2 + kstep; const char* b3 = b2 + kstep;
            if (last && has_next) S.a_ready(nxt);
            if constexpr (SP2) {
            PG8_LDB(B0, 0, 0); PG8_LDB(B1, 0, 1); PG8_SCHED; PG8_LDA(At, 0, 0); PG8_STAGE(PG8_SA(1, 1), a1 + hstep, voffA);
            PG8_WAIT_V(8); PG8_WAIT_L(0); PG8_BAR; PG8_MMA(0, 0, At, B0); PG8_MMA(0, 1, At, B1); PG8_BAR; PG8_SCHED;
            PG8_LDA(At, 0, 1); PG8_STAGE(PG8_SB(0, 0), b2, voffB); PG8_STAGE(PG8_SB(0, 1), b2 + hstep, voffB); PG8_STAGE(PG8_SA(0, 0), a2, voffA);
            PG8_WAIT_V(8); PG8_WAIT_L(0); PG8_BAR; PG8_MMA(1, 0, At, B0); PG8_MMA(1, 1, At, B1); PG8_BAR; PG8_SCHED;
            PG8_LDB(B0, 1, 0); PG8_LDB(B1, 1, 1); PG8_SCHED; PG8_LDA(At, 1, 0); PG8_STAGE(PG8_SA(0, 1), a2 + hstep, voffA);
            PG8_WAIT_V(8); PG8_WAIT_L(0); PG8_BAR; PG8_MMA(0, 0, At, B0); PG8_MMA(0, 1, At, B1); PG8_BAR; PG8_SCHED;
            PG8_LDA(At, 1, 1); PG8_STAGE(PG8_SB(1, 0), b3, voffB); PG8_STAGE(PG8_SB(1, 1), b3 + hstep, voffB); PG8_STAGE(PG8_SA(1, 0), a3, voffA);
            PG8_WAIT_V(8); PG8_WAIT_L(0); PG8_BAR; PG8_MMA(1, 0, At, B0); PG8_MMA(1, 1, At, B1); PG8_BAR; PG8_SCHED;
            } else {
            PG8_LDB(B0, 0, 0); PG8_SCHED; PG8_LDA(At, 0, 0); PG8_STAGE(PG8_SA(1, 1), a1 + hstep, voffA);
            PG8_WAIT_L(8); PG8_BAR; PG8_WAIT_L(0); PG8_MMA(0, 0, At, B0); PG8_BAR; PG8_SCHED;
            PG8_LDB(B1, 0, 1); PG8_STAGE(PG8_SB(0, 0), b2, voffB);
            PG8_BAR; PG8_WAIT_L(0); PG8_MMA(0, 1, At, B1); PG8_BAR;
            PG8_LDA(At, 0, 1); PG8_STAGE(PG8_SA(0, 0), a2, voffA);
            PG8_BAR; PG8_WAIT_L(0); PG8_MMA(1, 0, At, B0); PG8_BAR; PG8_SCHED;
            PG8_STAGE(PG8_SB(0, 1), b2 + hstep, voffB);
            PG8_WAIT_V(6); PG8_BAR; PG8_MMA(1, 1, At, B1); PG8_BAR;
            PG8_LDB(B0, 1, 0); PG8_SCHED; PG8_LDA(At, 1, 0); PG8_STAGE(PG8_SA(0, 1), a2 + hstep, voffA);
            PG8_WAIT_L(8); PG8_BAR; PG8_WAIT_L(0); PG8_MMA(0, 0, At, B0); PG8_BAR; PG8_SCHED;
            PG8_LDB(B1, 1, 1); PG8_STAGE(PG8_SB(1, 0), b3, voffB);
            PG8_BAR; PG8_WAIT_L(0); PG8_MMA(0, 1, At, B1); PG8_BAR;
            PG8_LDA(At, 1, 1); PG8_STAGE(PG8_SA(1, 0), a3, voffA);
            PG8_BAR; PG8_WAIT_L(0); PG8_MMA(1, 0, At, B0); PG8_BAR; PG8_SCHED;
            PG8_STAGE(PG8_SB(1, 1), b3 + hstep, voffB);
            PG8_WAIT_V(6); PG8_BAR; PG8_MMA(1, 1, At, B1); PG8_BAR;
            }
        }
        if constexpr (ALIGN_EPI) { if (wr == 0) PG8_BAR; }
        if constexpr (!Epi::AFTER_DRAIN) { E(acc, cur, wr, wc, fr, fq); S.done(cur); }
        if (!has_next) break;
#pragma unroll
        for (int a = 0; a < 2; ++a)
#pragma unroll
            for (int b = 0; b < 2; ++b)
#pragma unroll
                for (int m = 0; m < 4; ++m)
#pragma unroll
                    for (int n = 0; n < 2; ++n) acc[a][b][m][n] = (f32x4){0.f, 0.f, 0.f, 0.f};
        cur = nxt; cA = nA; cB = nB; ++ui;
        if constexpr (ALIGN_EPI) { if (wr == 1) PG8_BAR; }
    }
    PG8_WAIT_V(0);
    if constexpr (!ALIGN_EPI) { if (wr == 0) PG8_BAR; }
    PG8_BAR;
    if constexpr (Epi::AFTER_DRAIN) { E.fused(acc, cur, wr, wc, fr, fq, lds, wid, lane); S.done(cur); }
#undef PG8_SA
#undef PG8_SB
#undef PG8_STAGE
#undef PG8_LDA
#undef PG8_LDB
#undef PG8_MMA
#undef PG8_WAIT_V
#undef PG8_WAIT_L
#undef PG8_BAR
#undef PG8_SCHED
}
}

constexpr int T = 32768, D = 1024, SEQ = 2048;
constexpr int NWAVES = 8;
constexpr float LOG2E = 1.44269504f, ALPHA = 1.41421356237f, LN_EPS = 1e-5f, GN_EPS = 64e-5f;
constexpr size_t MiB = 1u << 20;
constexpr size_t WS_CTL = 0, CTL_ZERO_BYTES = 1 * MiB;
constexpr size_t WS_DUT = 1 * MiB, WS_AUT = WS_DUT + 128 * 1024, WS_GUT = WS_DUT + 256 * 1024, WS_VDT = WS_DUT + 576 * 1024, WS_VUT = WS_DUT + 608 * 1024,
                 WS_RB = WS_DUT + 640 * 1024, WS_TILE = WS_DUT + 704 * 1024;
constexpr size_t WS_RWT = 2 * MiB;
constexpr size_t WS_TOKE = 3 * MiB, WS_TOKP = WS_TOKE + 256 * 1024, WS_TOKW = WS_TOKE + 512 * 1024, WS_TOKS = WS_TOKE + 768 * 1024;
constexpr size_t WS_WNE = 4 * MiB, WNE_LAYER = 18 * MiB;
constexpr size_t WNE_WIN = 0, WNE_WBA = 11 * MiB, WNE_WBR = 12 * MiB, WNE_WOUT = 13 * MiB, WNE_WPG = 15 * MiB, WNE_WPLE = 17 * MiB;
constexpr size_t WS_XB = 40 * MiB, WS_VF = 104 * MiB, WS_YA = 136 * MiB, WS_YB = 168 * MiB, WS_QK = 200 * MiB, WS_VT = 264 * MiB, WS_RKVL = 296 * MiB, WS_NU = 424 * MiB;
constexpr size_t WS_LW = 200 * MiB, WS_AA = 232 * MiB, WS_GG = 264 * MiB;
constexpr size_t WS_T1 = 200 * MiB, WS_T2 = 264 * MiB, WS_MP = 328 * MiB;
constexpr size_t WS_EGU = 136 * MiB, WS_EDN = 168 * MiB, WS_LOG = 184 * MiB, WS_XG = 200 * MiB, WS_H = 344 * MiB, WS_PB = 392 * MiB, WS_TP = 216 * MiB;
constexpr size_t WS_END = 456 * MiB;
constexpr int CW_TMO = 0, CW_BAR = 4096, CW_CNT = 16384, CW_NTILES = 16384 + 256;
constexpr int WIN_ROWS = 5632;
constexpr int RING_BYTES = 131072, MISC_OFF = RING_BYTES + 320, LDS_BYTES = 147456;

#define GAS __attribute__((address_space(1)))
#define LAS __attribute__((address_space(3)))
typedef unsigned short bf16;
typedef unsigned v4u __attribute__((ext_vector_type(4)));
typedef unsigned v2u __attribute__((ext_vector_type(2)));
typedef float f32x4 __attribute__((ext_vector_type(4)));
typedef float f32x16 __attribute__((ext_vector_type(16)));
typedef short bf16x8 __attribute__((ext_vector_type(8)));
typedef GAS unsigned gu32;
#define RLX_AGENT __ATOMIC_RELAXED, __HIP_MEMORY_SCOPE_AGENT
#define LDS_WAIT() asm volatile("s_waitcnt lgkmcnt(0)" ::: "memory")
#define VM_WAIT() asm volatile("s_waitcnt vmcnt(0)" ::: "memory")
#define MFMA32(a, b, c) __builtin_amdgcn_mfma_f32_32x32x16_bf16((a), (b), (c), 0, 0, 0)
__device__ __forceinline__ unsigned f2bf(float f) { unsigned u = __builtin_bit_cast(unsigned, f); return (u + 0x7fffu + ((u >> 16) & 1u)) >> 16; }
__device__ __forceinline__ unsigned pk2(float lo, float hi) { return pg8::cvt_pk_bf16(lo, hi); }
__device__ __forceinline__ float bflo(unsigned w) { return __uint_as_float(w << 16); }
__device__ __forceinline__ float bfhi(unsigned w) { return __uint_as_float(w & 0xffff0000u); }
__device__ __forceinline__ float sigm(float x) { return __builtin_amdgcn_rcpf(1.0f + __builtin_amdgcn_exp2f(-LOG2E * x)); }
__device__ __forceinline__ void unpack8(const v4u w, float (&f)[8]) { f[0] = bflo(w.x); f[1] = bfhi(w.x); f[2] = bflo(w.y); f[3] = bfhi(w.y); f[4] = bflo(w.z); f[5] = bfhi(w.z); f[6] = bflo(w.w); f[7] = bfhi(w.w); }
__device__ __forceinline__ v4u pack8(const float (&f)[8]) { v4u w; w.x = pk2(f[0], f[1]); w.y = pk2(f[2], f[3]); w.z = pk2(f[4], f[5]); w.w = pk2(f[6], f[7]); return w; }
template <int CTRL> __device__ __forceinline__ float dppf(float x) { return __builtin_bit_cast(float, __builtin_amdgcn_update_dpp(0, __builtin_bit_cast(int, x), CTRL, 0xF, 0xF, true)); }
__device__ __forceinline__ float red8(float x) { x += dppf<0xB1>(x); x += dppf<0x4E>(x); x += dppf<0x141>(x); return x; }
__device__ __forceinline__ float wave_sum(float v) {
#pragma unroll
    for (int o = 1; o < 64; o <<= 1) v += __shfl_xor(v, o);
    return v;
}
__device__ __forceinline__ int crow(int i, int hh) { return (i & 3) + 8 * (i >> 2) + 4 * hh; }
#define XB_TMO      128
#define XB_XCNT(j)  (256  + 64 * (j))
#define XB_XSUB(j)  (1280 + 64 * (j))
#define XB_XGEN(j)  (2304 + 64 * (j))
#define XB_TOP      3328
#define XB_TOPGEN   3392
#define XCD_BAR_WORDS 3456
#define XB_SPIN_CAP (1u << 18)

__device__ __forceinline__ unsigned xb_ld(unsigned* p)              { return __hip_atomic_load(p, __ATOMIC_RELAXED, __HIP_MEMORY_SCOPE_AGENT); }
__device__ __forceinline__ unsigned xb_add(unsigned* p, unsigned v) { return __hip_atomic_fetch_add(p, v, __ATOMIC_RELAXED, __HIP_MEMORY_SCOPE_AGENT); }
__device__ __forceinline__ unsigned xb_xcc_id() { return (unsigned)__builtin_amdgcn_s_getreg((3 << 11) | 20) & 0xFu; }
#define XB_SPIN(cond, bar) do { unsigned _sp = 0; while (cond) { __builtin_amdgcn_s_sleep(1); \
    if ((++_sp & 255u) == 0u) { if (xb_ld(&(bar)[XB_TMO])) break; if (_sp > XB_SPIN_CAP) { atomicAdd(&(bar)[XB_TMO], 1u); break; } } } } while (0)

struct XcdBarrier {
    unsigned* bar; unsigned x;
    volatile LAS unsigned* st;
};

__device__ __forceinline__ XcdBarrier xcd_barrier_post(unsigned* bar, volatile LAS unsigned* st) {
    XcdBarrier b; b.bar = bar; b.x = xb_xcc_id(); b.st = st;
    if (threadIdx.x == 0) (void)xb_add(&bar[XB_XCNT(b.x)], 1u);
    return b;
}
__device__ __forceinline__ void xcd_barrier_complete(unsigned* bar, unsigned x, unsigned& nloc, unsigned& nx) {
    const unsigned G = gridDim.x * gridDim.y * gridDim.z;
    unsigned sum, cnt, mine, sp = 0u;
    for (;;) {
        sum = 0u; cnt = 0u; mine = 0u;
#pragma unroll
        for (unsigned j = 0; j < 16; ++j) { const unsigned c = xb_ld(&bar[XB_XCNT(j)]); sum += c; cnt += (c > 0u) ? 1u : 0u; mine = (j == x) ? c : mine; }
        if (sum == G) break;
        __builtin_amdgcn_s_sleep(1);
        if ((++sp & 255u) == 0u) { if (xb_ld(&bar[XB_TMO])) break; if (sp > XB_SPIN_CAP) { atomicAdd(&bar[XB_TMO], 1u); break; } }
    }
    nloc = mine > 0u ? mine : 1u; nx = cnt > 0u ? cnt : 1u;
}

__device__ __forceinline__ void xcd_barrier(const XcdBarrier& b, const bool leader) {
    asm volatile("s_waitcnt vmcnt(0)" ::: "memory");
    __syncthreads();
    if (leader) {
        unsigned* bar = b.bar;
        __builtin_amdgcn_s_waitcnt(0);
        unsigned nloc = b.st[0], nx = b.st[1];
        if (nloc == 0u) { xcd_barrier_complete(bar, b.x, nloc, nx); b.st[0] = nloc; b.st[1] = nx; }
        const unsigned old = xb_add(&bar[XB_XSUB(b.x)], 1u);
        const unsigned gen = old / nloc;
        if (old + 1u == (gen + 1u) * nloc) {
            __builtin_amdgcn_fence(__ATOMIC_RELEASE, "agent");
            asm volatile("s_waitcnt vmcnt(0)" ::: "memory");
            const unsigned og = xb_add(&bar[XB_TOP], 1u);
            const unsigned tg = og / nx;
            if (og + 1u == (tg + 1u) * nx) xb_add(&bar[XB_TOPGEN], 1u);
            else XB_SPIN(xb_ld(&bar[XB_TOPGEN]) == tg, bar);
            __builtin_amdgcn_fence(__ATOMIC_ACQUIRE, "agent");
            xb_add(&bar[XB_XGEN(b.x)], 1u);
            asm volatile("s_waitcnt vmcnt(0)" ::: "memory");
        } else {
            XB_SPIN(xb_ld(&bar[XB_XGEN(b.x)]) == gen, bar);
            __builtin_amdgcn_fence(__ATOMIC_ACQUIRE, "agent");
            asm volatile("s_waitcnt vmcnt(0)" ::: "memory");
        }
    }
    __syncthreads();
}

__device__ __forceinline__ void transpose_item(const float* W, int ldw, int k0, int n0, bf16* WT, int ldk, int drow0, LAS float* scr, int lane) {
#pragma unroll 8
    for (int i = 0; i < 32; ++i) { const int kk = 2 * i + (lane >> 5); scr[kk * 33 + (lane & 31)] = W[(size_t)(k0 + kk) * ldw + n0 + (lane & 31)]; }
    LDS_WAIT(); asm volatile("" ::: "memory");
    const int c = lane & 7;
#pragma unroll
    for (int j = 0; j < 4; ++j) { const int n = (lane >> 3) + 8 * j; const LAS float* s = scr + (8 * c) * 33 + n;
        v4u o; o.x = pk2(s[0 * 33], s[1 * 33]); o.y = pk2(s[2 * 33], s[3 * 33]); o.z = pk2(s[4 * 33], s[5 * 33]); o.w = pk2(s[6 * 33], s[7 * 33]);
        *(GAS v4u*)(WT + (size_t)(drow0 + n) * ldk + k0 + 8 * c) = o; }
    LDS_WAIT(); asm volatile("" ::: "memory");
}

template <int MODE, bool WRITE_XB>
__device__ __forceinline__ void ln_pass(const float* src, float* dst, bf16* XB, const float* g, const float* b, const bf16* Y2, const int* TOKS, const float* TOKW, int gw, int NGW, int lane) {
    f32x4 gv[4], bv[4];
#pragma unroll
    for (int j = 0; j < 4; ++j) { gv[j] = *(const f32x4*)(g + 4 * lane + 256 * j); bv[j] = *(const f32x4*)(b + 4 * lane + 256 * j); }
    for (int m = gw; m < T; m += NGW) {
        const GAS f32x4* xr = (const GAS f32x4*)(src + (size_t)m * D) + lane;
        f32x4 v[4]; float s = 0.f;
#pragma unroll
        for (int j = 0; j < 4; ++j) v[j] = xr[64 * j];
        if (MODE == 2) {
            const int s1 = TOKS[2 * m], s2 = TOKS[2 * m + 1]; const float w1 = TOKW[2 * m], w2 = TOKW[2 * m + 1];
            const GAS v2u* y1 = (const GAS v2u*)(Y2 + (size_t)s1 * D) + lane; const GAS v2u* y2 = (const GAS v2u*)(Y2 + (size_t)s2 * D) + lane;
#pragma unroll
            for (int j = 0; j < 4; ++j) { const v2u a = y1[64 * j], c = y2[64 * j];
                v[j] = v[j] * ALPHA + w1 * (f32x4){bflo(a.x), bfhi(a.x), bflo(a.y), bfhi(a.y)} + w2 * (f32x4){bflo(c.x), bfhi(c.x), bflo(c.y), bfhi(c.y)}; }
        }
#pragma unroll
        for (int j = 0; j < 4; ++j) s += (v[j].x + v[j].y) + (v[j].z + v[j].w);
        const float mean = wave_sum(s) * (1.f / D); float s2 = 0.f;
#pragma unroll
        for (int j = 0; j < 4; ++j) { v[j] = v[j] - mean; s2 += (v[j].x * v[j].x + v[j].y * v[j].y) + (v[j].z * v[j].z + v[j].w * v[j].w); }
        const float rstd = 1.f / sqrtf(wave_sum(s2) * (1.f / D) + LN_EPS);
        GAS f32x4* o4 = (GAS f32x4*)(dst + (size_t)m * D) + lane;
        GAS v2u* o8 = (GAS v2u*)(XB + (size_t)m * D) + lane;
#pragma unroll
        for (int j = 0; j < 4; ++j) { const f32x4 y = v[j] * rstd * gv[j] + bv[j]; o4[64 * j] = y;
            if (WRITE_XB) { v2u w; w.x = pk2(y.x, y.y); w.y = pk2(y.z, y.w); o8[64 * j] = w; } }
    }
}

__device__ __forceinline__ void attn_phase(LAS unsigned char* lds, const bf16* QK, const bf16* VT, bf16* YA, const float* rel_bias, int vcu, int G, int tid) {
    LAS float* bl = (LAS float*)lds;
    for (int i = tid; i < 8 * 257; i += NWAVES * 64) bl[i] = rel_bias[i] * LOG2E;
    __syncthreads();
    const int h = __builtin_amdgcn_readfirstlane(tid >> 6), lane = tid & 63, r = lane & 31, hh = lane >> 5;
    const int pr = 16 * ((r >> 2) & 1) + (r & 3) + 4 * (r >> 3);
    const float C1 = 0.125f * LOG2E;
    const float b256 = bl[h * 257 + 256];
    for (int unit = vcu; unit < 512; unit += G) {
        const int b = unit >> 5, c = unit & 31;
        const size_t rowQ = (size_t)b * SEQ + (size_t)c * 64;
        const bf16* Qp = QK + rowQ * 1024 + h * 64;
        const bf16* Kb = QK + (size_t)b * SEQ * 1024 + 512 + h * 64;
        const bf16* Vb = VT + (size_t)(h * 64) * T + (size_t)b * SEQ;
        bf16x8 qf[2][4];
#pragma unroll
        for (int qb = 0; qb < 2; ++qb)
#pragma unroll
            for (int kk = 0; kk < 4; ++kk) qf[qb][kk] = *(const bf16x8*)(Qp + (size_t)(qb * 32 + r) * 1024 + 16 * kk + 8 * hh);
        f32x16 o[2][2];
#pragma unroll
        for (int a = 0; a < 2; ++a)
#pragma unroll
            for (int q = 0; q < 2; ++q)
#pragma unroll
                for (int i = 0; i < 16; ++i) o[a][q][i] = 0.f;
        float mrun[2] = {-INFINITY, -INFINITY}, lrun[2] = {0.f, 0.f};
        const int kt0 = c >= 8 ? 0 : (8 - c) * 2;
        for (int kt = kt0; kt < 18; ++kt) {
            const int tk0 = (c - 8) * 64 + 32 * kt;
            bf16x8 kf[4], vf[2][2];
#pragma unroll
            for (int kk = 0; kk < 4; ++kk) kf[kk] = *(const bf16x8*)(Kb + (size_t)(tk0 + pr) * 1024 + 16 * kk + 8 * hh);
#pragma unroll
            for (int db = 0; db < 2; ++db)
#pragma unroll
                for (int st = 0; st < 2; ++st) vf[db][st] = *(const bf16x8*)(Vb + (size_t)(db * 32 + r) * T + tk0 + 16 * hh + 8 * st);
            bf16x8 pf[2][2];
#pragma unroll
            for (int qb = 0; qb < 2; ++qb) {
                f32x16 s;
#pragma unroll
                for (int i = 0; i < 16; ++i) s[i] = 0.f;
#pragma unroll
                for (int kk = 0; kk < 4; ++kk) s = MFMA32(kf[kk], qf[qb][kk], s);
                float t[16];
                if (kt < 12) {
#pragma unroll
                    for (int i = 0; i < 16; ++i) t[i] = s[i] * C1 + b256;
                } else {
                    const int dbase = 512 + qb * 32 + r - (32 * kt + 16 * hh);
#pragma unroll
                    for (int i = 0; i < 16; ++i) { int dist = dbase - i; dist = dist > 128 ? 128 : dist; dist = dist < -128 ? -128 : dist; t[i] = s[i] * C1 + bl[h * 257 + dist + 128]; }
                }
                float ml = t[0];
#pragma unroll
                for (int i = 1; i < 16; ++i) ml = fmaxf(ml, t[i]);
                ml = fmaxf(ml, __shfl_xor(ml, 32));
                const float mnew = fmaxf(mrun[qb], ml), al = __builtin_amdgcn_exp2f(mrun[qb] - mnew);
                mrun[qb] = mnew;
                float ls = 0.f;
#pragma unroll
                for (int i = 0; i < 16; ++i) { t[i] = __builtin_amdgcn_exp2f(t[i] - mnew); ls += t[i]; }
                lrun[qb] = lrun[qb] * al + ls;
#pragma unroll
                for (int i = 0; i < 16; ++i) { o[0][qb][i] *= al; o[1][qb][i] *= al; }
#pragma unroll
                for (int st = 0; st < 2; ++st) { v4u w; w.x = pk2(t[8 * st + 0], t[8 * st + 1]); w.y = pk2(t[8 * st + 2], t[8 * st + 3]); w.z = pk2(t[8 * st + 4], t[8 * st + 5]); w.w = pk2(t[8 * st + 6], t[8 * st + 7]);
                    pf[qb][st] = __builtin_bit_cast(bf16x8, w); }
            }
#pragma unroll
            for (int db = 0; db < 2; ++db)
#pragma unroll
                for (int qb = 0; qb < 2; ++qb)
#pragma unroll
                    for (int st = 0; st < 2; ++st) o[db][qb] = MFMA32(vf[db][st], pf[qb][st], o[db][qb]);
        }
#pragma unroll
        for (int qb = 0; qb < 2; ++qb) {
            const float l = lrun[qb] + __shfl_xor(lrun[qb], 32), inv = 1.f / l;
            bf16* orow = YA + (rowQ + qb * 32 + r) * 512 + h * 64;
#pragma unroll
            for (int db = 0; db < 2; ++db)
#pragma unroll
                for (int g4 = 0; g4 < 4; ++g4) { v2u w; w.x = pk2(o[db][qb][4 * g4] * inv, o[db][qb][4 * g4 + 1] * inv); w.y = pk2(o[db][qb][4 * g4 + 2] * inv, o[db][qb][4 * g4 + 3] * inv);
                    *(GAS v2u*)(orow + db * 32 + 8 * g4 + 4 * hh) = w; }
        }
    }
}

struct PrepArgs { const bf16* RKVL; bf16 *LW, *AA, *GG, *NU; const float* mu; const float *decay_base, *aaa_base, *vres_base; const bf16 *DUT, *AUT, *GUT, *VDT, *VUT; int layer; };
constexpr int PA_STRIDE = 592, PV_STRIDE = 1040, PD_STRIDE = 80;
constexpr int PREP_A = 0, PREP_V = 38912, PREP_D = PREP_V + 64 * PV_STRIDE;
template <int KS> __device__ __forceinline__ void prep_mm(f32x16 (&acc)[2][2], const LAS unsigned char* Abase, int astride, int acol0, const bf16* W, int Kw, int hd, int r, int hh) {
#pragma unroll
    for (int a = 0; a < 2; ++a)
#pragma unroll
        for (int b = 0; b < 2; ++b)
#pragma unroll
            for (int i = 0; i < 16; ++i) acc[a][b][i] = 0.f;
#pragma unroll
    for (int ks = 0; ks < KS; ++ks) {
        bf16x8 af[2], bfr[2];
#pragma unroll
        for (int mb = 0; mb < 2; ++mb) af[mb] = *(const LAS bf16x8*)(Abase + (mb * 32 + r) * astride + (acol0 + 16 * ks + 8 * hh) * 2);
#pragma unroll
        for (int nb = 0; nb < 2; ++nb) bfr[nb] = *(const bf16x8*)(W + (size_t)(64 * hd + nb * 32 + r) * Kw + 16 * ks + 8 * hh);
#pragma unroll
        for (int mb = 0; mb < 2; ++mb)
#pragma unroll
            for (int nb = 0; nb < 2; ++nb) acc[mb][nb] = MFMA32(af[mb], bfr[nb], acc[mb][nb]);
    }
}
template <int MODE> __device__ __forceinline__ void prep_store(const f32x16 (&acc)[2][2], bf16* OUT, const float* base, int t0g, int hd, int r, int hh) {
#pragma unroll
    for (int nb = 0; nb < 2; ++nb) { const int col = 64 * hd + nb * 32 + r; const float bs = MODE == 2 ? 0.f : base[col];
#pragma unroll
        for (int mb = 0; mb < 2; ++mb)
#pragma unroll
            for (int i = 0; i < 16; ++i) { float v = acc[mb][nb][i]; if (MODE == 0) v = -0.60653066f * sigm(v + bs); if (MODE == 1) v = sigm(v + bs);
                OUT[(size_t)(t0g + mb * 32 + crow(i, hh)) * 512 + col] = (bf16)f2bf(v); } }
}
__device__ __forceinline__ void prep_phase(LAS unsigned char* lds, const PrepArgs& P, int vcu, int G, int tid) {
    const int hd = __builtin_amdgcn_readfirstlane(tid >> 6), lane = tid & 63, r = lane & 31, hh = lane >> 5;
    for (int unit = vcu; unit < 512; unit += G) {
        const int t0g = unit * 64, s0 = t0g & (SEQ - 1);
        for (int i = tid; i < 64 * 36; i += NWAVES * 64) { const int tok = i / 36, ch = i - tok * 36; const size_t row = (size_t)t0g + tok;
            const v4u cu = *(const GAS v4u*)(P.RKVL + row * 2048 + 1536 + 8 * ch);
            v4u pv = (v4u){0u, 0u, 0u, 0u}; if (s0 + tok > 0) pv = *(const GAS v4u*)(P.RKVL + (row - 1) * 2048 + 1536 + 8 * ch);
            float c8[8], p8[8], o8[8]; unpack8(cu, c8); unpack8(pv, p8);
            const float* mu = P.mu + 1536 + 8 * ch;
#pragma unroll
            for (int j = 0; j < 8; ++j) { float x = c8[j] + (p8[j] - c8[j]) * mu[j];
                if (ch < 8) x = 2.f * sigm(2.f * x) - 1.f; else if (ch >= 16) x = sigm(x);
                o8[j] = x; }
            *(LAS v4u*)(lds + PREP_A + tok * PA_STRIDE + 16 * ch) = pack8(o8); }
        if (P.layer == 1) {
            for (int i = tid; i < 64 * 64; i += NWAVES * 64) { const int tok = i >> 6, ch = i & 63; const size_t row = (size_t)t0g + tok;
                const v4u cu = *(const GAS v4u*)(P.RKVL + row * 2048 + 1024 + 8 * ch);
                v4u pv = (v4u){0u, 0u, 0u, 0u}; if (s0 + tok > 0) pv = *(const GAS v4u*)(P.RKVL + (row - 1) * 2048 + 1024 + 8 * ch);
                float c8[8], p8[8], o8[8]; unpack8(cu, c8); unpack8(pv, p8);
                const float* mu = P.mu + 1024 + 8 * ch;
#pragma unroll
                for (int j = 0; j < 8; ++j) o8[j] = c8[j] + (p8[j] - c8[j]) * mu[j];
                *(LAS v4u*)(lds + PREP_V + tok * PV_STRIDE + 16 * ch) = pack8(o8); }
        }
        __syncthreads();
        f32x16 acc[2][2];
        prep_mm<4>(acc, lds + PREP_A, PA_STRIDE, 0, P.DUT, 64, hd, r, hh);    prep_store<0>(acc, P.LW, P.decay_base, t0g, hd, r, hh);
        prep_mm<4>(acc, lds + PREP_A, PA_STRIDE, 64, P.AUT, 64, hd, r, hh);   prep_store<1>(acc, P.AA, P.aaa_base, t0g, hd, r, hh);
        prep_mm<10>(acc, lds + PREP_A, PA_STRIDE, 128, P.GUT, 160, hd, r, hh); prep_store<2>(acc, P.GG, nullptr, t0g, hd, r, hh);
        if (P.layer == 1) {
            if (hd < 2) {
                f32x16 a1;
#pragma unroll
                for (int i = 0; i < 16; ++i) a1[i] = 0.f;
#pragma unroll 4
                for (int ks = 0; ks < 32; ++ks) {
                    const bf16x8 af = *(const LAS bf16x8*)(lds + PREP_V + (hd * 32 + r) * PV_STRIDE + (16 * ks + 8 * hh) * 2);
                    const bf16x8 bfr = *(const bf16x8*)(P.VDT + (size_t)r * 512 + 16 * ks + 8 * hh);
                    a1 = MFMA32(af, bfr, a1);
                }
#pragma unroll
                for (int i = 0; i < 16; ++i) *(LAS bf16*)(lds + PREP_D + (hd * 32 + crow(i, hh)) * PD_STRIDE + 2 * r) = (bf16)f2bf(a1[i]);
            }
            __syncthreads();
            prep_mm<2>(acc, lds + PREP_D, PD_STRIDE, 0, P.VUT, 32, hd, r, hh); prep_store<1>(acc, P.NU, P.vres_base, t0g, hd, r, hh);
        }
        __syncthreads();
    }
}

struct ScanArgs { const bf16* RKVL; const bf16 *LW, *AA, *GG, *NU; bf16* VF; bf16* YB; const float* mu; const float *k_k, *k_a, *r_k, *gn_g, *gn_b; int layer; };
constexpr int SC_W = 0, SC_A = 16384, SC_B = 32768, SC_K = 49152, SC_R = 65536, SC_V = 81920, SC_Y = 98304, SC_RK = 114688, SC_TAB = 114944;
__device__ __forceinline__ void scan_phase(LAS unsigned char* lds, const ScanArgs& P, int unit, int tid) {
    const int b = unit >> 3, h = unit & 7;
    const int i = tid >> 3, c8 = tid & 7;
    LAS float* tab = (LAS float*)(lds + SC_TAB);
    if (tid < 64) {
        tab[0 * 64 + tid] = P.mu[h * 64 + tid]; tab[1 * 64 + tid] = P.mu[512 + h * 64 + tid]; tab[2 * 64 + tid] = P.mu[1024 + h * 64 + tid];
        tab[3 * 64 + tid] = P.k_k[h * 64 + tid]; tab[4 * 64 + tid] = P.k_a[h * 64 + tid]; tab[5 * 64 + tid] = P.r_k[h * 64 + tid];
        tab[6 * 64 + tid] = P.gn_g[h * 64 + tid]; tab[7 * 64 + tid] = P.gn_b[h * 64 + tid];
    }
    __syncthreads();
    float mur[8], muk[8], muv[8], kkw[8], kaw[8], rkw[8];
#pragma unroll
    for (int j = 0; j < 8; ++j) { mur[j] = tab[8 * c8 + j]; muk[j] = tab[64 + 8 * c8 + j]; muv[j] = tab[128 + 8 * c8 + j]; kkw[j] = tab[192 + 8 * c8 + j]; kaw[j] = tab[256 + 8 * c8 + j]; rkw[j] = tab[320 + 8 * c8 + j]; }
    float S[8];
#pragma unroll
    for (int j = 0; j < 8; ++j) S[j] = 0.f;
    const size_t row0 = (size_t)b * SEQ;
    const int hc = h * 64 + 8 * c8;
    for (int tile = 0; tile < SEQ / 64; ++tile) {
        {
            const int tok = i, s = tile * 64 + tok; const size_t row = row0 + s;
            const bf16* rp = P.RKVL + row * 2048;
            const v4u rc = *(const GAS v4u*)(rp + hc), kc = *(const GAS v4u*)(rp + 512 + hc), vc = *(const GAS v4u*)(rp + 1024 + hc);
            v4u rpv = (v4u){0u, 0u, 0u, 0u}, kpv = rpv, vpv = rpv;
            if (s > 0) { rpv = *(const GAS v4u*)(rp - 2048 + hc); kpv = *(const GAS v4u*)(rp - 2048 + 512 + hc); vpv = *(const GAS v4u*)(rp - 2048 + 1024 + hc); }
            const v4u lwv = *(const GAS v4u*)(P.LW + row * 512 + hc), aav = *(const GAS v4u*)(P.AA + row * 512 + hc);
            float r8[8], rp8[8], k8[8], kp8[8], v8[8], vp8[8], lw8[8], a8[8];
            unpack8(rc, r8); unpack8(rpv, rp8); unpack8(kc, k8); unpack8(kpv, kp8); unpack8(vc, v8); unpack8(vpv, vp8); unpack8(lwv, lw8); unpack8(aav, a8);
            float kk[8], ss = 0.f, rk = 0.f, wv[8], av[8], bv[8], kv[8], rv[8], vv[8];
#pragma unroll
            for (int j = 0; j < 8; ++j) { rv[j] = r8[j] + (rp8[j] - r8[j]) * mur[j]; const float ks = k8[j] + (kp8[j] - k8[j]) * muk[j];
                kk[j] = ks * kkw[j]; ss += kk[j] * kk[j]; kv[j] = ks * (1.f + (a8[j] - 1.f) * kaw[j]); rk += rv[j] * kv[j] * rkw[j];
                wv[j] = __builtin_amdgcn_exp2f(lw8[j] * LOG2E); vv[j] = v8[j] + (vp8[j] - v8[j]) * muv[j]; }
            ss = red8(ss); rk = red8(rk);
            const float rn = __builtin_amdgcn_rsqf(fmaxf(ss, 1e-24f));
#pragma unroll
            for (int j = 0; j < 8; ++j) { const float kn = kk[j] * rn; av[j] = -kn; bv[j] = kn * a8[j]; }
            if (P.layer == 0) { *(GAS v4u*)(P.VF + row * 512 + hc) = pack8(vv); }
            else { const v4u nuv = *(const GAS v4u*)(P.NU + row * 512 + hc), vfv = *(const GAS v4u*)(P.VF + row * 512 + hc); float nu8[8], vf8[8]; unpack8(nuv, nu8); unpack8(vfv, vf8);
#pragma unroll
                for (int j = 0; j < 8; ++j) vv[j] = vv[j] + (vf8[j] - vv[j]) * nu8[j]; }
            const int o = tok * 256 + c8 * 32;
            *(LAS f32x4*)(lds + SC_W + o) = (f32x4){wv[0], wv[1], wv[2], wv[3]}; *(LAS f32x4*)(lds + SC_W + o + 16) = (f32x4){wv[4], wv[5], wv[6], wv[7]};
            *(LAS f32x4*)(lds + SC_A + o) = (f32x4){av[0], av[1], av[2], av[3]}; *(LAS f32x4*)(lds + SC_A + o + 16) = (f32x4){av[4], av[5], av[6], av[7]};
            *(LAS f32x4*)(lds + SC_B + o) = (f32x4){bv[0], bv[1], bv[2], bv[3]}; *(LAS f32x4*)(lds + SC_B + o + 16) = (f32x4){bv[4], bv[5], bv[6], bv[7]};
            *(LAS f32x4*)(lds + SC_K + o) = (f32x4){kv[0], kv[1], kv[2], kv[3]}; *(LAS f32x4*)(lds + SC_K + o + 16) = (f32x4){kv[4], kv[5], kv[6], kv[7]};
            *(LAS f32x4*)(lds + SC_R + o) = (f32x4){rv[0], rv[1], rv[2], rv[3]}; *(LAS f32x4*)(lds + SC_R + o + 16) = (f32x4){rv[4], rv[5], rv[6], rv[7]};
            *(LAS f32x4*)(lds + SC_V + o) = (f32x4){vv[0], vv[1], vv[2], vv[3]}; *(LAS f32x4*)(lds + SC_V + o + 16) = (f32x4){vv[4], vv[5], vv[6], vv[7]};
            if (c8 == 0) *(LAS float*)(lds + SC_RK + tok * 4) = rk;
        }
        __syncthreads();
#pragma unroll 4
        for (int tk = 0; tk < 64; ++tk) {
            const int o = tk * 256 + c8 * 32;
            const f32x4 w0 = *(const LAS f32x4*)(lds + SC_W + o), w1 = *(const LAS f32x4*)(lds + SC_W + o + 16);
            const f32x4 a0 = *(const LAS f32x4*)(lds + SC_A + o), a1 = *(const LAS f32x4*)(lds + SC_A + o + 16);
            const f32x4 b0 = *(const LAS f32x4*)(lds + SC_B + o), b1 = *(const LAS f32x4*)(lds + SC_B + o + 16);
            const f32x4 k0 = *(const LAS f32x4*)(lds + SC_K + o), k1 = *(const LAS f32x4*)(lds + SC_K + o + 16);
            const f32x4 r0 = *(const LAS f32x4*)(lds + SC_R + o), r1 = *(const LAS f32x4*)(lds + SC_R + o + 16);
            const float vi = *(const LAS float*)(lds + SC_V + tk * 256 + i * 4);
            float sa = (S[0] * a0[0] + S[1] * a0[1]) + (S[2] * a0[2] + S[3] * a0[3]) + ((S[4] * a1[0] + S[5] * a1[1]) + (S[6] * a1[2] + S[7] * a1[3]));
            sa = red8(sa);
#pragma unroll
            for (int j = 0; j < 4; ++j) { S[j] = S[j] * w0[j] + (sa * b0[j] + vi * k0[j]); S[4 + j] = S[4 + j] * w1[j] + (sa * b1[j] + vi * k1[j]); }
            float y = (S[0] * r0[0] + S[1] * r0[1]) + (S[2] * r0[2] + S[3] * r0[3]) + ((S[4] * r1[0] + S[5] * r1[1]) + (S[6] * r1[2] + S[7] * r1[3]));
            y = red8(y);
            if (c8 == 0) *(LAS float*)(lds + SC_Y + tk * 256 + i * 4) = y;
        }
        __syncthreads();
        {
            const int tok = i; const size_t row = row0 + tile * 64 + tok;
            const f32x4 y0 = *(const LAS f32x4*)(lds + SC_Y + tok * 256 + c8 * 32), y1 = *(const LAS f32x4*)(lds + SC_Y + tok * 256 + c8 * 32 + 16);
            const f32x4 v0 = *(const LAS f32x4*)(lds + SC_V + tok * 256 + c8 * 32), v1 = *(const LAS f32x4*)(lds + SC_V + tok * 256 + c8 * 32 + 16);
            const float rk = *(const LAS float*)(lds + SC_RK + tok * 4);
            const v4u gv = *(const GAS v4u*)(P.GG + row * 512 + hc); float g8[8]; unpack8(gv, g8);
            float yy[8] = {y0[0], y0[1], y0[2], y0[3], y1[0], y1[1], y1[2], y1[3]}, vv[8] = {v0[0], v0[1], v0[2], v0[3], v1[0], v1[1], v1[2], v1[3]};
            float sm = 0.f;
#pragma unroll
            for (int j = 0; j < 8; ++j) sm += yy[j];
            const float mean = red8(sm) * (1.f / 64.f); float sq = 0.f;
#pragma unroll
            for (int j = 0; j < 8; ++j) { yy[j] -= mean; sq += yy[j] * yy[j]; }
            const float rstd = __builtin_amdgcn_rsqf(red8(sq) * (1.f / 64.f) + GN_EPS);
            float o8[8];
#pragma unroll
            for (int j = 0; j < 8; ++j) o8[j] = (yy[j] * rstd * tab[384 + 8 * c8 + j] + tab[448 + 8 * c8 + j] + rk * vv[j]) * g8[j];
            *(GAS v4u*)(P.YB + row * 512 + hc) = pack8(o8);
        }
        __syncthreads();
    }
}

__device__ __forceinline__ void route_phase(const float* LOG, unsigned* cnt, int* TOKE, int* TOKP, float* TOKW, int gt, int NT) {
    for (int m = gt; m < T; m += NT) {
        const float* lg = LOG + (size_t)m * 64;
        const f32x4 gl = *(const f32x4*)lg;
        int grp = 0; float gm = gl[0];
        if (gl[1] > gm) { gm = gl[1]; grp = 1; } if (gl[2] > gm) { gm = gl[2]; grp = 2; } if (gl[3] > gm) { gm = gl[3]; grp = 3; }
        const float se = __expf(gl[0] - gm) + __expf(gl[1] - gm) + __expf(gl[2] - gm) + __expf(gl[3] - gm);
        const float gate = 1.f / se;
        const f32x4 e0 = *(const f32x4*)(lg + 4 + grp * 8), e1 = *(const f32x4*)(lg + 8 + grp * 8);
        const float v[8] = {e0[0], e0[1], e0[2], e0[3], e1[0], e1[1], e1[2], e1[3]};
        int i0 = 0; float v0 = v[0];
#pragma unroll
        for (int j = 1; j < 8; ++j) if (v[j] > v0) { v0 = v[j]; i0 = j; }
        int i1 = -1; float v1 = -INFINITY;
#pragma unroll
        for (int j = 0; j < 8; ++j) if (j != i0 && (i1 < 0 || v[j] > v1)) { v1 = v[j]; i1 = j; }
        const float w0 = 1.f / (1.f + __expf(v1 - v0)), w1 = 1.f - w0;
        const int x0 = grp * 8 + i0, x1 = grp * 8 + i1;
        const unsigned p0 = __hip_atomic_fetch_add(cnt + x0, 1u, RLX_AGENT), p1 = __hip_atomic_fetch_add(cnt + x1, 1u, RLX_AGENT);
        TOKE[2 * m] = x0; TOKE[2 * m + 1] = x1; TOKP[2 * m] = (int)p0; TOKP[2 * m + 1] = (int)p1; TOKW[2 * m] = w0 * gate; TOKW[2 * m + 1] = w1 * gate;
    }
}
__device__ __forceinline__ void gather_phase(LAS unsigned char* lds, unsigned* cnt, unsigned* ntiles_w, int* TILE_E, const int* TOKE, const int* TOKP, int* TOKS, const bf16* XB, bf16* XG, int bx, int gw, int NGW, int tid) {
    LAS int* offs = (LAS int*)lds;
    if (tid == 0) { int o = 0; for (int e = 0; e < 32; ++e) { offs[e] = o; const unsigned c = __hip_atomic_load(cnt + e, RLX_AGENT); o += (int)((c + 255u) & ~255u); } offs[32] = o; }
    __syncthreads();
    if (bx == 0) { const int nt = offs[32] >> 8;
        for (int rt = tid; rt < nt; rt += NWAVES * 64) { int e = 0; while (e < 31 && offs[e + 1] <= rt * 256) ++e; TILE_E[rt] = e; }
        if (tid == 0) __hip_atomic_store(ntiles_w, (unsigned)nt, RLX_AGENT); }
    const int lane = tid & 63;
    for (int m = gw; m < T; m += NGW) {
        const int s0 = offs[TOKE[2 * m]] + TOKP[2 * m], s1 = offs[TOKE[2 * m + 1]] + TOKP[2 * m + 1];
        const GAS v4u* src = (const GAS v4u*)(XB + (size_t)m * D) + lane; const v4u a = src[0], c = src[64];
        GAS v4u* d0 = (GAS v4u*)(XG + (size_t)s0 * D) + lane; GAS v4u* d1 = (GAS v4u*)(XG + (size_t)s1 * D) + lane;
        d0[0] = a; d0[64] = c; d1[0] = a; d1[64] = c;
        if (lane == 0) { TOKS[2 * m] = s0; TOKS[2 * m + 1] = s1; }
    }
}

#ifndef MK_N_LAUNCHES
#define MK_N_LAUNCHES 31
#endif
constexpr int N_PHASES = 31;
struct Args { const float* in[34]; float* out; unsigned char* ws; int ph_lo, ph_hi; };
enum { I_X = 0, I_P, I_LNIN_G, I_LNIN_B, I_RELB, I_WIN, I_TOKMIX, I_DECB, I_DECUP, I_AAAB, I_AAAUP, I_GATEUP, I_KK, I_KA, I_RK, I_VRB, I_VRD, I_VRU, I_GNG, I_GNB,
       I_WBA, I_WBR, I_WOUT, I_RG, I_RGB, I_RE, I_REB, I_EG, I_EU, I_ED, I_PLEP, I_PLEG, I_LNG, I_LNB };

#ifndef EN_MASK
#define EN_MASK 0xFFFF
#endif
#define EN(k) (((EN_MASK) >> (k)) & 1)
#define IN(k) (lo <= (k) && (k) < hi)
#define SEAM(k) do { if (IN((k) + 1)) { XcdBarrier b_; b_.bar = (unsigned*)(ctl + CW_BAR); b_.x = xb_xcc_id(); b_.st = (volatile LAS unsigned*)(lds + MISC_OFF) + 8; xcd_barrier(b_, tid == 0); } } while (0)
#define PH_IDS \
    int tid = wv * 64 + (int)__builtin_amdgcn_mbcnt_hi(~0u, __builtin_amdgcn_mbcnt_lo(~0u, 0u)); asm volatile("" : "+v"(tid)); int bx = blockIdx.x, G = gridDim.x; asm volatile("" : "+s"(bx), "+s"(G)); \
    const int lane = tid & 63, wave = wv; \
    const int vcu = (G % 8 == 0) ? (bx % 8) * (G / 8) + bx / 8 : bx; \
    const int gw = bx * NWAVES + wave, NGW = G * NWAVES, gt = bx * (NWAVES * 64) + tid, NT = G * NWAVES * 64; \
    unsigned char* ws = args.ws; float* xres = args.out; bf16* XB = (bf16*)(ws + WS_XB); gu32* ctl = (gu32*)(ws + WS_CTL); \
    (void)lane; (void)wave; (void)vcu; (void)gw; (void)NGW; (void)gt; (void)NT; (void)xres; (void)XB; (void)ctl;
#define AIN(i) (args.in[i])
template <int l> __device__ __forceinline__ void layer_body(const Args& args, LAS unsigned char* lds, const int lo, const int hi, const int wv) {

        constexpr int pb = 1 + 15 * l;
#define wb (ws + WS_WNE + (size_t)l * WNE_LAYER)
#define WinT ((const bf16*)(wb + WNE_WIN))
        if (EN(1) && IN(pb + 0)) { PH_IDS
            { pg8::Gemm g{XB, WinT, T, 1024, 1024}; pg8::StaticOrder S; S.init(T, 1024, G, bx); pg8::EpiStore E{(bf16*)(ws + WS_QK), 1024, 1 << 30};
              pg8::gemm_phase<pg8::EpiStore, pg8::StaticOrder, true, true>(lds, g, S, E, wv); }
            { pg8::Gemm g{XB, WinT + (size_t)1536 * 1024, T, 2048, 1024}; pg8::StaticOrder S; S.init(T, 2048, G, bx); pg8::EpiStore E{(bf16*)(ws + WS_RKVL), 2048, 1 << 30};
              pg8::gemm_phase<pg8::EpiStore, pg8::StaticOrder, true, true>(lds, g, S, E, wv); }
            { pg8::Gemm g{WinT + (size_t)1024 * 1024, XB, 512, T, 1024}; pg8::StaticOrder S; S.init(512, T, G, bx); pg8::EpiStore E{(bf16*)(ws + WS_VT), T, 1 << 30};
              pg8::gemm_phase<pg8::EpiStore, pg8::StaticOrder, true, true>(lds, g, S, E, wv); }
            SEAM(pb + 0);
        }
        if (EN(2) && IN(pb + 1)) { PH_IDS
#ifndef DIS_ATTN
 attn_phase(lds, (const bf16*)(ws + WS_QK), (const bf16*)(ws + WS_VT), (bf16*)(ws + WS_YA), AIN(I_RELB), vcu, G, tid);
#endif
 SEAM(pb + 1); }
        if (EN(3) && IN(pb + 2)) { PH_IDS
            PrepArgs P{(const bf16*)(ws + WS_RKVL), (bf16*)(ws + WS_LW), (bf16*)(ws + WS_AA), (bf16*)(ws + WS_GG), (bf16*)(ws + WS_NU), AIN(I_TOKMIX) + l * 1824,
                       AIN(I_DECB) + l * 512, AIN(I_AAAB) + l * 512, AIN(I_VRB), (const bf16*)(ws + WS_DUT) + l * 32768, (const bf16*)(ws + WS_AUT) + l * 32768,
                       (const bf16*)(ws + WS_GUT) + l * 81920, (const bf16*)(ws + WS_VDT), (const bf16*)(ws + WS_VUT), l};
#ifndef DIS_PREP
            prep_phase(lds, P, vcu, G, tid);
#endif
 SEAM(pb + 2);
        }
        if (EN(4) && IN(pb + 3)) { PH_IDS
            if (bx < 128) { ScanArgs P{(const bf16*)(ws + WS_RKVL), (const bf16*)(ws + WS_LW), (const bf16*)(ws + WS_AA), (const bf16*)(ws + WS_GG), (const bf16*)(ws + WS_NU), (bf16*)(ws + WS_VF), (bf16*)(ws + WS_YB),
                            AIN(I_TOKMIX) + l * 1824, AIN(I_KK) + l * 512, AIN(I_KA) + l * 512, AIN(I_RK) + l * 512, AIN(I_GNG) + l * 512, AIN(I_GNB) + l * 512, l};

#ifndef DIS_SCAN
                scan_phase(lds, P, bx, tid);
#endif
 }
            SEAM(pb + 3);
        }
        if (EN(5) && IN(pb + 4)) { PH_IDS
            bf16* T1 = (bf16*)(ws + WS_T1); bf16* T2 = (bf16*)(ws + WS_T2); bf16* MP = (bf16*)(ws + WS_MP);
            { pg8::Gemm g{(const bf16*)(ws + WS_YA), (const bf16*)(wb + WNE_WBA), T, 1024, 512}; pg8::StaticOrder S; S.init(T, 1024, G, bx); pg8::EpiStore E{T1, 1024, 1 << 30};
              pg8::gemm_phase<pg8::EpiStore, pg8::StaticOrder, true, true>(lds, g, S, E, wv); }
            { pg8::Gemm g{XB, WinT + (size_t)3584 * 1024, T, 1024, 1024}; pg8::StaticOrder S; S.init(T, 1024, G, bx); pg8::EpiGate<0> E{T1, nullptr, T1, 1024};
              pg8::gemm_phase<pg8::EpiGate<0>, pg8::StaticOrder, true, true>(lds, g, S, E, wv); }
            { pg8::Gemm g{(const bf16*)(ws + WS_YB), (const bf16*)(wb + WNE_WBR), T, 1024, 512}; pg8::StaticOrder S; S.init(T, 1024, G, bx); pg8::EpiStore E{T2, 1024, 1 << 30};
              pg8::gemm_phase<pg8::EpiStore, pg8::StaticOrder, true, true>(lds, g, S, E, wv); }
            { pg8::Gemm g{XB, WinT + (size_t)4608 * 1024, T, 1024, 1024}; pg8::StaticOrder S; S.init(T, 1024, G, bx); pg8::EpiGate<1> E{T1, T2, MP, 1024};
              pg8::gemm_phase<pg8::EpiGate<1>, pg8::StaticOrder, true, true>(lds, g, S, E, wv); }
            SEAM(pb + 4);
        }
        if (EN(6) && IN(pb + 5)) { PH_IDS
            pg8::Gemm g{(const bf16*)(ws + WS_MP), (const bf16*)(wb + WNE_WOUT), T, 1024, 1024}; pg8::StaticOrder S; S.init(T, 1024, G, bx); pg8::EpiRes<0> E{xres, nullptr, 1024, ALPHA};
            pg8::gemm_phase<pg8::EpiRes<0>, pg8::StaticOrder, true, true>(lds, g, S, E, wv);
            SEAM(pb + 5);
        }
        if (EN(7) && IN(pb + 6)) { PH_IDS
            ln_pass<0, true>(xres, xres, XB, AIN(I_LNG) + (l * 3 + 0) * 1024, AIN(I_LNB) + (l * 3 + 0) * 1024, nullptr, nullptr, nullptr, gw, NGW, lane);
            LAS float* scr = (LAS float*)(lds + wave * 16384);
            bf16* EGU = (bf16*)(ws + WS_EGU); bf16* EDN = (bf16*)(ws + WS_EDN);
            for (int it = gw; it < 3 * 4096; it += NGW) {
                const int which = it >> 12, r = it & 4095, e = r >> 7, rr = r & 127;
                if (which < 2) { const int kb = rr >> 3, nb = rr & 7, n0 = 32 * nb;
                    transpose_item(AIN(which == 0 ? I_EG : I_EU) + ((size_t)(l * 32 + e) << 18), 256, 64 * kb, n0, EGU, 1024, e * 512 + (n0 >> 7) * 256 + which * 128 + (n0 & 127), scr, lane); }
                else { const int kb = rr >> 5, nb = rr & 31; transpose_item(AIN(I_ED) + ((size_t)(l * 32 + e) << 18), 1024, 64 * kb, 32 * nb, EDN, 256, e * 1024 + 32 * nb, scr, lane); }
            }
            { const float* psrc = AIN(I_P) + (size_t)l * T * 256; bf16* PB = (bf16*)(ws + WS_PB);
              for (int i = gt; i < T * 256 / 4; i += NT) { const f32x4 v = *(const GAS f32x4*)(psrc + (size_t)i * 4); v2u w; w.x = pk2(v.x, v.y); w.y = pk2(v.z, v.w); *(GAS v2u*)(PB + (size_t)i * 4) = w; } }
            SEAM(pb + 6);
        }
        if (EN(8) && IN(pb + 7)) { PH_IDS
            pg8::Gemm g{XB, (const bf16*)(ws + WS_RWT) + (size_t)l * 256 * 1024, T, 256, 1024}; pg8::StaticOrder S; S.init(T, 256, G, bx); pg8::EpiRouter E{(float*)(ws + WS_LOG), (const float*)(ws + WS_RB) + l * 64};
            pg8::gemm_phase<pg8::EpiRouter, pg8::StaticOrder, true, true>(lds, g, S, E, wv);
            SEAM(pb + 7);
        }
        if (EN(9) && IN(pb + 8)) { PH_IDS route_phase((const float*)(ws + WS_LOG), (unsigned*)(ctl + CW_CNT + 64 * l), (int*)(ws + WS_TOKE), (int*)(ws + WS_TOKP), (float*)(ws + WS_TOKW), gt, NT); SEAM(pb + 8); }
        if (EN(10) && IN(pb + 9)) { PH_IDS gather_phase(lds, (unsigned*)(ctl + CW_CNT + 64 * l), (unsigned*)(ctl + CW_NTILES + 64 * l), (int*)(ws + WS_TILE), (const int*)(ws + WS_TOKE), (const int*)(ws + WS_TOKP), (int*)(ws + WS_TOKS), XB, (bf16*)(ws + WS_XG), bx, gw, NGW, tid); SEAM(pb + 9); }
        if (EN(11) && IN(pb + 10)) { PH_IDS
            const int ntiles = __builtin_amdgcn_readfirstlane((int)__hip_atomic_load((unsigned*)(ctl + CW_NTILES + 64 * l), RLX_AGENT));
            pg8::Gemm g{(const bf16*)(ws + WS_XG), (const bf16*)(ws + WS_EGU), 0, 0, 1024}; pg8::MoeOrder S; S.init((const int*)(ws + WS_TILE), ntiles, 2, G, bx); pg8::EpiSwiglu E{(bf16*)(ws + WS_H)};
            pg8::gemm_phase<pg8::EpiSwiglu, pg8::MoeOrder, true, true>(lds, g, S, E, wv);
            SEAM(pb + 10);
        }
        if (EN(12) && IN(pb + 11)) { PH_IDS
            const int ntiles = __builtin_amdgcn_readfirstlane((int)__hip_atomic_load((unsigned*)(ctl + CW_NTILES + 64 * l), RLX_AGENT));
            pg8::Gemm g{(const bf16*)(ws + WS_H), (const bf16*)(ws + WS_EDN), 0, 0, 256}; pg8::MoeOrder S; S.init((const int*)(ws + WS_TILE), ntiles, 4, G, bx); pg8::EpiStore E{(bf16*)(ws + WS_XG), 1024, 4};
            pg8::gemm_phase<pg8::EpiStore, pg8::MoeOrder, true, true>(lds, g, S, E, wv);
            SEAM(pb + 11);
        }
        if (EN(13) && IN(pb + 12)) { PH_IDS
            ln_pass<2, true>(xres, xres, XB, AIN(I_LNG) + (l * 3 + 1) * 1024, AIN(I_LNB) + (l * 3 + 1) * 1024, (const bf16*)(ws + WS_XG), (const int*)(ws + WS_TOKS), (const float*)(ws + WS_TOKW), gw, NGW, lane);
            SEAM(pb + 12);
        }
        if (EN(14) && IN(pb + 13)) { PH_IDS
            bf16* TP = (bf16*)(ws + WS_TP);
            { pg8::Gemm g{(const bf16*)(ws + WS_PB), (const bf16*)(wb + WNE_WPLE), T, 1024, 256}; pg8::StaticOrder S; S.init(T, 1024, G, bx); pg8::EpiStore E{TP, 1024, 1 << 30};
              pg8::gemm_phase<pg8::EpiStore, pg8::StaticOrder, true, true>(lds, g, S, E, wv); }
            { pg8::Gemm g{XB, (const bf16*)(wb + WNE_WPG), T, 1024, 1024}; pg8::StaticOrder S; S.init(T, 1024, G, bx); pg8::EpiRes<1> E{xres, TP, 1024, ALPHA};
              pg8::gemm_phase<pg8::EpiRes<1>, pg8::StaticOrder, true, true>(lds, g, S, E, wv); }
            SEAM(pb + 13);
        }
        if (EN(15) && IN(pb + 14)) { PH_IDS
            ln_pass<0, true>(xres, xres, XB, AIN(I_LNG) + (l * 3 + 2) * 1024, AIN(I_LNB) + (l * 3 + 2) * 1024, nullptr, nullptr, nullptr, gw, NGW, lane);
            if (l == 0) SEAM(pb + 14);
        }

}
#undef wb
#undef WinT
__global__ void __launch_bounds__(NWAVES * 64, 2) mega_fwd(Args args) {
    extern __shared__ __attribute__((aligned(16))) unsigned char lds_raw[];
    LAS unsigned char* lds = (LAS unsigned char*)lds_raw;
    for (int u = threadIdx.x; u < (LDS_BYTES - RING_BYTES) / 4; u += NWAVES * 64) ((LAS unsigned*)(lds + RING_BYTES))[u] = 0u;
    __syncthreads();
    (void)xcd_barrier_post((unsigned*)(args.ws + WS_CTL) + CW_BAR, (volatile LAS unsigned*)(lds + MISC_OFF) + 8);
    const int lo = args.ph_lo, hi = args.ph_hi, wv = __builtin_amdgcn_readfirstlane(threadIdx.x >> 6);

    if (EN(0) && IN(0)) { PH_IDS
        LAS float* scr = (LAS float*)(lds + wave * 16384);
        constexpr int I_WINL = 16 * 169, I_BR = 8 * 32, I_SQ = 16 * 32, I_PLE = 4 * 32, I_LAYER = I_WINL + 2 * I_BR + 2 * I_SQ + I_PLE;
        for (int it = gw; it < 2 * I_LAYER; it += NGW) {
            const int l = it / I_LAYER; int r = it - l * I_LAYER; unsigned char* wb_ = ws + WS_WNE + (size_t)l * WNE_LAYER;
            if (r < I_WINL) { const int kb = r / 169, nb = r - kb * 169, n0 = 32 * nb; transpose_item(AIN(I_WIN) + (size_t)l * 1024 * 5408, 5408, 64 * kb, n0, (bf16*)(wb_ + WNE_WIN), 1024, n0 + (n0 >= 3360 ? 224 : 0), scr, lane); continue; } r -= I_WINL;
            if (r < I_BR) { const int kb = r / 32, nb = r & 31; transpose_item(AIN(I_WBA) + (size_t)l * 512 * 1024, 1024, 64 * kb, 32 * nb, (bf16*)(wb_ + WNE_WBA), 512, 32 * nb, scr, lane); continue; } r -= I_BR;
            if (r < I_BR) { const int kb = r / 32, nb = r & 31; transpose_item(AIN(I_WBR) + (size_t)l * 512 * 1024, 1024, 64 * kb, 32 * nb, (bf16*)(wb_ + WNE_WBR), 512, 32 * nb, scr, lane); continue; } r -= I_BR;
            if (r < I_SQ) { const int kb = r / 32, nb = r & 31; transpose_item(AIN(I_WOUT) + (size_t)l * 1024 * 1024, 1024, 64 * kb, 32 * nb, (bf16*)(wb_ + WNE_WOUT), 1024, 32 * nb, scr, lane); continue; } r -= I_SQ;
            if (r < I_SQ) { const int kb = r / 32, nb = r & 31; transpose_item(AIN(I_PLEG) + (size_t)l * 1024 * 1024, 1024, 64 * kb, 32 * nb, (bf16*)(wb_ + WNE_WPG), 1024, 32 * nb, scr, lane); continue; } r -= I_SQ;
            { const int kb = r / 32, nb = r & 31; transpose_item(AIN(I_PLEP) + (size_t)l * 256 * 1024, 1024, 64 * kb, 32 * nb, (bf16*)(wb_ + WNE_WPLE), 256, 32 * nb, scr, lane); }
        }
        for (int i = gt; i < 2 * 224 * 1024 / 8; i += NT) { const int l = i / (224 * 128), r = i - l * (224 * 128);
            *(GAS v4u*)(ws + WS_WNE + (size_t)l * WNE_LAYER + WNE_WIN + (size_t)3360 * 2048 + (size_t)r * 16) = (v4u){0u, 0u, 0u, 0u}; }
        { bf16* RWT = (bf16*)(ws + WS_RWT);
          for (int i = gt; i < 2 * 256 * 1024; i += NT) { const int l = i >> 18, n = (i >> 10) & 255, k = i & 1023;
              const float v = n < 4 ? AIN(I_RG)[l * 4096 + k * 4 + n] : n < 36 ? AIN(I_RE)[l * 32768 + k * 32 + (n - 4)] : 0.f; RWT[i] = (bf16)f2bf(v); } }
        { float* RB = (float*)(ws + WS_RB); if (gt < 128) { const int l = gt >> 6, n = gt & 63; RB[gt] = n < 4 ? AIN(I_RGB)[l * 4 + n] : n < 36 ? AIN(I_REB)[l * 32 + n - 4] : 0.f; } }
        { bf16* DUT = (bf16*)(ws + WS_DUT); bf16* AUT = (bf16*)(ws + WS_AUT);
          for (int i = gt; i < 2 * 512 * 64; i += NT) { const int l = i >> 15, n = (i >> 6) & 511, k = i & 63;
              DUT[i] = (bf16)f2bf(AIN(I_DECUP)[l * 32768 + k * 512 + n]); AUT[i] = (bf16)f2bf(AIN(I_AAAUP)[l * 32768 + k * 512 + n]); } }
        { bf16* GUT = (bf16*)(ws + WS_GUT);
          for (int i = gt; i < 2 * 512 * 160; i += NT) { const int l = i / 81920, r = i - l * 81920, n = r / 160, k = r - n * 160; GUT[i] = (bf16)f2bf(AIN(I_GATEUP)[l * 81920 + k * 512 + n]); } }
        { bf16* VDT = (bf16*)(ws + WS_VDT); bf16* VUT = (bf16*)(ws + WS_VUT);
          for (int i = gt; i < 16384; i += NT) { VDT[i] = (bf16)f2bf(AIN(I_VRD)[(i & 511) * 32 + (i >> 9)]); VUT[i] = (bf16)f2bf(AIN(I_VRU)[(i & 31) * 512 + (i >> 5)]); } }
        ln_pass<0, true>(AIN(I_X), xres, XB, AIN(I_LNIN_G), AIN(I_LNIN_B), nullptr, nullptr, nullptr, gw, NGW, lane);
        SEAM(0);
    }

    layer_body<0>(args, lds, lo, hi, wv);
    layer_body<1>(args, lds, lo, hi, wv);
#undef IN
#undef SEAM
}

extern "C" void kernel_launch(void* const* d_in, const int* in_sizes, int n_in, void* d_out, int out_size, void* d_ws, size_t ws_size, hipStream_t stream) {
    static int grid = 0;
    if (grid == 0) {
        if (n_in != 34 || out_size != T * D || ws_size < WS_END) { fprintf(stderr, "kernel_launch: unexpected shapes (n_in %d out %d ws %zu)\n", n_in, out_size, ws_size); grid = -1; return; }
        int dev = 0, cus = 0, per_cu = 0;
        if (hipGetDevice(&dev) != hipSuccess || hipDeviceGetAttribute(&cus, hipDeviceAttributeMultiprocessorCount, dev) != hipSuccess) { grid = -1; return; }
        if (hipFuncSetAttribute((const void*)mega_fwd, hipFuncAttributeMaxDynamicSharedMemorySize, LDS_BYTES) != hipSuccess) { fprintf(stderr, "kernel_launch: hipFuncSetAttribute failed\n"); grid = -1; return; }
        if (hipOccupancyMaxActiveBlocksPerMultiprocessor(&per_cu, (const void*)mega_fwd, NWAVES * 64, LDS_BYTES) != hipSuccess || per_cu < 1) fprintf(stderr, "kernel_launch: occupancy query reports %d\n", per_cu);
        (void)hipGetLastError();
        grid = cus;
    }
    if (grid < 0) return;
    if (hipMemsetAsync((char*)d_ws + WS_CTL, 0, CTL_ZERO_BYTES, stream) != hipSuccess) return;
    Args a{};
    for (int i = 0; i < 34; ++i) a.in[i] = (const float*)d_in[i];
    a.out = (float*)d_out; a.ws = (unsigned char*)d_ws;
#if MK_N_LAUNCHES == 1
    a.ph_lo = 0; a.ph_hi = N_PHASES;
    hipLaunchKernelGGL(mega_fwd, dim3(grid), dim3(NWAVES * 64), LDS_BYTES, stream, a);
#else
    for (int p = 0; p < N_PHASES; ++p) { a.ph_lo = p; a.ph_hi = p + 1; hipLaunchKernelGGL(mega_fwd, dim3(grid), dim3(NWAVES * 64), LDS_BYTES, stream, a); }
#endif
}
```

```cpp
#include <hip/hip_runtime.h>
#include <cstdio>
#include <cstdint>
#include <cmath>
namespace pg8 {
#define PG8_LAS __attribute__((address_space(3)))
typedef unsigned short bf16_t;
typedef short bf16x8 __attribute__((ext_vector_type(8)));
typedef float f32x4 __attribute__((ext_vector_type(4)));
typedef unsigned u32x4 __attribute__((ext_vector_type(4)));
constexpr int BM = 256, BK = 64, HALF = 128, HTB = HALF * BK * 2  , STAGE_BYTES = 8 * HTB, NXCD = 8, WGM = 8;

__host__ __device__ __forceinline__ int lds_byte(int r, int c) { const int st = (r >> 4) * 2 + (c >> 5), rr = r & 15, cc = c & 31, ob = rr * 64 + cc * 2; return st * 1024 + (ob ^ (((ob >> 9) & 1) << 5)); }
__host__ __device__ __forceinline__ void stage_rc(int b, int& R, int& C) { const int st = b / 1024, sb = b % 1024, swz = sb ^ (((sb >> 9) & 1) << 5); R = (st >> 1) * 16 + swz / 64; C = (st & 1) * 32 + (swz % 64) / 2; }
__host__ __device__ __forceinline__ int perm32(int rho) { const int n = rho >> 4, i = rho & 15; return 8 * (i >> 2) + 4 * n + (i & 3); }

struct Unit { int pm, pn; };
struct Gemm { const bf16_t* A; const bf16_t* Bt; int M, N, K; };

struct StaticOrder {
    int nM, nN, nwg, G, c;
    __host__ __device__ void init(int M, int N, int G_, int c_) { nM = M / BM; nN = N / BM; nwg = nM * nN; G = G_; c = c_; }
    __host__ __device__ bool next(int i, Unit& u) const {
        const long L = (long)i * G + c; if (L >= nwg) return false;
        int wgid = (int)L; { const int q = nwg / NXCD, r = nwg % NXCD, xcd = wgid % NXCD, off = wgid / NXCD; wgid = (xcd < r ? xcd * (q + 1) : r * (q + 1) + (xcd - r) * q) + off; }
        const int nig = WGM * nN, gid = wgid / nig, fm = gid * WGM, gsz = (nM - fm) < WGM ? (nM - fm) : WGM;
        u.pm = fm + ((wgid % nig) % gsz); u.pn = (wgid % nig) / gsz; return true;
    }
    __device__ __forceinline__ void a_ready(const Unit&) const {}
    __device__ __forceinline__ void done(const Unit&) const {}
};
__device__ __forceinline__ unsigned cvt_pk_bf16(float lo, float hi) { unsigned r; asm volatile("v_cvt_pk_bf16_f32 %0, %1, %2" : "=v"(r) : "v"(lo), "v"(hi)); return r; }
typedef float f32x2 __attribute__((ext_vector_type(2)));
typedef unsigned u32x2 __attribute__((ext_vector_type(2)));
__device__ __forceinline__ float bf_lo(unsigned w) { return __uint_as_float(w << 16); }
__device__ __forceinline__ float bf_hi(unsigned w) { return __uint_as_float(w & 0xffff0000u); }
__device__ __forceinline__ float sigm(float x) { return __builtin_amdgcn_rcpf(1.0f + __builtin_amdgcn_exp2f(-1.44269504f * x)); }

struct EpiStore {
    static constexpr bool PERM = true, AFTER_DRAIN = false;
    bf16_t* O; int ldc; int pn_mod;
    __device__ __forceinline__ void operator()(const f32x4 (&acc)[2][2][4][2], const Unit& u, int wr, int wc, int fr, int fq) const {
        const int row0 = u.pm * BM + wr * 64 + fr, col0 = (u.pn % pn_mod) * BM + wc * 32 + 8 * fq;
#pragma unroll
        for (int ai = 0; ai < 2; ++ai)
#pragma unroll
            for (int m = 0; m < 4; ++m) { bf16_t* rowp = O + (size_t)(row0 + ai * HALF + m * 16) * ldc + col0;
#pragma unroll
                for (int bj = 0; bj < 2; ++bj) { const f32x4 v0 = acc[ai][bj][m][0], v1 = acc[ai][bj][m][1];
                    u32x4 w; w.x = cvt_pk_bf16(v0[0], v0[1]); w.y = cvt_pk_bf16(v0[2], v0[3]); w.z = cvt_pk_bf16(v1[0], v1[1]); w.w = cvt_pk_bf16(v1[2], v1[3]);
                    *(u32x4*)(rowp + bj * HALF) = w; } }
    }
};
template <int MODE> struct EpiGate {
    static constexpr bool PERM = true, AFTER_DRAIN = false;
    const bf16_t* T1; const bf16_t* T2; bf16_t* O; int ldc;
    __device__ __forceinline__ void operator()(const f32x4 (&acc)[2][2][4][2], const Unit& u, int wr, int wc, int fr, int fq) const {
        const int row0 = u.pm * BM + wr * 64 + fr, col0 = u.pn * BM + wc * 32 + 8 * fq;
#pragma unroll
        for (int ai = 0; ai < 2; ++ai)
#pragma unroll
            for (int m = 0; m < 4; ++m) { const size_t off = (size_t)(row0 + ai * HALF + m * 16) * ldc + col0;
#pragma unroll
                for (int bj = 0; bj < 2; ++bj) { const f32x4 v0 = acc[ai][bj][m][0], v1 = acc[ai][bj][m][1];
                    const u32x4 a = *(const u32x4*)(T1 + off + bj * HALF);
                    float r[8];
                    if (MODE == 0) {
                        r[0] = sigm(v0[0]) * bf_lo(a.x); r[1] = sigm(v0[1]) * bf_hi(a.x); r[2] = sigm(v0[2]) * bf_lo(a.y); r[3] = sigm(v0[3]) * bf_hi(a.y);
                        r[4] = sigm(v1[0]) * bf_lo(a.z); r[5] = sigm(v1[1]) * bf_hi(a.z); r[6] = sigm(v1[2]) * bf_lo(a.w); r[7] = sigm(v1[3]) * bf_hi(a.w);
                    } else {
                        const u32x4 b = *(const u32x4*)(T2 + off + bj * HALF);
                        r[0] = bf_lo(a.x) + sigm(v0[0]) * bf_lo(b.x); r[1] = bf_hi(a.x) + sigm(v0[1]) * bf_hi(b.x); r[2] = bf_lo(a.y) + sigm(v0[2]) * bf_lo(b.y); r[3] = bf_hi(a.y) + sigm(v0[3]) * bf_hi(b.y);
                        r[4] = bf_lo(a.z) + sigm(v1[0]) * bf_lo(b.z); r[5] = bf_hi(a.z) + sigm(v1[1]) * bf_hi(b.z); r[6] = bf_lo(a.w) + sigm(v1[2]) * bf_lo(b.w); r[7] = bf_hi(a.w) + sigm(v1[3]) * bf_hi(b.w);
                    }
                    u32x4 w; w.x = cvt_pk_bf16(r[0], r[1]); w.y = cvt_pk_bf16(r[2], r[3]); w.z = cvt_pk_bf16(r[4], r[5]); w.w = cvt_pk_bf16(r[6], r[7]);
                    *(u32x4*)(O + off + bj * HALF) = w; } }
    }
};
template <int MODE> struct EpiRes {
    static constexpr bool PERM = false, AFTER_DRAIN = false;
    float* X; const bf16_t* TP; int ldc; float alpha;
    __device__ __forceinline__ void operator()(const f32x4 (&acc)[2][2][4][2], const Unit& u, int wr, int wc, int fr, int fq) const {
        const int row0 = u.pm * BM + wr * 64 + fr, col0 = u.pn * BM + wc * 32 + 4 * fq;
#pragma unroll
        for (int ai = 0; ai < 2; ++ai)
#pragma unroll
            for (int m = 0; m < 4; ++m) { const size_t off = (size_t)(row0 + ai * HALF + m * 16) * ldc + col0;
#pragma unroll
                for (int bj = 0; bj < 2; ++bj) { if (MODE == 1 && bj == 1) asm volatile("" ::: "memory");
#pragma unroll
                    for (int n = 0; n < 2; ++n) { float* p = X + off + bj * HALF + n * 16; const f32x4 x = *(const f32x4*)p; f32x4 a = acc[ai][bj][m][n];
                        if (MODE == 1) { const u32x2 t = *(const u32x2*)(TP + off + bj * HALF + n * 16);
                            a = (f32x4){bf_lo(t.x) * sigm(a[0]), bf_hi(t.x) * sigm(a[1]), bf_lo(t.y) * sigm(a[2]), bf_hi(t.y) * sigm(a[3])}; }
                        *(f32x4*)p = x * alpha + a; } }
                if (MODE == 1 || (m & 1)) asm volatile("" ::: "memory"); }
    }
};
struct EpiRouter {
    static constexpr bool PERM = false, AFTER_DRAIN = false;
    float* LOG; const float* bias;
    __device__ __forceinline__ void operator()(const f32x4 (&acc)[2][2][4][2], const Unit& u, int wr, int wc, int fr, int fq) const {
        if (wc >= 2) return;
        const int row0 = u.pm * BM + wr * 64 + fr, col0 = wc * 32 + 4 * fq;
        const f32x4 b0 = *(const f32x4*)(bias + col0), b1 = *(const f32x4*)(bias + col0 + 16);
#pragma unroll
        for (int ai = 0; ai < 2; ++ai)
#pragma unroll
            for (int m = 0; m < 4; ++m) { float* p = LOG + (size_t)(row0 + ai * HALF + m * 16) * 64 + col0;
                *(f32x4*)p = acc[ai][0][m][0] + b0; *(f32x4*)(p + 16) = acc[ai][0][m][1] + b1; }
    }
};
struct EpiSwiglu {
    static constexpr bool PERM = true, AFTER_DRAIN = false;
    bf16_t* H;
    __device__ __forceinline__ void operator()(const f32x4 (&acc)[2][2][4][2], const Unit& u, int wr, int wc, int fr, int fq) const {
        const int row0 = u.pm * BM + wr * 64 + fr, col0 = (u.pn & 1) * HALF + wc * 32 + 8 * fq;
#pragma unroll
        for (int ai = 0; ai < 2; ++ai)
#pragma unroll
            for (int m = 0; m < 4; ++m) { bf16_t* rowp = H + (size_t)(row0 + ai * HALF + m * 16) * 256 + col0;
                const f32x4 g0 = acc[ai][0][m][0], g1 = acc[ai][0][m][1], u0 = acc[ai][1][m][0], u1 = acc[ai][1][m][1];
                float r[8];
#pragma unroll
                for (int q = 0; q < 4; ++q) { r[q] = g0[q] * sigm(g0[q]) * u0[q]; r[4 + q] = g1[q] * sigm(g1[q]) * u1[q]; }
                u32x4 w; w.x = cvt_pk_bf16(r[0], r[1]); w.y = cvt_pk_bf16(r[2], r[3]); w.z = cvt_pk_bf16(r[4], r[5]); w.w = cvt_pk_bf16(r[6], r[7]);
                *(u32x4*)rowp = w; }
    }
};
struct MoeOrder {
    const int* tile_e; int nunits, npn, G, c;
    __device__ __forceinline__ void init(const int* te, int ntiles, int npn_, int G_, int c_) { tile_e = te; npn = npn_; nunits = ntiles * npn_; G = G_; c = c_; }
    __device__ __forceinline__ bool next(int i, Unit& u) const {
        const int L = i * G + c; if (L >= nunits) return false;
        const int rt = L / npn, pn = L - rt * npn;
        const int e = __builtin_amdgcn_readfirstlane(__hip_atomic_load(tile_e + rt, __ATOMIC_RELAXED, __HIP_MEMORY_SCOPE_AGENT));
        u.pm = rt; u.pn = e * npn + pn; return true;
    }
    __device__ __forceinline__ void a_ready(const Unit&) const {}
    __device__ __forceinline__ void done(const Unit&) const {}
};
template <class Epi, class Sched, bool ALIGN_EPI = false, bool SP2 = false>
__device__ __forceinline__ void gemm_phase(PG8_LAS unsigned char* lds, const Gemm g, const Sched& S, const Epi& E, const int wv) {
    int tid_ = wv * 64 + (int)__builtin_amdgcn_mbcnt_hi(~0u, __builtin_amdgcn_mbcnt_lo(~0u, 0u)); asm volatile("" : "+v"(tid_));
    const int tid = tid_, wid = __builtin_amdgcn_readfirstlane(tid >> 6), lane = tid & 63, wr = wid >> 2, wc = wid & 3, fr = lane & 15, fq = lane >> 4;
    const int K = g.K, nt = K / BK;
    unsigned voffA[2], voffB[2];
#pragma unroll
    for (int i = 0; i < 2; ++i) { int R, C; stage_rc(tid * 16 + i * 8192, R, C); const int Rb = Epi::PERM ? ((R & ~31) + perm32(R & 31)) : R;
        voffA[i] = (unsigned)(R * K + C) * 2u; voffB[i] = (unsigned)(Rb * K + C) * 2u; }
    const size_t kstep = (size_t)(BK * 2);
    const size_t hstep = (size_t)HALF * K * 2;
    const size_t tstep = 2 * hstep;
    const unsigned ldsw = (unsigned)wid * 1024u;
    const int aoff = lds_byte(wr * 64 + fr, fq * 8), boff = lds_byte(wc * 32 + fr, fq * 8);
#define PG8_SA(b, h) (((b) * 2 + (h)) * HTB)
#define PG8_SB(b, h) ((4 + (b) * 2 + (h)) * HTB)
#define PG8_STAGE(bufoff, gbase, voff) do { _Pragma("unroll") for (int _i = 0; _i < 2; ++_i) \
        __builtin_amdgcn_global_load_lds((const unsigned*)((const char*)(gbase) + (voff)[_i]), (PG8_LAS unsigned*)(lds + (bufoff) + ldsw + _i * 8192), 16, 0, 0); } while (0)
#define PG8_LDA(dst, b, h) do { _Pragma("unroll") for (int m = 0; m < 4; ++m) _Pragma("unroll") for (int k = 0; k < 2; ++k) dst[m][k] = *(const PG8_LAS bf16x8*)(lds + PG8_SA(b, h) + aoff + m * 2048 + k * 1024); } while (0)
#define PG8_LDB(dst, b, h) do { _Pragma("unroll") for (int n = 0; n < 2; ++n) _Pragma("unroll") for (int k = 0; k < 2; ++k) dst[n][k] = *(const PG8_LAS bf16x8*)(lds + PG8_SB(b, h) + boff + n * 2048 + k * 1024); } while (0)
#define PG8_MMA(ai, bj, At, Bt) do { __builtin_amdgcn_s_setprio(1); _Pragma("unroll") for (int m = 0; m < 4; ++m) _Pragma("unroll") for (int n = 0; n < 2; ++n) _Pragma("unroll") for (int k = 0; k < 2; ++k) \
        acc[ai][bj][m][n] = __builtin_amdgcn_mfma_f32_16x16x32_bf16(Bt[n][k], At[m][k], acc[ai][bj][m][n], 0, 0, 0); __builtin_amdgcn_s_setprio(0); } while (0)
#define PG8_WAIT_V(n) asm volatile("s_waitcnt vmcnt(" #n ")" ::: "memory")
#define PG8_WAIT_L(n) asm volatile("s_waitcnt lgkmcnt(" #n ")" ::: "memory")
#define PG8_BAR __builtin_amdgcn_s_barrier()
#define PG8_SCHED __builtin_amdgcn_sched_barrier(0)
    Unit cur, nxt; int ui = 0;
    if (!S.next(0, cur)) return;
    f32x4 acc[2][2][4][2];
#pragma unroll
    for (int a = 0; a < 2; ++a)
#pragma unroll
        for (int b = 0; b < 2; ++b)
#pragma unroll
            for (int m = 0; m < 4; ++m)
#pragma unroll
                for (int n = 0; n < 2; ++n) acc[a][b][m][n] = (f32x4){0.f, 0.f, 0.f, 0.f};
    bf16x8 At[4][2], B0[2][2], B1[2][2];
    const char* cA = (const char*)g.A + (size_t)cur.pm * tstep; const char* cB = (const char*)g.Bt + (size_t)cur.pn * tstep;
    S.a_ready(cur);
    if constexpr (SP2) {
        PG8_STAGE(PG8_SB(0, 0), cB, voffB); PG8_STAGE(PG8_SB(0, 1), cB + hstep, voffB); PG8_STAGE(PG8_SA(0, 0), cA, voffA); PG8_STAGE(PG8_SA(0, 1), cA + hstep, voffA);
        if (wr == 1) PG8_BAR;
        PG8_WAIT_V(2); PG8_BAR;
        PG8_STAGE(PG8_SB(1, 0), cB + kstep, voffB); PG8_STAGE(PG8_SA(1, 0), cA + kstep, voffA); PG8_STAGE(PG8_SB(1, 1), cB + hstep + kstep, voffB);
        PG8_WAIT_V(6); PG8_BAR;
    } else {
        PG8_STAGE(PG8_SB(0, 0), cB, voffB); PG8_STAGE(PG8_SA(0, 0), cA, voffA); PG8_STAGE(PG8_SB(0, 1), cB + hstep, voffB); PG8_STAGE(PG8_SA(0, 1), cA + hstep, voffA);
        if (wr == 1) PG8_BAR;
        PG8_WAIT_V(4); PG8_BAR;
        PG8_STAGE(PG8_SB(1, 0), cB + kstep, voffB); PG8_STAGE(PG8_SA(1, 0), cA + kstep, voffA); PG8_STAGE(PG8_SB(1, 1), cB + hstep + kstep, voffB);
        PG8_WAIT_V(6); PG8_BAR;
    }
    for (;;) {
        const bool has_next = S.next(ui + 1, nxt);
        const char* nA = has_next ? (const char*)g.A + (size_t)nxt.pm * tstep : cA; const char* nB = has_next ? (const char*)g.Bt + (size_t)nxt.pn * tstep : cB;
        for (int t = 0; t < nt; t += 2) {
            const bool last = (t == nt - 2);
            const char* a1 = cA + (size_t)(t + 1) * kstep;
            const char* a2 = last ? nA : cA + (size_t)(t + 2) * kstep; const char* b2 = last ? nB : cB + (size_t)(t + 2) * kstep;
            const char* a3 = a2 + kstep; const char* b3 = b2 + kstep;
            if (last && has_next) S.a_ready(nxt);
            if constexpr (SP2) {
            PG8_LDB(B0, 0, 0); PG8_LDB(B1, 0, 1); PG8_SCHED; PG8_LDA(At, 0, 0); PG8_STAGE(PG8_SA(1, 1), a1 + hstep, voffA);
            PG8_WAIT_V(8); PG8_WAIT_L(0); PG8_BAR; PG8_MMA(0, 0, At, B0); PG8_MMA(0, 1, At, B1); PG8_BAR; PG8_SCHED;
            PG8_LDA(At, 0, 1); PG8_STAGE(PG8_SB(0, 0), b2, voffB); PG8_STAGE(PG8_SB(0, 1), b2 + hstep, voffB); PG8_STAGE(PG8_SA(0, 0), a2, voffA);
            PG8_WAIT_V(8); PG8_WAIT_L(0); PG8_BAR; PG8_MMA(1, 0, At, B0); PG8_MMA(1, 1, At, B1); PG8_BAR; PG8_SCHED;
            PG8_LDB(B0, 1, 0); PG8_LDB(B1, 1, 1); PG8_SCHED; PG8_LDA(At, 1, 0); PG8_STAGE(PG8_SA(0, 1), a2 + hstep, voffA);
            PG8_WAIT_V(8); PG8_WAIT_L(0); PG8_BAR; PG8_MMA(0, 0, At, B0); PG8_MMA(0, 1, At, B1); PG8_BAR; PG8_SCHED;
            PG8_LDA(At, 1, 1); PG8_STAGE(PG8_SB(1, 0), b3, voffB); PG8_STAGE(PG8_SB(1, 1), b3 + hstep, voffB); PG8_STAGE(PG8_SA(1, 0), a3, voffA);
            PG8_WAIT_V(8); PG8_WAIT_L(0); PG8_BAR; PG8_MMA(1, 0, At, B0); PG8_MMA(1, 1, At, B1); PG8_BAR; PG8_SCHED;
            } else {
            PG8_LDB(B0, 0, 0); PG8_SCHED; PG8_LDA(At, 0, 0); PG8_STAGE(PG8_SA(1, 1), a1 + hstep, voffA);
            PG8_WAIT_L(8); PG8_BAR; PG8_WAIT_L(0); PG8_MMA(0, 0, At, B0); PG8_BAR; PG8_SCHED;
            PG8_LDB(B1, 0, 1); PG8_STAGE(PG8_SB(0, 0), b2, voffB);
            PG8_BAR; PG8_WAIT_L(0); PG8_MMA(0, 1, At, B1); PG8_BAR;
            PG8_LDA(At, 0, 1); PG8_STAGE(PG8_SA(0, 0), a2, voffA);
            PG8_BAR; PG8_WAIT_L(0); PG8_MMA(1, 0, At, B0); PG8_BAR; PG8_SCHED;
            PG8_STAGE(PG8_SB(0, 1), b2 + hstep, voffB);
            PG8_WAIT_V(6); PG8_BAR; PG8_MMA(1, 1, At, B1); PG8_BAR;
            PG8_LDB(B0, 1, 0); PG8_SCHED; PG8_LDA(At, 1, 0); PG8_STAGE(PG8_SA(0, 1), a2 + hstep, voffA);
            PG8_WAIT_L(8); PG8_BAR; PG8_WAIT_L(0); PG8_MMA(0, 0, At, B0); PG8_BAR; PG8_SCHED;
            PG8_LDB(B1, 1, 1); PG8_STAGE(PG8_SB(1, 0), b3, voffB);
            PG8_BAR; PG8_WAIT_L(0); PG8_MMA(0, 1, At, B1); PG8_BAR;
            PG8_LDA(At, 1, 1); PG8_STAGE(PG8_SA(1, 0), a3, voffA);
            PG8_BAR; PG8_WAIT_L(0); PG8_MMA(1, 0, At, B0); PG8_BAR; PG8_SCHED;
            PG8_STAGE(PG8_SB(1, 1), b3 + hstep, voffB);
            PG8_WAIT_V(6); PG8_BAR; PG8_MMA(1, 1, At, B1); PG8_BAR;
            }
        }
        if constexpr (ALIGN_EPI) { if (wr == 0) PG8_BAR; }
        if constexpr (!Epi::AFTER_DRAIN) { E(acc, cur, wr, wc, fr, fq); S.done(cur); }
        if (!has_next) break;
#pragma unroll
        for (int a = 0; a < 2; ++a)
#pragma unroll
            for (int b = 0; b < 2; ++b)
#pragma unroll
                for (int m = 0; m < 4; ++m)
#pragma unroll
                    for (int n = 0; n < 2; ++n) acc[a][b][m][n] = (f32x4){0.f, 0.f, 0.f, 0.f};
        cur = nxt; cA = nA; cB = nB; ++ui;
        if constexpr (ALIGN_EPI) { if (wr == 1) PG8_BAR; }
    }
    PG8_WAIT_V(0);
    if constexpr (!ALIGN_EPI) { if (wr == 0) PG8_BAR; }
    PG8_BAR;
    if constexpr (Epi::AFTER_DRAIN) { E.fused(acc, cur, wr, wc, fr, fq, lds, wid, lane); S.done(cur); }
#undef PG8_SA
#undef PG8_SB
#undef PG8_STAGE
#undef PG8_LDA
#undef PG8_LDB
#undef PG8_MMA
#undef PG8_WAIT_V
#undef PG8_WAIT_L
#undef PG8_BAR
#undef PG8_SCHED
}
}

constexpr int T = 32768, D = 1024, SEQ = 2048;
constexpr int NWAVES = 8;
constexpr float LOG2E = 1.44269504f, ALPHA = 1.41421356237f, LN_EPS = 1e-5f, GN_EPS = 64e-5f;
constexpr size_t MiB = 1u << 20;
constexpr size_t WS_CTL = 0, CTL_ZERO_BYTES = 1 * MiB;
constexpr size_t WS_DUT = 1 * MiB, WS_AUT = WS_DUT + 128 * 1024, WS_GUT = WS_DUT + 256 * 1024, WS_VDT = WS_DUT + 576 * 1024, WS_VUT = WS_DUT + 608 * 1024,
                 WS_RB = WS_DUT + 640 * 1024, WS_TILE = WS_DUT + 704 * 1024;
constexpr size_t WS_RWT = 2 * MiB;
constexpr size_t WS_TOKE = 3 * MiB, WS_TOKP = WS_TOKE + 256 * 1024, WS_TOKW = WS_TOKE + 512 * 1024, WS_TOKS = WS_TOKE + 768 * 1024;
constexpr size_t WS_WNE = 4 * MiB, WNE_LAYER = 18 * MiB;
constexpr size_t WNE_WIN = 0, WNE_WBA = 11 * MiB, WNE_WBR = 12 * MiB, WNE_WOUT = 13 * MiB, WNE_WPG = 15 * MiB, WNE_WPLE = 17 * MiB;
constexpr size_t WS_XB = 40 * MiB, WS_VF = 104 * MiB, WS_YA = 136 * MiB, WS_YB = 168 * MiB, WS_QK = 200 * MiB, WS_VT = 264 * MiB, WS_RKVL = 296 * MiB, WS_NU = 424 * MiB;
constexpr size_t WS_LW = 200 * MiB, WS_AA = 232 * MiB, WS_GG = 264 * MiB;
constexpr size_t WS_T1 = 200 * MiB, WS_T2 = 264 * MiB, WS_MP = 328 * MiB;
constexpr size_t WS_EGU = 136 * MiB, WS_EDN = 168 * MiB, WS_LOG = 184 * MiB, WS_XG = 200 * MiB, WS_H = 344 * MiB, WS_PB = 392 * MiB, WS_TP = 216 * MiB;
constexpr size_t WS_END = 456 * MiB;
constexpr int CW_TMO = 0, CW_BAR = 4096, CW_CNT = 16384, CW_NTILES = 16384 + 256;
constexpr int WIN_ROWS = 5632;
constexpr int RING_BYTES = 131072, MISC_OFF = RING_BYTES + 320, LDS_BYTES = 147456;

#define GAS __attribute__((address_space(1)))
#define LAS __attribute__((address_space(3)))
typedef unsigned short bf16;
typedef unsigned v4u __attribute__((ext_vector_type(4)));
typedef unsigned v2u __attribute__((ext_vector_type(2)));
typedef float f32x4 __attribute__((ext_vector_type(4)));
typedef float f32x16 __attribute__((ext_vector_type(16)));
typedef short bf16x8 __attribute__((ext_vector_type(8)));
typedef GAS unsigned gu32;
#define RLX_AGENT __ATOMIC_RELAXED, __HIP_MEMORY_SCOPE_AGENT
#define LDS_WAIT() asm volatile("s_waitcnt lgkmcnt(0)" ::: "memory")
#define VM_WAIT() asm volatile("s_waitcnt vmcnt(0)" ::: "memory")
#define MFMA32(a, b, c) __builtin_amdgcn_mfma_f32_32x32x16_bf16((a), (b), (c), 0, 0, 0)
__device__ __forceinline__ unsigned f2bf(float f) { unsigned u = __builtin_bit_cast(unsigned, f); return (u + 0x7fffu + ((u >> 16) & 1u)) >> 16; }
__device__ __forceinline__ unsigned pk2(float lo, float hi) { return pg8::cvt_pk_bf16(lo, hi); }
__device__ __forceinline__ float bflo(unsigned w) { return __uint_as_float(w << 16); }
__device__ __forceinline__ float bfhi(unsigned w) { return __uint_as_float(w & 0xffff0000u); }
__device__ __forceinline__ float sigm(float x) { return __builtin_amdgcn_rcpf(1.0f + __builtin_amdgcn_exp2f(-LOG2E * x)); }
__device__ __forceinline__ void unpack8(const v4u w, float (&f)[8]) { f[0] = bflo(w.x); f[1] = bfhi(w.x); f[2] = bflo(w.y); f[3] = bfhi(w.y); f[4] = bflo(w.z); f[5] = bfhi(w.z); f[6] = bflo(w.w); f[7] = bfhi(w.w); }
__device__ __forceinline__ v4u pack8(const float (&f)[8]) { v4u w; w.x = pk2(f[0], f[1]); w.y = pk2(f[2], f[3]); w.z = pk2(f[4], f[5]); w.w = pk2(f[6], f[7]); return w; }
template <int CTRL> __device__ __forceinline__ float dppf(float x) { return __builtin_bit_cast(float, __builtin_amdgcn_update_dpp(0, __builtin_bit_cast(int, x), CTRL, 0xF, 0xF, true)); }
__device__ __forceinline__ float red8(float x) { x += dppf<0xB1>(x); x += dppf<0x4E>(x); x += dppf<0x141>(x); return x; }
__device__ __forceinline__ float wave_sum(float v) {
#pragma unroll
    for (int o = 1; o < 64; o <<= 1) v += __shfl_xor(v, o);
    return v;
}
__device__ __forceinline__ int crow(int i, int hh) { return (i & 3) + 8 * (i >> 2) + 4 * hh; }
#define XB_TMO      128
#define XB_XCNT(j)  (256  + 64 * (j))
#define XB_XSUB(j)  (1280 + 64 * (j))
#define XB_XGEN(j)  (2304 + 64 * (j))
#define XB_TOP      3328
#define XB_TOPGEN   3392
#define XCD_BAR_WORDS 3456
#define XB_SPIN_CAP (1u << 18)

__device__ __forceinline__ unsigned xb_ld(unsigned* p)              { return __hip_atomic_load(p, __ATOMIC_RELAXED, __HIP_MEMORY_SCOPE_AGENT); }
__device__ __forceinline__ unsigned xb_add(unsigned* p, unsigned v) { return __hip_atomic_fetch_add(p, v, __ATOMIC_RELAXED, __HIP_MEMORY_SCOPE_AGENT); }
__device__ __forceinline__ unsigned xb_xcc_id() { return (unsigned)__builtin_amdgcn_s_getreg((3 << 11) | 20) & 0xFu; }
#define XB_SPIN(cond, bar) do { unsigned _sp = 0; while (cond) { __builtin_amdgcn_s_sleep(1); \
    if ((++_sp & 255u) == 0u) { if (xb_ld(&(bar)[XB_TMO])) break; if (_sp > XB_SPIN_CAP) { atomicAdd(&(bar)[XB_TMO], 1u); break; } } } } while (0)

struct XcdBarrier {
    unsigned* bar; unsigned x;
    volatile LAS unsigned* st;
};

__device__ __forceinline__ XcdBarrier xcd_barrier_post(unsigned* bar, volatile LAS unsigned* st) {
    XcdBarrier b; b.bar = bar; b.x = xb_xcc_id(); b.st = st;
    if (threadIdx.x == 0) (void)xb_add(&bar[XB_XCNT(b.x)], 1u);
    return b;
}
__device__ __forceinline__ void xcd_barrier_complete(unsigned* bar, unsigned x, unsigned& nloc, unsigned& nx) {
    const unsigned G = gridDim.x * gridDim.y * gridDim.z;
    unsigned sum, cnt, mine, sp = 0u;
    for (;;) {
        sum = 0u; cnt = 0u; mine = 0u;
#pragma unroll
        for (unsigned j = 0; j < 16; ++j) { const unsigned c = xb_ld(&bar[XB_XCNT(j)]); sum += c; cnt += (c > 0u) ? 1u : 0u; mine = (j == x) ? c : mine; }
        if (sum == G) break;
        __builtin_amdgcn_s_sleep(1);
        if ((++sp & 255u) == 0u) { if (xb_ld(&bar[XB_TMO])) break; if (sp > XB_SPIN_CAP) { atomicAdd(&bar[XB_TMO], 1u); break; } }
    }
    nloc = mine > 0u ? mine : 1u; nx = cnt > 0u ? cnt : 1u;
}

__device__ __forceinline__ void xcd_barrier(const XcdBarrier& b, const bool leader) {
    asm volatile("s_waitcnt vmcnt(0)" ::: "memory");
    __syncthreads();
    if (leader) {
        unsigned* bar = b.bar;
        __builtin_amdgcn_s_waitcnt(0);
        unsigned nloc = b.st[0], nx = b.st[1];
        if (nloc == 0u) { xcd_barrier_complete(bar, b.x, nloc, nx); b.st[0] = nloc; b.st[1] = nx; }
        const unsigned old = xb_add(&bar[XB_XSUB(b.x)], 1u);
        const unsigned gen = old / nloc;
        if (old + 1u == (gen + 1u) * nloc) {
            __builtin_amdgcn_fence(__ATOMIC_RELEASE, "agent");
            asm volatile("s_waitcnt vmcnt(0)" ::: "memory");
            const unsigned og = xb_add(&bar[XB_TOP], 1u);
            const unsigned tg = og / nx;
            if (og + 1u == (tg + 1u) * nx) xb_add(&bar[XB_TOPGEN], 1u);
            else XB_SPIN(xb_ld(&bar[XB_TOPGEN]) == tg, bar);
            __builtin_amdgcn_fence(__ATOMIC_ACQUIRE, "agent");
            xb_add(&bar[XB_XGEN(b.x)], 1u);
            asm volatile("s_waitcnt vmcnt(0)" ::: "memory");
        } else {
            XB_SPIN(xb_ld(&bar[XB_XGEN(b.x)]) == gen, bar);
            __builtin_amdgcn_fence(__ATOMIC_ACQUIRE, "agent");
            asm volatile("s_waitcnt vmcnt(0)" ::: "memory");
        }
    }
    __syncthreads();
}

__device__ __forceinline__ void transpose_item(const float* W, int ldw, int k0, int n0, bf16* WT, int ldk, int drow0, LAS float* scr, int lane) {
#pragma unroll 8
    for (int i = 0; i < 32; ++i) { const int kk = 2 * i + (lane >> 5); scr[kk * 33 + (lane & 31)] = W[(size_t)(k0 + kk) * ldw + n0 + (lane & 31)]; }
    LDS_WAIT(); asm volatile("" ::: "memory");
    const int c = lane & 7;
#pragma unroll
    for (int j = 0; j < 4; ++j) { const int n = (lane >> 3) + 8 * j; const LAS float* s = scr + (8 * c) * 33 + n;
        v4u o; o.x = pk2(s[0 * 33], s[1 * 33]); o.y = pk2(s[2 * 33], s[3 * 33]); o.z = pk2(s[4 * 33], s[5 * 33]); o.w = pk2(s[6 * 33], s[7 * 33]);
        *(GAS v4u*)(WT + (size_t)(drow0 + n) * ldk + k0 + 8 * c) = o; }
    LDS_WAIT(); asm volatile("" ::: "memory");
}

template <int MODE, bool WRITE_XB>
__device__ __forceinline__ void ln_pass(const float* src, float* dst, bf16* XB, const float* g, const float* b, const bf16* Y2, const int* TOKS, const float* TOKW, int gw, int NGW, int lane) {
    f32x4 gv[4], bv[4];
#pragma unroll
    for (int j = 0; j < 4; ++j) { gv[j] = *(const f32x4*)(g + 4 * lane + 256 * j); bv[j] = *(const f32x4*)(b + 4 * lane + 256 * j); }
    for (int m = gw; m < T; m += NGW) {
        const GAS f32x4* xr = (const GAS f32x4*)(src + (size_t)m * D) + lane;
        f32x4 v[4]; float s = 0.f;
#pragma unroll
        for (int j = 0; j < 4; ++j) v[j] = xr[64 * j];
        if (MODE == 2) {
            const int s1 = TOKS[2 * m], s2 = TOKS[2 * m + 1]; const float w1 = TOKW[2 * m], w2 = TOKW[2 * m + 1];
            const GAS v2u* y1 = (const GAS v2u*)(Y2 + (size_t)s1 * D) + lane; const GAS v2u* y2 = (const GAS v2u*)(Y2 + (size_t)s2 * D) + lane;
#pragma unroll
            for (int j = 0; j < 4; ++j) { const v2u a = y1[64 * j], c = y2[64 * j];
                v[j] = v[j] * ALPHA + w1 * (f32x4){bflo(a.x), bfhi(a.x), bflo(a.y), bfhi(a.y)} + w2 * (f32x4){bflo(c.x), bfhi(c.x), bflo(c.y), bfhi(c.y)}; }
        }
#pragma unroll
        for (int j = 0; j < 4; ++j) s += (v[j].x + v[j].y) + (v[j].z + v[j].w);
        const float mean = wave_sum(s) * (1.f / D); float s2 = 0.f;
#pragma unroll
        for (int j = 0; j < 4; ++j) { v[j] = v[j] - mean; s2 += (v[j].x * v[j].x + v[j].y * v[j].y) + (v[j].z * v[j].z + v[j].w * v[j].w); }
        const float rstd = 1.f / sqrtf(wave_sum(s2) * (1.f / D) + LN_EPS);
        GAS f32x4* o4 = (GAS f32x4*)(dst + (size_t)m * D) + lane;
        GAS v2u* o8 = (GAS v2u*)(XB + (size_t)m * D) + lane;
#pragma unroll
        for (int j = 0; j < 4; ++j) { const f32x4 y = v[j] * rstd * gv[j] + bv[j]; o4[64 * j] = y;
            if (WRITE_XB) { v2u w; w.x = pk2(y.x, y.y); w.y = pk2(y.z, y.w); o8[64 * j] = w; } }
    }
}

__device__ __forceinline__ void attn_phase(LAS unsigned char* lds, const bf16* QK, const bf16* VT, bf16* YA, const float* rel_bias, int vcu, int G, int tid) {
    LAS float* bl = (LAS float*)lds;
    for (int i = tid; i < 8 * 257; i += NWAVES * 64) bl[i] = rel_bias[i] * LOG2E;
    __syncthreads();
    const int h = __builtin_amdgcn_readfirstlane(tid >> 6), lane = tid & 63, r = lane & 31, hh = lane >> 5;
    const int pr = 16 * ((r >> 2) & 1) + (r & 3) + 4 * (r >> 3);
    const float C1 = 0.125f * LOG2E;
    const float b256 = bl[h * 257 + 256];
    for (int unit = vcu; unit < 512; unit += G) {
        const int b = unit >> 5, c = unit & 31;
        const size_t rowQ = (size_t)b * SEQ + (size_t)c * 64;
        const bf16* Qp = QK + rowQ * 1024 + h * 64;
        const bf16* Kb = QK + (size_t)b * SEQ * 1024 + 512 + h * 64;
        const bf16* Vb = VT + (size_t)(h * 64) * T + (size_t)b * SEQ;
        bf16x8 qf[2][4];
#pragma unroll
        for (int qb = 0; qb < 2; ++qb)
#pragma unroll
            for (int kk = 0; kk < 4; ++kk) qf[qb][kk] = *(const bf16x8*)(Qp + (size_t)(qb * 32 + r) * 1024 + 16 * kk + 8 * hh);
        f32x16 o[2][2];
#pragma unroll
        for (int a = 0; a < 2; ++a)
#pragma unroll
            for (int q = 0; q < 2; ++q)
#pragma unroll
                for (int i = 0; i < 16; ++i) o[a][q][i] = 0.f;
        float mrun[2] = {-INFINITY, -INFINITY}, lrun[2] = {0.f, 0.f};
        const int kt0 = c >= 8 ? 0 : (8 - c) * 2;
        for (int kt = kt0; kt < 18; ++kt) {
            const int tk0 = (c - 8) * 64 + 32 * kt;
            bf16x8 kf[4], vf[2][2];
#pragma unroll
            for (int kk = 0; kk < 4; ++kk) kf[kk] = *(const bf16x8*)(Kb + (size_t)(tk0 + pr) * 1024 + 16 * kk + 8 * hh);
#pragma unroll
            for (int db = 0; db < 2; ++db)
#pragma unroll
                for (int st = 0; st < 2; ++st) vf[db][st] = *(const bf16x8*)(Vb + (size_t)(db * 32 + r) * T + tk0 + 16 * hh + 8 * st);
            bf16x8 pf[2][2];
#pragma unroll
            for (int qb = 0; qb < 2; ++qb) {
                f32x16 s;
#pragma unroll
                for (int i = 0; i < 16; ++i) s[i] = 0.f;
#pragma unroll
                for (int kk = 0; kk < 4; ++kk) s = MFMA32(kf[kk], qf[qb][kk], s);
                float t[16];
                if (kt < 12) {
#pragma unroll
                    for (int i = 0; i < 16; ++i) t[i] = s[i] * C1 + b256;
                } else {
                    const int dbase = 512 + qb * 32 + r - (32 * kt + 16 * hh);
#pragma unroll
                    for (int i = 0; i < 16; ++i) { int dist = dbase - i; dist = dist > 128 ? 128 : dist; dist = dist < -128 ? -128 : dist; t[i] = s[i] * C1 + bl[h * 257 + dist + 128]; }
                }
                float ml = t[0];
#pragma unroll
                for (int i = 1; i < 16; ++i) ml = fmaxf(ml, t[i]);
                ml = fmaxf(ml, __shfl_xor(ml, 32));
                const float mnew = fmaxf(mrun[qb], ml), al = __builtin_amdgcn_exp2f(mrun[qb] - mnew);
                mrun[qb] = mnew;
                float ls = 0.f;
#pragma unroll
                for (int i = 0; i < 16; ++i) { t[i] = __builtin_amdgcn_exp2f(t[i] - mnew); ls += t[i]; }
                lrun[qb] = lrun[qb] * al + ls;
#pragma unroll
                for (int i = 0; i < 16; ++i) { o[0][qb][i] *= al; o[1][qb][i] *= al; }
#pragma unroll
                for (int st = 0; st < 2; ++st) { v4u w; w.x = pk2(t[8 * st + 0], t[8 * st + 1]); w.y = pk2(t[8 * st + 2], t[8 * st + 3]); w.z = pk2(t[8 * st + 4], t[8 * st + 5]); w.w = pk2(t[8 * st + 6], t[8 * st + 7]);
                    pf[qb][st] = __builtin_bit_cast(bf16x8, w); }
            }
#pragma unroll
            for (int db = 0; db < 2; ++db)
#pragma unroll
                for (int qb = 0; qb < 2; ++qb)
#pragma unroll
                    for (int st = 0; st < 2; ++st) o[db][qb] = MFMA32(vf[db][st], pf[qb][st], o[db][qb]);
        }
#pragma unroll
        for (int qb = 0; qb < 2; ++qb) {
            const float l = lrun[qb] + __shfl_xor(lrun[qb], 32), inv = 1.f / l;
            bf16* orow = YA + (rowQ + qb * 32 + r) * 512 + h * 64;
#pragma unroll
            for (int db = 0; db < 2; ++db)
#pragma unroll
                for (int g4 = 0; g4 < 4; ++g4) { v2u w; w.x = pk2(o[db][qb][4 * g4] * inv, o[db][qb][4 * g4 + 1] * inv); w.y = pk2(o[db][qb][4 * g4 + 2] * inv, o[db][qb][4 * g4 + 3] * inv);
                    *(GAS v2u*)(orow + db * 32 + 8 * g4 + 4 * hh) = w; }
        }
    }
}

struct PrepArgs { const bf16* RKVL; bf16 *LW, *AA, *GG, *NU; const float* mu; const float *decay_base, *aaa_base, *vres_base; const bf16 *DUT, *AUT, *GUT, *VDT, *VUT; int layer; };
constexpr int PA_STRIDE = 592, PV_STRIDE = 1040, PD_STRIDE = 80;
constexpr int PREP_A = 0, PREP_V = 38912, PREP_D = PREP_V + 64 * PV_STRIDE;
template <int KS> __device__ __forceinline__ void prep_mm(f32x16 (&acc)[2][2], const LAS unsigned char* Abase, int astride, int acol0, const bf16* W, int Kw, int hd, int r, int hh) {
#pragma unroll
    for (int a = 0; a < 2; ++a)
#pragma unroll
        for (int b = 0; b < 2; ++b)
#pragma unroll
            for (int i = 0; i < 16; ++i) acc[a][b][i] = 0.f;
#pragma unroll
    for (int ks = 0; ks < KS; ++ks) {
        bf16x8 af[2], bfr[2];
#pragma unroll
        for (int mb = 0; mb < 2; ++mb) af[mb] = *(const LAS bf16x8*)(Abase + (mb * 32 + r) * astride + (acol0 + 16 * ks + 8 * hh) * 2);
#pragma unroll
        for (int nb = 0; nb < 2; ++nb) bfr[nb] = *(const bf16x8*)(W + (size_t)(64 * hd + nb * 32 + r) * Kw + 16 * ks + 8 * hh);
#pragma unroll
        for (int mb = 0; mb < 2; ++mb)
#pragma unroll
            for (int nb = 0; nb < 2; ++nb) acc[mb][nb] = MFMA32(af[mb], bfr[nb], acc[mb][nb]);
    }
}
template <int MODE> __device__ __forceinline__ void prep_store(const f32x16 (&acc)[2][2], bf16* OUT, const float* base, int t0g, int hd, int r, int hh) {
#pragma unroll
    for (int nb = 0; nb < 2; ++nb) { const int col = 64 * hd + nb * 32 + r; const float bs = MODE == 2 ? 0.f : base[col];
#pragma unroll
        for (int mb = 0; mb < 2; ++mb)
#pragma unroll
            for (int i = 0; i < 16; ++i) { float v = acc[mb][nb][i]; if (MODE == 0) v = -0.60653066f * sigm(v + bs); if (MODE == 1) v = sigm(v + bs);
                OUT[(size_t)(t0g + mb * 32 + crow(i, hh)) * 512 + col] = (bf16)f2bf(v); } }
}
__device__ __forceinline__ void prep_phase(LAS unsigned char* lds, const PrepArgs& P, int vcu, int G, int tid) {
    const int hd = __builtin_amdgcn_readfirstlane(tid >> 6), lane = tid & 63, r = lane & 31, hh = lane >> 5;
    for (int unit = vcu; unit < 512; unit += G) {
        const int t0g = unit * 64, s0 = t0g & (SEQ - 1);
        for (int i = tid; i < 64 * 36; i += NWAVES * 64) { const int tok = i / 36, ch = i - tok * 36; const size_t row = (size_t)t0g + tok;
            const v4u cu = *(const GAS v4u*)(P.RKVL + row * 2048 + 1536 + 8 * ch);
            v4u pv = (v4u){0u, 0u, 0u, 0u}; if (s0 + tok > 0) pv = *(const GAS v4u*)(P.RKVL + (row - 1) * 2048 + 1536 + 8 * ch);
            float c8[8], p8[8], o8[8]; unpack8(cu, c8); unpack8(pv, p8);
            const float* mu = P.mu + 1536 + 8 * ch;
#pragma unroll
            for (int j = 0; j < 8; ++j) { float x = c8[j] + (p8[j] - c8[j]) * mu[j];
                if (ch < 8) x = 2.f * sigm(2.f * x) - 1.f; else if (ch >= 16) x = sigm(x);
                o8[j] = x; }
            *(LAS v4u*)(lds + PREP_A + tok * PA_STRIDE + 16 * ch) = pack8(o8); }
        if (P.layer == 1) {
            for (int i = tid; i < 64 * 64; i += NWAVES * 64) { const int tok = i >> 6, ch = i & 63; const size_t row = (size_t)t0g + tok;
                const v4u cu = *(const GAS v4u*)(P.RKVL + row * 2048 + 1024 + 8 * ch);
                v4u pv = (v4u){0u, 0u, 0u, 0u}; if (s0 + tok > 0) pv = *(const GAS v4u*)(P.RKVL + (row - 1) * 2048 + 1024 + 8 * ch);
                float c8[8], p8[8], o8[8]; unpack8(cu, c8); unpack8(pv, p8);
                const float* mu = P.mu + 1024 + 8 * ch;
#pragma unroll
                for (int j = 0; j < 8; ++j) o8[j] = c8[j] + (p8[j] - c8[j]) * mu[j];
                *(LAS v4u*)(lds + PREP_V + tok * PV_STRIDE + 16 * ch) = pack8(o8); }
        }
        __syncthreads();
        f32x16 acc[2][2];
        prep_mm<4>(acc, lds + PREP_A, PA_STRIDE, 0, P.DUT, 64, hd, r, hh);    prep_store<0>(acc, P.LW, P.decay_base, t0g, hd, r, hh);
        prep_mm<4>(acc, lds + PREP_A, PA_STRIDE, 64, P.AUT, 64, hd, r, hh);   prep_store<1>(acc, P.AA, P.aaa_base, t0g, hd, r, hh);
        prep_mm<10>(acc, lds + PREP_A, PA_STRIDE, 128, P.GUT, 160, hd, r, hh); prep_store<2>(acc, P.GG, nullptr, t0g, hd, r, hh);
        if (P.layer == 1) {
            if (hd < 2) {
                f32x16 a1;
#pragma unroll
                for (int i = 0; i < 16; ++i) a1[i] = 0.f;
#pragma unroll 4
                for (int ks = 0; ks < 32; ++ks) {
                    const bf16x8 af = *(const LAS bf16x8*)(lds + PREP_V + (hd * 32 + r) * PV_STRIDE + (16 * ks + 8 * hh) * 2);
                    const bf16x8 bfr = *(const bf16x8*)(P.VDT + (size_t)r * 512 + 16 * ks + 8 * hh);
                    a1 = MFMA32(af, bfr, a1);
                }
#pragma unroll
                for (int i = 0; i < 16; ++i) *(LAS bf16*)(lds + PREP_D + (hd * 32 + crow(i, hh)) * PD_STRIDE + 2 * r) = (bf16)f2bf(a1[i]);
            }
            __syncthreads();
            prep_mm<2>(acc, lds + PREP_D, PD_STRIDE, 0, P.VUT, 32, hd, r, hh); prep_store<1>(acc, P.NU, P.vres_base, t0g, hd, r, hh);
        }
        __syncthreads();
    }
}

struct ScanArgs { const bf16* RKVL; const bf16 *LW, *AA, *GG, *NU; bf16* VF; bf16* YB; const float* mu; const float *k_k, *k_a, *r_k, *gn_g, *gn_b; int layer; };
constexpr int SC_W = 0, SC_A = 16384, SC_B = 32768, SC_K = 49152, SC_R = 65536, SC_V = 81920, SC_Y = 98304, SC_RK = 114688, SC_TAB = 114944;
__device__ __forceinline__ void scan_phase(LAS unsigned char* lds, const ScanArgs& P, int unit, int tid) {
    const int b = unit >> 3, h = unit & 7;
    const int i = tid >> 3, c8 = tid & 7;
    LAS float* tab = (LAS float*)(lds + SC_TAB);
    if (tid < 64) {
        tab[0 * 64 + tid] = P.mu[h * 64 + tid]; tab[1 * 64 + tid] = P.mu[512 + h * 64 + tid]; tab[2 * 64 + tid] = P.mu[1024 + h * 64 + tid];
        tab[3 * 64 + tid] = P.k_k[h * 64 + tid]; tab[4 * 64 + tid] = P.k_a[h * 64 + tid]; tab[5 * 64 + tid] = P.r_k[h * 64 + tid];
        tab[6 * 64 + tid] = P.gn_g[h * 64 + tid]; tab[7 * 64 + tid] = P.gn_b[h * 64 + tid];
    }
    __syncthreads();
    float mur[8], muk[8], muv[8], kkw[8], kaw[8], rkw[8];
#pragma unroll
    for (int j = 0; j < 8; ++j) { mur[j] = tab[8 * c8 + j]; muk[j] = tab[64 + 8 * c8 + j]; muv[j] = tab[128 + 8 * c8 + j]; kkw[j] = tab[192 + 8 * c8 + j]; kaw[j] = tab[256 + 8 * c8 + j]; rkw[j] = tab[320 + 8 * c8 + j]; }
    float S[8];
#pragma unroll
    for (int j = 0; j < 8; ++j) S[j] = 0.f;
    const size_t row0 = (size_t)b * SEQ;
    const int hc = h * 64 + 8 * c8;
    for (int tile = 0; tile < SEQ / 64; ++tile) {
        {
            const int tok = i, s = tile * 64 + tok; const size_t row = row0 + s;
            const bf16* rp = P.RKVL + row * 2048;
            const v4u rc = *(const GAS v4u*)(rp + hc), kc = *(const GAS v4u*)(rp + 512 + hc), vc = *(const GAS v4u*)(rp + 1024 + hc);
            v4u rpv = (v4u){0u, 0u, 0u, 0u}, kpv = rpv, vpv = rpv;
            if (s > 0) { rpv = *(const GAS v4u*)(rp - 2048 + hc); kpv = *(const GAS v4u*)(rp - 2048 + 512 + hc); vpv = *(const GAS v4u*)(rp - 2048 + 1024 + hc); }
            const v4u lwv = *(const GAS v4u*)(P.LW + row * 512 + hc), aav = *(const GAS v4u*)(P.AA + row * 512 + hc);
            float r8[8], rp8[8], k8[8], kp8[8], v8[8], vp8[8], lw8[8], a8[8];
            unpack8(rc, r8); unpack8(rpv, rp8); unpack8(kc, k8); unpack8(kpv, kp8); unpack8(vc, v8); unpack8(vpv, vp8); unpack8(lwv, lw8); unpack8(aav, a8);
            float kk[8], ss = 0.f, rk = 0.f, wv[8], av[8], bv[8], kv[8], rv[8], vv[8];
#pragma unroll
            for (int j = 0; j < 8; ++j) { rv[j] = r8[j] + (rp8[j] - r8[j]) * mur[j]; const float ks = k8[j] + (kp8[j] - k8[j]) * muk[j];
                kk[j] = ks * kkw[j]; ss += kk[j] * kk[j]; kv[j] = ks * (1.f + (a8[j] - 1.f) * kaw[j]); rk += rv[j] * kv[j] * rkw[j];
                wv[j] = __builtin_amdgcn_exp2f(lw8[j] * LOG2E); vv[j] = v8[j] + (vp8[j] - v8[j]) * muv[j]; }
            ss = red8(ss); rk = red8(rk);
            const float rn = __builtin_amdgcn_rsqf(fmaxf(ss, 1e-24f));
#pragma unroll
            for (int j = 0; j < 8; ++j) { const float kn = kk[j] * rn; av[j] = -kn; bv[j] = kn * a8[j]; }
            if (P.layer == 0) { *(GAS v4u*)(P.VF + row * 512 + hc) = pack8(vv); }
            else { const v4u nuv = *(const GAS v4u*)(P.NU + row * 512 + hc), vfv = *(const GAS v4u*)(P.VF + row * 512 + hc); float nu8[8], vf8[8]; unpack8(nuv, nu8); unpack8(vfv, vf8);
#pragma unroll
                for (int j = 0; j < 8; ++j) vv[j] = vv[j] + (vf8[j] - vv[j]) * nu8[j]; }
            const int o = tok * 256 + c8 * 32;
            *(LAS f32x4*)(lds + SC_W + o) = (f32x4){wv[0], wv[1], wv[2], wv[3]}; *(LAS f32x4*)(lds + SC_W + o + 16) = (f32x4){wv[4], wv[5], wv[6], wv[7]};
            *(LAS f32x4*)(lds + SC_A + o) = (f32x4){av[0], av[1], av[2], av[3]}; *(LAS f32x4*)(lds + SC_A + o + 16) = (f32x4){av[4], av[5], av[6], av[7]};
            *(LAS f32x4*)(lds + SC_B + o) = (f32x4){bv[0], bv[1], bv[2], bv[3]}; *(LAS f32x4*)(lds + SC_B + o + 16) = (f32x4){bv[4], bv[5], bv[6], bv[7]};
            *(LAS f32x4*)(lds + SC_K + o) = (f32x4){kv[0], kv[1], kv[2], kv[3]}; *(LAS f32x4*)(lds + SC_K + o + 16) = (f32x4){kv[4], kv[5], kv[6], kv[7]};
            *(LAS f32x4*)(lds + SC_R + o) = (f32x4){rv[0], rv[1], rv[2], rv[3]}; *(LAS f32x4*)(lds + SC_R + o + 16) = (f32x4){rv[4], rv[5], rv[6], rv[7]};
            *(LAS f32x4*)(lds + SC_V + o) = (f32x4){vv[0], vv[1], vv[2], vv[3]}; *(LAS f32x4*)(lds + SC_V + o + 16) = (f32x4){vv[4], vv[5], vv[6], vv[7]};
            if (c8 == 0) *(LAS float*)(lds + SC_RK + tok * 4) = rk;
        }
        __syncthreads();
#pragma unroll 4
        for (int tk = 0; tk < 64; ++tk) {
            const int o = tk * 256 + c8 * 32;
            const f32x4 w0 = *(const LAS f32x4*)(lds + SC_W + o), w1 = *(const LAS f32x4*)(lds + SC_W + o + 16);
            const f32x4 a0 = *(const LAS f32x4*)(lds + SC_A + o), a1 = *(const LAS f32x4*)(lds + SC_A + o + 16);
            const f32x4 b0 = *(const LAS f32x4*)(lds + SC_B + o), b1 = *(const LAS f32x4*)(lds + SC_B + o + 16);
            const f32x4 k0 = *(const LAS f32x4*)(lds + SC_K + o), k1 = *(const LAS f32x4*)(lds + SC_K + o + 16);
            const f32x4 r0 = *(const LAS f32x4*)(lds + SC_R + o), r1 = *(const LAS f32x4*)(lds + SC_R + o + 16);
            const float vi = *(const LAS float*)(lds + SC_V + tk * 256 + i * 4);
            float sa = (S[0] * a0[0] + S[1] * a0[1]) + (S[2] * a0[2] + S[3] * a0[3]) + ((S[4] * a1[0] + S[5] * a1[1]) + (S[6] * a1[2] + S[7] * a1[3]));
            sa = red8(sa);
#pragma unroll
            for (int j = 0; j < 4; ++j) { S[j] = S[j] * w0[j] + (sa * b0[j] + vi * k0[j]); S[4 + j] = S[4 + j] * w1[j] + (sa * b1[j] + vi * k1[j]); }
            float y = (S[0] * r0[0] + S[1] * r0[1]) + (S[2] * r0[2] + S[3] * r0[3]) + ((S[4] * r1[0] + S[5] * r1[1]) + (S[6] * r1[2] + S[7] * r1[3]));
            y = red8(y);
            if (c8 == 0) *(LAS float*)(lds + SC_Y + tk * 256 + i * 4) = y;
        }
        __syncthreads();
        {
            const int tok = i; const size_t row = row0 + tile * 64 + tok;
            const f32x4 y0 = *(const LAS f32x4*)(lds + SC_Y + tok * 256 + c8 * 32), y1 = *(const LAS f32x4*)(lds + SC_Y + tok * 256 + c8 * 32 + 16);
            const f32x4 v0 = *(const LAS f32x4*)(lds + SC_V + tok * 256 + c8 * 32), v1 = *(const LAS f32x4*)(lds + SC_V + tok * 256 + c8 * 32 + 16);
            const float rk = *(const LAS float*)(lds + SC_RK + tok * 4);
            const v4u gv = *(const GAS v4u*)(P.GG + row * 512 + hc); float g8[8]; unpack8(gv, g8);
            float yy[8] = {y0[0], y0[1], y0[2], y0[3], y1[0], y1[1], y1[2], y1[3]}, vv[8] = {v0[0], v0[1], v0[2], v0[3], v1[0], v1[1], v1[2], v1[3]};
            float sm = 0.f;
#pragma unroll
            for (int j = 0; j < 8; ++j) sm += yy[j];
            const float mean = red8(sm) * (1.f / 64.f); float sq = 0.f;
#pragma unroll
            for (int j = 0; j < 8; ++j) { yy[j] -= mean; sq += yy[j] * yy[j]; }
            const float rstd = __builtin_amdgcn_rsqf(red8(sq) * (1.f / 64.f) + GN_EPS);
            float o8[8];
#pragma unroll
            for (int j = 0; j < 8; ++j) o8[j] = (yy[j] * rstd * tab[384 + 8 * c8 + j] + tab[448 + 8 * c8 + j] + rk * vv[j]) * g8[j];
            *(GAS v4u*)(P.YB + row * 512 + hc) = pack8(o8);
        }
        __syncthreads();
    }
}

__device__ __forceinline__ void route_phase(const float* LOG, unsigned* cnt, int* TOKE, int* TOKP, float* TOKW, int gt, int NT) {
    for (int m = gt; m < T; m += NT) {
        const float* lg = LOG + (size_t)m * 64;
        const f32x4 gl = *(const f32x4*)lg;
        int grp = 0; float gm = gl[0];
        if (gl[1] > gm) { gm = gl[1]; grp = 1; } if (gl[2] > gm) { gm = gl[2]; grp = 2; } if (gl[3] > gm) { gm = gl[3]; grp = 3; }
        const float se = __expf(gl[0] - gm) + __expf(gl[1] - gm) + __expf(gl[2] - gm) + __expf(gl[3] - gm);
        const float gate = 1.f / se;
        const f32x4 e0 = *(const f32x4*)(lg + 4 + grp * 8), e1 = *(const f32x4*)(lg + 8 + grp * 8);
        const float v[8] = {e0[0], e0[1], e0[2], e0[3], e1[0], e1[1], e1[2], e1[3]};
        int i0 = 0; float v0 = v[0];
#pragma unroll
        for (int j = 1; j < 8; ++j) if (v[j] > v0) { v0 = v[j]; i0 = j; }
        int i1 = -1; float v1 = -INFINITY;
#pragma unroll
        for (int j = 0; j < 8; ++j) if (j != i0 && (i1 < 0 || v[j] > v1)) { v1 = v[j]; i1 = j; }
        const float w0 = 1.f / (1.f + __expf(v1 - v0)), w1 = 1.f - w0;
        const int x0 = grp * 8 + i0, x1 = grp * 8 + i1;
        const unsigned p0 = __hip_atomic_fetch_add(cnt + x0, 1u, RLX_AGENT), p1 = __hip_atomic_fetch_add(cnt + x1, 1u, RLX_AGENT);
        TOKE[2 * m] = x0; TOKE[2 * m + 1] = x1; TOKP[2 * m] = (int)p0; TOKP[2 * m + 1] = (int)p1; TOKW[2 * m] = w0 * gate; TOKW[2 * m + 1] = w1 * gate;
    }
}
__device__ __forceinline__ void gather_phase(LAS unsigned char* lds, unsigned* cnt, unsigned* ntiles_w, int* TILE_E, const int* TOKE, const int* TOKP, int* TOKS, const bf16* XB, bf16* XG, int bx, int gw, int NGW, int tid) {
    LAS int* offs = (LAS int*)lds;
    if (tid == 0) { int o = 0; for (int e = 0; e < 32; ++e) { offs[e] = o; const unsigned c = __hip_atomic_load(cnt + e, RLX_AGENT); o += (int)((c + 255u) & ~255u); } offs[32] = o; }
    __syncthreads();
    if (bx == 0) { const int nt = offs[32] >> 8;
        for (int rt = tid; rt < nt; rt += NWAVES * 64) { int e = 0; while (e < 31 && offs[e + 1] <= rt * 256) ++e; TILE_E[rt] = e; }
        if (tid == 0) __hip_atomic_store(ntiles_w, (unsigned)nt, RLX_AGENT); }
    const int lane = tid & 63;
    for (int m = gw; m < T; m += NGW) {
        const int s0 = offs[TOKE[2 * m]] + TOKP[2 * m], s1 = offs[TOKE[2 * m + 1]] + TOKP[2 * m + 1];
        const GAS v4u* src = (const GAS v4u*)(XB + (size_t)m * D) + lane; const v4u a = src[0], c = src[64];
        GAS v4u* d0 = (GAS v4u*)(XG + (size_t)s0 * D) + lane; GAS v4u* d1 = (GAS v4u*)(XG + (size_t)s1 * D) + lane;
        d0[0] = a; d0[64] = c; d1[0] = a; d1[64] = c;
        if (lane == 0) { TOKS[2 * m] = s0; TOKS[2 * m + 1] = s1; }
    }
}

#ifndef MK_N_LAUNCHES
#define MK_N_LAUNCHES 1
#endif
constexpr int N_PHASES = 31;
struct Args { const float* in[34]; float* out; unsigned char* ws; int ph_lo, ph_hi; };
enum { I_X = 0, I_P, I_LNIN_G, I_LNIN_B, I_RELB, I_WIN, I_TOKMIX, I_DECB, I_DECUP, I_AAAB, I_AAAUP, I_GATEUP, I_KK, I_KA, I_RK, I_VRB, I_VRD, I_VRU, I_GNG, I_GNB,
       I_WBA, I_WBR, I_WOUT, I_RG, I_RGB, I_RE, I_REB, I_EG, I_EU, I_ED, I_PLEP, I_PLEG, I_LNG, I_LNB };

#ifndef EN_MASK
#define EN_MASK 0xFFFF
#endif
#define EN(k) (((EN_MASK) >> (k)) & 1)
#define IN(k) (lo <= (k) && (k) < hi)
#define SEAM(k) do { if (IN((k) + 1)) { XcdBarrier b_; b_.bar = (unsigned*)(ctl + CW_BAR); b_.x = xb_xcc_id(); b_.st = (volatile LAS unsigned*)(lds + MISC_OFF) + 8; xcd_barrier(b_, tid == 0); } } while (0)
#define PH_IDS \
    int tid = wv * 64 + (int)__builtin_amdgcn_mbcnt_hi(~0u, __builtin_amdgcn_mbcnt_lo(~0u, 0u)); asm volatile("" : "+v"(tid)); int bx = blockIdx.x, G = gridDim.x; asm volatile("" : "+s"(bx), "+s"(G)); \
    const int lane = tid & 63, wave = wv; \
    const int vcu = (G % 8 == 0) ? (bx % 8) * (G / 8) + bx / 8 : bx; \
    const int gw = bx * NWAVES + wave, NGW = G * NWAVES, gt = bx * (NWAVES * 64) + tid, NT = G * NWAVES * 64; \
    unsigned char* ws = args.ws; float* xres = args.out; bf16* XB = (bf16*)(ws + WS_XB); gu32* ctl = (gu32*)(ws + WS_CTL); \
    (void)lane; (void)wave; (void)vcu; (void)gw; (void)NGW; (void)gt; (void)NT; (void)xres; (void)XB; (void)ctl;
#define AIN(i) (args.in[i])
template <int l> __device__ __forceinline__ void layer_body(const Args& args, LAS unsigned char* lds, const int lo, const int hi, const int wv) {

        constexpr int pb = 1 + 15 * l;
#define wb (ws + WS_WNE + (size_t)l * WNE_LAYER)
#define WinT ((const bf16*)(wb + WNE_WIN))
        if (EN(1) && IN(pb + 0)) { PH_IDS
            { pg8::Gemm g{XB, WinT, T, 1024, 1024}; pg8::StaticOrder S; S.init(T, 1024, G, bx); pg8::EpiStore E{(bf16*)(ws + WS_QK), 1024, 1 << 30};
              pg8::gemm_phase<pg8::EpiStore, pg8::StaticOrder, true, true>(lds, g, S, E, wv); }
            { pg8::Gemm g{XB, WinT + (size_t)1536 * 1024, T, 2048, 1024}; pg8::StaticOrder S; S.init(T, 2048, G, bx); pg8::EpiStore E{(bf16*)(ws + WS_RKVL), 2048, 1 << 30};
              pg8::gemm_phase<pg8::EpiStore, pg8::StaticOrder, true, true>(lds, g, S, E, wv); }
            { pg8::Gemm g{WinT + (size_t)1024 * 1024, XB, 512, T, 1024}; pg8::StaticOrder S; S.init(512, T, G, bx); pg8::EpiStore E{(bf16*)(ws + WS_VT), T, 1 << 30};
              pg8::gemm_phase<pg8::EpiStore, pg8::StaticOrder, true, true>(lds, g, S, E, wv); }
            SEAM(pb + 0);
        }
        if (EN(2) && IN(pb + 1)) { PH_IDS
#ifndef DIS_ATTN
 attn_phase(lds, (const bf16*)(ws + WS_QK), (const bf16*)(ws + WS_VT), (bf16*)(ws + WS_YA), AIN(I_RELB), vcu, G, tid);
#endif
 SEAM(pb + 1); }
        if (EN(3) && IN(pb + 2)) { PH_IDS
            PrepArgs P{(const bf16*)(ws + WS_RKVL), (bf16*)(ws + WS_LW), (bf16*)(ws + WS_AA), (bf16*)(ws + WS_GG), (bf16*)(ws + WS_NU), AIN(I_TOKMIX) + l * 1824,
                       AIN(I_DECB) + l * 512, AIN(I_AAAB) + l * 512, AIN(I_VRB), (const bf16*)(ws + WS_DUT) + l * 32768, (const bf16*)(ws + WS_AUT) + l * 32768,
                       (const bf16*)(ws + WS_GUT) + l * 81920, (const bf16*)(ws + WS_VDT), (const bf16*)(ws + WS_VUT), l};
#ifndef DIS_PREP
            prep_phase(lds, P, vcu, G, tid);
#endif
 SEAM(pb + 2);
        }
        if (EN(4) && IN(pb + 3)) { PH_IDS
            if (bx < 128) { ScanArgs P{(const bf16*)(ws + WS_RKVL), (const bf16*)(ws + WS_LW), (const bf16*)(ws + WS_AA), (const bf16*)(ws + WS_GG), (const bf16*)(ws + WS_NU), (bf16*)(ws + WS_VF), (bf16*)(ws + WS_YB),
                            AIN(I_TOKMIX) + l * 1824, AIN(I_KK) + l * 512, AIN(I_KA) + l * 512, AIN(I_RK) + l * 512, AIN(I_GNG) + l * 512, AIN(I_GNB) + l * 512, l};

#ifndef DIS_SCAN
                scan_phase(lds, P, bx, tid);
#endif
 }
            SEAM(pb + 3);
        }
        if (EN(5) && IN(pb + 4)) { PH_IDS
            bf16* T1 = (bf16*)(ws + WS_T1); bf16* T2 = (bf16*)(ws + WS_T2); bf16* MP = (bf16*)(ws + WS_MP);
            { pg8::Gemm g{(const bf16*)(ws + WS_YA), (const bf16*)(wb + WNE_WBA), T, 1024, 512}; pg8::StaticOrder S; S.init(T, 1024, G, bx); pg8::EpiStore E{T1, 1024, 1 << 30};
              pg8::gemm_phase<pg8::EpiStore, pg8::StaticOrder, true, true>(lds, g, S, E, wv); }
            { pg8::Gemm g{XB, WinT + (size_t)3584 * 1024, T, 1024, 1024}; pg8::StaticOrder S; S.init(T, 1024, G, bx); pg8::EpiGate<0> E{T1, nullptr, T1, 1024};
              pg8::gemm_phase<pg8::EpiGate<0>, pg8::StaticOrder, true, true>(lds, g, S, E, wv); }
            { pg8::Gemm g{(const bf16*)(ws + WS_YB), (const bf16*)(wb + WNE_WBR), T, 1024, 512}; pg8::StaticOrder S; S.init(T, 1024, G, bx); pg8::EpiStore E{T2, 1024, 1 << 30};
              pg8::gemm_phase<pg8::EpiStore, pg8::StaticOrder, true, true>(lds, g, S, E, wv); }
            { pg8::Gemm g{XB, WinT + (size_t)4608 * 1024, T, 1024, 1024}; pg8::StaticOrder S; S.init(T, 1024, G, bx); pg8::EpiGate<1> E{T1, T2, MP, 1024};
              pg8::gemm_phase<pg8::EpiGate<1>, pg8::StaticOrder, true, true>(lds, g, S, E, wv); }
            SEAM(pb + 4);
        }
        if (EN(6) && IN(pb + 5)) { PH_IDS
            pg8::Gemm g{(const bf16*)(ws + WS_MP), (const bf16*)(wb + WNE_WOUT), T, 1024, 1024}; pg8::StaticOrder S; S.init(T, 1024, G, bx); pg8::EpiRes<0> E{xres, nullptr, 1024, ALPHA};
            pg8::gemm_phase<pg8::EpiRes<0>, pg8::StaticOrder, true, true>(lds, g, S, E, wv);
            SEAM(pb + 5);
        }
        if (EN(7) && IN(pb + 6)) { PH_IDS
            ln_pass<0, true>(xres, xres, XB, AIN(I_LNG) + (l * 3 + 0) * 1024, AIN(I_LNB) + (l * 3 + 0) * 1024, nullptr, nullptr, nullptr, gw, NGW, lane);
            LAS float* scr = (LAS float*)(lds + wave * 16384);
            bf16* EGU = (bf16*)(ws + WS_EGU); bf16* EDN = (bf16*)(ws + WS_EDN);
            for (int it = gw; it < 3 * 4096; it += NGW) {
                const int which = it >> 12, r = it & 4095, e = r >> 7, rr = r & 127;
                if (which < 2) { const int kb = rr >> 3, nb = rr & 7, n0 = 32 * nb;
                    transpose_item(AIN(which == 0 ? I_EG : I_EU) + ((size_t)(l * 32 + e) << 18), 256, 64 * kb, n0, EGU, 1024, e * 512 + (n0 >> 7) * 256 + which * 128 + (n0 & 127), scr, lane); }
                else { const int kb = rr >> 5, nb = rr & 31; transpose_item(AIN(I_ED) + ((size_t)(l * 32 + e) << 18), 1024, 64 * kb, 32 * nb, EDN, 256, e * 1024 + 32 * nb, scr, lane); }
            }
            { const float* psrc = AIN(I_P) + (size_t)l * T * 256; bf16* PB = (bf16*)(ws + WS_PB);
              for (int i = gt; i < T * 256 / 4; i += NT) { const f32x4 v = *(const GAS f32x4*)(psrc + (size_t)i * 4); v2u w; w.x = pk2(v.x, v.y); w.y = pk2(v.z, v.w); *(GAS v2u*)(PB + (size_t)i * 4) = w; } }
            SEAM(pb + 6);
        }
        if (EN(8) && IN(pb + 7)) { PH_IDS
            pg8::Gemm g{XB, (const bf16*)(ws + WS_RWT) + (size_t)l * 256 * 1024, T, 256, 1024}; pg8::StaticOrder S; S.init(T, 256, G, bx); pg8::EpiRouter E{(float*)(ws + WS_LOG), (const float*)(ws + WS_RB) + l * 64};
            pg8::gemm_phase<pg8::EpiRouter, pg8::StaticOrder, true, true>(lds, g, S, E, wv);
            SEAM(pb + 7);
        }
        if (EN(9) && IN(pb + 8)) { PH_IDS route_phase((const float*)(ws + WS_LOG), (unsigned*)(ctl + CW_CNT + 64 * l), (int*)(ws + WS_TOKE), (int*)(ws + WS_TOKP), (float*)(ws + WS_TOKW), gt, NT); SEAM(pb + 8); }
        if (EN(10) && IN(pb + 9)) { PH_IDS gather_phase(lds, (unsigned*)(ctl + CW_CNT + 64 * l), (unsigned*)(ctl + CW_NTILES + 64 * l), (int*)(ws + WS_TILE), (const int*)(ws + WS_TOKE), (const int*)(ws + WS_TOKP), (int*)(ws + WS_TOKS), XB, (bf16*)(ws + WS_XG), bx, gw, NGW, tid); SEAM(pb + 9); }
        if (EN(11) && IN(pb + 10)) { PH_IDS
            const int ntiles = __builtin_amdgcn_readfirstlane((int)__hip_atomic_load((unsigned*)(ctl + CW_NTILES + 64 * l), RLX_AGENT));
            pg8::Gemm g{(const bf16*)(ws + WS_XG), (const bf16*)(ws + WS_EGU), 0, 0, 1024}; pg8::MoeOrder S; S.init((const int*)(ws + WS_TILE), ntiles, 2, G, bx); pg8::EpiSwiglu E{(bf16*)(ws + WS_H)};
            pg8::gemm_phase<pg8::EpiSwiglu, pg8::MoeOrder, true, true>(lds, g, S, E, wv);
            SEAM(pb + 10);
        }
        if (EN(12) && IN(pb + 11)) { PH_IDS
            const int ntiles = __builtin_amdgcn_readfirstlane((int)__hip_atomic_load((unsigned*)(ctl + CW_NTILES + 64 * l), RLX_AGENT));
            pg8::Gemm g{(const bf16*)(ws + WS_H), (const bf16*)(ws + WS_EDN), 0, 0, 256}; pg8::MoeOrder S; S.init((const int*)(ws + WS_TILE), ntiles, 4, G, bx); pg8::EpiStore E{(bf16*)(ws + WS_XG), 1024, 4};
            pg8::gemm_phase<pg8::EpiStore, pg8::MoeOrder, true, true>(lds, g, S, E, wv);
            SEAM(pb + 11);
        }
        if (EN(13) && IN(pb + 12)) { PH_IDS
            ln_pass<2, true>(xres, xres, XB, AIN(I_LNG) + (l * 3 + 1) * 1024, AIN(I_LNB) + (l * 3 + 1) * 1024, (const bf16*)(ws + WS_XG), (const int*)(ws + WS_TOKS), (const float*)(ws + WS_TOKW), gw, NGW, lane);
            SEAM(pb + 12);
        }
        if (EN(14) && IN(pb + 13)) { PH_IDS
            bf16* TP = (bf16*)(ws + WS_TP);
            { pg8::Gemm g{(const bf16*)(ws + WS_PB), (const bf16*)(wb + WNE_WPLE), T, 1024, 256}; pg8::StaticOrder S; S.init(T, 1024, G, bx); pg8::EpiStore E{TP, 1024, 1 << 30};
              pg8::gemm_phase<pg8::EpiStore, pg8::StaticOrder, true, true>(lds, g, S, E, wv); }
            { pg8::Gemm g{XB, (const bf16*)(wb + WNE_WPG), T, 1024, 1024}; pg8::StaticOrder S; S.init(T, 1024, G, bx); pg8::EpiRes<1> E{xres, TP, 1024, ALPHA};
              pg8::gemm_phase<pg8::EpiRes<1>, pg8::StaticOrder, true, true>(lds, g, S, E, wv); }
            SEAM(pb + 13);
        }
        if (EN(15) && IN(pb + 14)) { PH_IDS
            ln_pass<0, true>(xres, xres, XB, AIN(I_LNG) + (l * 3 + 2) * 1024, AIN(I_LNB) + (l * 3 + 2) * 1024, nullptr, nullptr, nullptr, gw, NGW, lane);
            if (l == 0) SEAM(pb + 14);
        }

}
#undef wb
#undef WinT
__global__ void __launch_bounds__(NWAVES * 64, 2) mega_fwd(Args args) {
    extern __shared__ __attribute__((aligned(16))) unsigned char lds_raw[];
    LAS unsigned char* lds = (LAS unsigned char*)lds_raw;
    for (int u = threadIdx.x; u < (LDS_BYTES - RING_BYTES) / 4; u += NWAVES * 64) ((LAS unsigned*)(lds + RING_BYTES))[u] = 0u;
    __syncthreads();
    (void)xcd_barrier_post((unsigned*)(args.ws + WS_CTL) + CW_BAR, (volatile LAS unsigned*)(lds + MISC_OFF) + 8);
    const int lo = args.ph_lo, hi = args.ph_hi, wv = __builtin_amdgcn_readfirstlane(threadIdx.x >> 6);

    if (EN(0) && IN(0)) { PH_IDS
        LAS float* scr = (LAS float*)(lds + wave * 16384);
        constexpr int I_WINL = 16 * 169, I_BR = 8 * 32, I_SQ = 16 * 32, I_PLE = 4 * 32, I_LAYER = I_WINL + 2 * I_BR + 2 * I_SQ + I_PLE;
        for (int it = gw; it < 2 * I_LAYER; it += NGW) {
            const int l = it / I_LAYER; int r = it - l * I_LAYER; unsigned char* wb_ = ws + WS_WNE + (size_t)l * WNE_LAYER;
            if (r < I_WINL) { const int kb = r / 169, nb = r - kb * 169, n0 = 32 * nb; transpose_item(AIN(I_WIN) + (size_t)l * 1024 * 5408, 5408, 64 * kb, n0, (bf16*)(wb_ + WNE_WIN), 1024, n0 + (n0 >= 3360 ? 224 : 0), scr, lane); continue; } r -= I_WINL;
            if (r < I_BR) { const int kb = r / 32, nb = r & 31; transpose_item(AIN(I_WBA) + (size_t)l * 512 * 1024, 1024, 64 * kb, 32 * nb, (bf16*)(wb_ + WNE_WBA), 512, 32 * nb, scr, lane); continue; } r -= I_BR;
            if (r < I_BR) { const int kb = r / 32, nb = r & 31; transpose_item(AIN(I_WBR) + (size_t)l * 512 * 1024, 1024, 64 * kb, 32 * nb, (bf16*)(wb_ + WNE_WBR), 512, 32 * nb, scr, lane); continue; } r -= I_BR;
            if (r < I_SQ) { const int kb = r / 32, nb = r & 31; transpose_item(AIN(I_WOUT) + (size_t)l * 1024 * 1024, 1024, 64 * kb, 32 * nb, (bf16*)(wb_ + WNE_WOUT), 1024, 32 * nb, scr, lane); continue; } r -= I_SQ;
            if (r < I_SQ) { const int kb = r / 32, nb = r & 31; transpose_item(AIN(I_PLEG) + (size_t)l * 1024 * 1024, 1024, 64 * kb, 32 * nb, (bf16*)(wb_ + WNE_WPG), 1024, 32 * nb, scr, lane); continue; } r -= I_SQ;
            { const int kb = r / 32, nb = r & 31; transpose_item(AIN(I_PLEP) + (size_t)l * 256 * 1024, 1024, 64 * kb, 32 * nb, (bf16*)(wb_ + WNE_WPLE), 256, 32 * nb, scr, lane); }
        }
        for (int i = gt; i < 2 * 224 * 1024 / 8; i += NT) { const int l = i / (224 * 128), r = i - l * (224 * 128);
            *(GAS v4u*)(ws + WS_WNE + (size_t)l * WNE_LAYER + WNE_WIN + (size_t)3360 * 2048 + (size_t)r * 16) = (v4u){0u, 0u, 0u, 0u}; }
        { bf16* RWT = (bf16*)(ws + WS_RWT);
          for (int i = gt; i < 2 * 256 * 1024; i += NT) { const int l = i >> 18, n = (i >> 10) & 255, k = i & 1023;
              const float v = n < 4 ? AIN(I_RG)[l * 4096 + k * 4 + n] : n < 36 ? AIN(I_RE)[l * 32768 + k * 32 + (n - 4)] : 0.f; RWT[i] = (bf16)f2bf(v); } }
        { float* RB = (float*)(ws + WS_RB); if (gt < 128) { const int l = gt >> 6, n = gt & 63; RB[gt] = n < 4 ? AIN(I_RGB)[l * 4 + n] : n < 36 ? AIN(I_REB)[l * 32 + n - 4] : 0.f; } }
        { bf16* DUT = (bf16*)(ws + WS_DUT); bf16* AUT = (bf16*)(ws + WS_AUT);
          for (int i = gt; i < 2 * 512 * 64; i += NT) { const int l = i >> 15, n = (i >> 6) & 511, k = i & 63;
              DUT[i] = (bf16)f2bf(AIN(I_DECUP)[l * 32768 + k * 512 + n]); AUT[i] = (bf16)f2bf(AIN(I_AAAUP)[l * 32768 + k * 512 + n]); } }
        { bf16* GUT = (bf16*)(ws + WS_GUT);
          for (int i = gt; i < 2 * 512 * 160; i += NT) { const int l = i / 81920, r = i - l * 81920, n = r / 160, k = r - n * 160; GUT[i] = (bf16)f2bf(AIN(I_GATEUP)[l * 81920 + k * 512 + n]); } }
        { bf16* VDT = (bf16*)(ws + WS_VDT); bf16* VUT = (bf16*)(ws + WS_VUT);
          for (int i = gt; i < 16384; i += NT) { VDT[i] = (bf16)f2bf(AIN(I_VRD)[(i & 511) * 32 + (i >> 9)]); VUT[i] = (bf16)f2bf(AIN(I_VRU)[(i & 31) * 512 + (i >> 5)]); } }
        ln_pass<0, true>(AIN(I_X), xres, XB, AIN(I_LNIN_G), AIN(I_LNIN_B), nullptr, nullptr, nullptr, gw, NGW, lane);
        SEAM(0);
    }

    layer_body<0>(args, lds, lo, hi, wv);
    layer_body<1>(args, lds, lo, hi, wv);
#undef IN
#undef SEAM
}

extern "C" void kernel_launch(void* const* d_in, const int* in_sizes, int n_in, void* d_out, int out_size, void* d_ws, size_t ws_size, hipStream_t stream) {
    static int grid = 0;
    if (grid == 0) {
        if (n_in != 34 || out_size != T * D || ws_size < WS_END) { fprintf(stderr, "kernel_launch: unexpected shapes (n_in %d out %d ws %zu)\n", n_in, out_size, ws_size); grid = -1; return; }
        int dev = 0, cus = 0, per_cu = 0;
        if (hipGetDevice(&dev) != hipSuccess || hipDeviceGetAttribute(&cus, hipDeviceAttributeMultiprocessorCount, dev) != hipSuccess) { grid = -1; return; }
        if (hipFuncSetAttribute((const void*)mega_fwd, hipFuncAttributeMaxDynamicSharedMemorySize, LDS_BYTES) != hipSuccess) { fprintf(stderr, "kernel_launch: hipFuncSetAttribute failed\n"); grid = -1; return; }
        if (hipOccupancyMaxActiveBlocksPerMultiprocessor(&per_cu, (const void*)mega_fwd, NWAVES * 64, LDS_BYTES) != hipSuccess || per_cu < 1) fprintf(stderr, "kernel_launch: occupancy query reports %d\n", per_cu);
        (void)hipGetLastError();
        grid = cus;
    }
    if (grid < 0) return;
    if (hipMemsetAsync((char*)d_ws + WS_CTL, 0, CTL_ZERO_BYTES, stream) != hipSuccess) return;
    Args a{};
    for (int i = 0; i < 34; ++i) a.in[i] = (const float*)d_in[i];
    a.out = (float*)d_out; a.ws = (unsigned char*)d_ws;
#if MK_N_LAUNCHES == 1
    a.ph_lo = 0; a.ph_hi = N_PHASES;
    hipLaunchKernelGGL(mega_fwd, dim3(grid), dim3(NWAVES * 64), LDS_BYTES, stream, a);
#else
    for (int p = 0; p < N_PHASES; ++p) { a.ph_lo = p; a.ph_hi = p + 1; hipLaunchKernelGGL(mega_fwd, dim3(grid), dim3(NWAVES * 64), LDS_BYTES, stream, a); }
#endif
}
```

```cpp
#include <hip/hip_runtime.h>
#include <cstdio>
#include <cstdint>
#include <cmath>
namespace pg8 {
#define PG8_LAS __attribute__((address_space(3)))
typedef unsigned short bf16_t;
typedef short bf16x8 __attribute__((ext_vector_type(8)));
typedef float f32x4 __attribute__((ext_vector_type(4)));
typedef unsigned u32x4 __attribute__((ext_vector_type(4)));
constexpr int BM = 256, BK = 64, HALF = 128, HTB = HALF * BK * 2  , STAGE_BYTES = 8 * HTB, NXCD = 8, WGM = 8;

__host__ __device__ __forceinline__ int lds_byte(int r, int c) { const int st = (r >> 4) * 2 + (c >> 5), rr = r & 15, cc = c & 31, ob = rr * 64 + cc * 2; return st * 1024 + (ob ^ (((ob >> 9) & 1) << 5)); }
__host__ __device__ __forceinline__ void stage_rc(int b, int& R, int& C) { const int st = b / 1024, sb = b % 1024, swz = sb ^ (((sb >> 9) & 1) << 5); R = (st >> 1) * 16 + swz / 64; C = (st & 1) * 32 + (swz % 64) / 2; }
__host__ __device__ __forceinline__ int perm32(int rho) { const int n = rho >> 4, i = rho & 15; return 8 * (i >> 2) + 4 * n + (i & 3); }

struct Unit { int pm, pn; };
struct Gemm { const bf16_t* A; const bf16_t* Bt; int M, N, K; const int* rows; };

struct StaticOrder {
    int nM, nN, nwg, G, c;
    __host__ __device__ __forceinline__ void init(int M, int N, int G_, int c_) { nM = M / BM; nN = N / BM; nwg = nM * nN; G = G_; c = c_; }
    __host__ __device__ __forceinline__ bool next(int i, Unit& u) const {
        const long L = (long)i * G + c; if (L >= nwg) return false;
        int wgid = (int)L; { const int q = nwg / NXCD, r = nwg % NXCD, xcd = wgid % NXCD, off = wgid / NXCD; wgid = (xcd < r ? xcd * (q + 1) : r * (q + 1) + (xcd - r) * q) + off; }
        const int nig = WGM * nN, gid = wgid / nig, fm = gid * WGM, gsz = (nM - fm) < WGM ? (nM - fm) : WGM;
        u.pm = fm + ((wgid % nig) % gsz); u.pn = (wgid % nig) / gsz; return true;
    }
    __device__ __forceinline__ void a_ready(const Unit&) const {}
    __device__ __forceinline__ void done(const Unit&) const {}
};
__device__ __forceinline__ unsigned cvt_pk_bf16(float lo, float hi) { unsigned r; asm volatile("v_cvt_pk_bf16_f32 %0, %1, %2" : "=v"(r) : "v"(lo), "v"(hi)); return r; }
typedef float f32x2 __attribute__((ext_vector_type(2)));
typedef unsigned u32x2 __attribute__((ext_vector_type(2)));
__device__ __forceinline__ float bf_lo(unsigned w) { return __uint_as_float(w << 16); }
__device__ __forceinline__ float bf_hi(unsigned w) { return __uint_as_float(w & 0xffff0000u); }
__device__ __forceinline__ float sigm(float x) { return __builtin_amdgcn_rcpf(1.0f + __builtin_amdgcn_exp2f(-1.44269504f * x)); }

template <int PNMASK, bool LIMIT> struct EpiStoreT {
    static constexpr bool PERM = true, AFTER_DRAIN = false; static constexpr int EPI_VM = LIMIT ? 0 : 16;
    bf16_t* O; int ldc; int ncols;
    __device__ __forceinline__ void operator()(const f32x4 (&acc)[2][2][4][2], const Unit& u, int wr, int wc, int fr, int fq) const {
        const int row0 = u.pm * BM + wr * 64 + fr, col0 = (u.pn & PNMASK) * BM + wc * 32 + 8 * fq;
#pragma unroll
        for (int ai = 0; ai < 2; ++ai)
#pragma unroll
            for (int m = 0; m < 4; ++m) { bf16_t* rowp = O + (size_t)(row0 + ai * HALF + m * 16) * ldc + col0;
#pragma unroll
                for (int bj = 0; bj < 2; ++bj) { const f32x4 v0 = acc[ai][bj][m][0], v1 = acc[ai][bj][m][1];
                    u32x4 w; w.x = cvt_pk_bf16(v0[0], v0[1]); w.y = cvt_pk_bf16(v0[2], v0[3]); w.z = cvt_pk_bf16(v1[0], v1[1]); w.w = cvt_pk_bf16(v1[2], v1[3]);
                    if (!LIMIT || col0 + bj * HALF < ncols) {
                        *(u32x4*)(rowp + bj * HALF) = w;
                    } } }
    }
};
typedef EpiStoreT<-1, false> EpiStore;
struct EpiNull {
    static constexpr bool PERM = true, AFTER_DRAIN = false; static constexpr int EPI_VM = 0;
    float* sink;
    __device__ __forceinline__ void operator()(const f32x4 (&acc)[2][2][4][2], const Unit& u, int wr, int wc, int fr, int fq) const {
        float s = 0.f;
#pragma unroll
        for (int ai = 0; ai < 2; ++ai)
#pragma unroll
            for (int m = 0; m < 4; ++m)
#pragma unroll
                for (int bj = 0; bj < 2; ++bj) { const f32x4 a = acc[ai][bj][m][0] + acc[ai][bj][m][1]; s += (a[0] + a[1]) + (a[2] + a[3]); }
        if (s == 1.2345e30f) *sink = s;
    }
};
template <int MODE> struct EpiGate {
    static constexpr bool PERM = true, AFTER_DRAIN = false; static constexpr int EPI_VM = 16;
    const bf16_t* T1; const bf16_t* T2; bf16_t* O; int ldc;
    __device__ __forceinline__ void operator()(const f32x4 (&acc)[2][2][4][2], const Unit& u, int wr, int wc, int fr, int fq) const {
        const int row0 = u.pm * BM + wr * 64 + fr, col0 = u.pn * BM + wc * 32 + 8 * fq;
#pragma unroll
        for (int ai = 0; ai < 2; ++ai)
#pragma unroll
            for (int m = 0; m < 4; ++m) { const size_t off = (size_t)(row0 + ai * HALF + m * 16) * ldc + col0;
#pragma unroll
                for (int bj = 0; bj < 2; ++bj) { const f32x4 v0 = acc[ai][bj][m][0], v1 = acc[ai][bj][m][1];
                    const u32x4 a = *(const u32x4*)(T1 + off + bj * HALF);
                    float r[8];
                    if (MODE == 0) {
                        r[0] = sigm(v0[0]) * bf_lo(a.x); r[1] = sigm(v0[1]) * bf_hi(a.x); r[2] = sigm(v0[2]) * bf_lo(a.y); r[3] = sigm(v0[3]) * bf_hi(a.y);
                        r[4] = sigm(v1[0]) * bf_lo(a.z); r[5] = sigm(v1[1]) * bf_hi(a.z); r[6] = sigm(v1[2]) * bf_lo(a.w); r[7] = sigm(v1[3]) * bf_hi(a.w);
                    } else {
                        const u32x4 b = *(const u32x4*)(T2 + off + bj * HALF);
                        r[0] = bf_lo(a.x) + sigm(v0[0]) * bf_lo(b.x); r[1] = bf_hi(a.x) + sigm(v0[1]) * bf_hi(b.x); r[2] = bf_lo(a.y) + sigm(v0[2]) * bf_lo(b.y); r[3] = bf_hi(a.y) + sigm(v0[3]) * bf_hi(b.y);
                        r[4] = bf_lo(a.z) + sigm(v1[0]) * bf_lo(b.z); r[5] = bf_hi(a.z) + sigm(v1[1]) * bf_hi(b.z); r[6] = bf_lo(a.w) + sigm(v1[2]) * bf_lo(b.w); r[7] = bf_hi(a.w) + sigm(v1[3]) * bf_hi(b.w);
                    }
                    u32x4 w; w.x = cvt_pk_bf16(r[0], r[1]); w.y = cvt_pk_bf16(r[2], r[3]); w.z = cvt_pk_bf16(r[4], r[5]); w.w = cvt_pk_bf16(r[6], r[7]);
                    *(u32x4*)(O + off + bj * HALF) = w; } }
    }
};
template <int MODE> struct EpiRes {
    static constexpr bool PERM = true, AFTER_DRAIN = false; static constexpr int EPI_VM = 16;
    const bf16_t* XB; bf16_t* OUT; const bf16_t* TP; int ldc; float alpha;
    __device__ __forceinline__ void operator()(const f32x4 (&acc)[2][2][4][2], const Unit& u, int wr, int wc, int fr, int fq) const {
        const int row0 = u.pm * BM + wr * 64 + fr, col0 = u.pn * BM + wc * 32 + 8 * fq;
#pragma unroll
        for (int ai = 0; ai < 2; ++ai)
#pragma unroll
            for (int mp = 0; mp < 2; ++mp) {
            u32x4 xbv[2][2], tv[2][2];
#pragma unroll
            for (int mm = 0; mm < 2; ++mm)
#pragma unroll
                for (int bj = 0; bj < 2; ++bj) { const size_t off = (size_t)(row0 + ai * HALF + (2 * mp + mm) * 16) * ldc + col0 + bj * HALF; xbv[mm][bj] = *(const u32x4*)(XB + off); if (MODE == 1) tv[mm][bj] = *(const u32x4*)(TP + off); }
            asm volatile("" ::: "memory");
#pragma unroll
            for (int mm = 0; mm < 2; ++mm) { const int m = 2 * mp + mm; const size_t off = (size_t)(row0 + ai * HALF + m * 16) * ldc + col0;
#pragma unroll
                for (int bj = 0; bj < 2; ++bj) { const f32x4 v0 = acc[ai][bj][m][0], v1 = acc[ai][bj][m][1];
                    const u32x4 xb = xbv[mm][bj];
                    float a[8] = {v0[0], v0[1], v0[2], v0[3], v1[0], v1[1], v1[2], v1[3]};
                    if (MODE == 1) { const u32x4 t = tv[mm][bj];
                        a[0] = bf_lo(t.x) * sigm(a[0]); a[1] = bf_hi(t.x) * sigm(a[1]); a[2] = bf_lo(t.y) * sigm(a[2]); a[3] = bf_hi(t.y) * sigm(a[3]);
                        a[4] = bf_lo(t.z) * sigm(a[4]); a[5] = bf_hi(t.z) * sigm(a[5]); a[6] = bf_lo(t.w) * sigm(a[6]); a[7] = bf_hi(t.w) * sigm(a[7]); }
                    u32x4 w;
                    w.x = cvt_pk_bf16(bf_lo(xb.x) * alpha + a[0], bf_hi(xb.x) * alpha + a[1]); w.y = cvt_pk_bf16(bf_lo(xb.y) * alpha + a[2], bf_hi(xb.y) * alpha + a[3]);
                    w.z = cvt_pk_bf16(bf_lo(xb.z) * alpha + a[4], bf_hi(xb.z) * alpha + a[5]); w.w = cvt_pk_bf16(bf_lo(xb.w) * alpha + a[6], bf_hi(xb.w) * alpha + a[7]);
                    *(u32x4*)(OUT + off + bj * HALF) = w; } }
            asm volatile("" ::: "memory"); }
    }
};
struct EpiRouter {
    static constexpr bool PERM = false, AFTER_DRAIN = false; static constexpr int EPI_VM = 0;
    float* LOG; const float* bias;
    __device__ __forceinline__ void operator()(const f32x4 (&acc)[2][2][4][2], const Unit& u, int wr, int wc, int fr, int fq) const {
        if (wc >= 2) return;
        const int row0 = u.pm * BM + wr * 64 + fr, col0 = wc * 32 + 4 * fq;
        const f32x4 b0 = *(const f32x4*)(bias + col0), b1 = *(const f32x4*)(bias + col0 + 16);
#pragma unroll
        for (int ai = 0; ai < 2; ++ai)
#pragma unroll
            for (int m = 0; m < 4; ++m) { float* p = LOG + (size_t)(row0 + ai * HALF + m * 16) * 64 + col0;
                *(f32x4*)p = acc[ai][0][m][0] + b0; *(f32x4*)(p + 16) = acc[ai][0][m][1] + b1; }
    }
};
struct EpiGate2 {
    static constexpr bool PERM = true, AFTER_DRAIN = false;
    const bf16_t* T1; const bf16_t* T2; bf16_t* O; int ldc;
    __device__ __forceinline__ void operator()(const f32x4 (&acc)[2][2][4][2], const Unit& u, int wr, int wc, int fr, int fq) const {
        const int row0 = u.pm * BM + wr * 64 + fr, col0 = u.pn * HALF + wc * 32 + 8 * fq;
#pragma unroll
        for (int ai = 0; ai < 2; ++ai) {
            u32x4 t1v[4], t2v[4];
#pragma unroll
            for (int m = 0; m < 4; ++m) { const size_t off = (size_t)(row0 + ai * HALF + m * 16) * ldc + col0; t1v[m] = *(const u32x4*)(T1 + off); t2v[m] = *(const u32x4*)(T2 + off); }
            asm volatile("" ::: "memory");
#pragma unroll
            for (int m = 0; m < 4; ++m) { const size_t off = (size_t)(row0 + ai * HALF + m * 16) * ldc + col0;
                const f32x4 a0 = acc[ai][0][m][0], a1 = acc[ai][0][m][1], b0 = acc[ai][1][m][0], b1 = acc[ai][1][m][1];
                const u32x4 t1 = t1v[m], t2 = t2v[m];
                float r[8];
                r[0] = sigm(a0[0]) * bf_lo(t1.x) + sigm(b0[0]) * bf_lo(t2.x); r[1] = sigm(a0[1]) * bf_hi(t1.x) + sigm(b0[1]) * bf_hi(t2.x);
                r[2] = sigm(a0[2]) * bf_lo(t1.y) + sigm(b0[2]) * bf_lo(t2.y); r[3] = sigm(a0[3]) * bf_hi(t1.y) + sigm(b0[3]) * bf_hi(t2.y);
                r[4] = sigm(a1[0]) * bf_lo(t1.z) + sigm(b1[0]) * bf_lo(t2.z); r[5] = sigm(a1[1]) * bf_hi(t1.z) + sigm(b1[1]) * bf_hi(t2.z);
                r[6] = sigm(a1[2]) * bf_lo(t1.w) + sigm(b1[2]) * bf_lo(t2.w); r[7] = sigm(a1[3]) * bf_hi(t1.w) + sigm(b1[3]) * bf_hi(t2.w);
                u32x4 w; w.x = cvt_pk_bf16(r[0], r[1]); w.y = cvt_pk_bf16(r[2], r[3]); w.z = cvt_pk_bf16(r[4], r[5]); w.w = cvt_pk_bf16(r[6], r[7]);
                *(u32x4*)(O + off) = w; }
            asm volatile("" ::: "memory"); }
    }
};
struct GateOrder {
    StaticOrder base;
    __device__ __forceinline__ void init(int M, int G_, int c_) { base.init(M, 1024, G_, c_); }
    __device__ __forceinline__ bool next(int i, Unit& u) const { Unit t; if (!base.next(i >> 1, t)) return false; u.pm = t.pm; u.pn = 2 * t.pn + (i & 1); return true; }
    __device__ __forceinline__ void a_ready(const Unit&) const {}
    __device__ __forceinline__ void done(const Unit&) const {}
};
struct EpiSwiglu {
    static constexpr bool PERM = true, AFTER_DRAIN = false; static constexpr int EPI_VM = 8;
    bf16_t* H;
    __device__ __forceinline__ void operator()(const f32x4 (&acc)[2][2][4][2], const Unit& u, int wr, int wc, int fr, int fq) const {
        const int row0 = u.pm * BM + wr * 64 + fr, col0 = (u.pn & 1) * HALF + wc * 32 + 8 * fq;
#pragma unroll
        for (int ai = 0; ai < 2; ++ai)
#pragma unroll
            for (int m = 0; m < 4; ++m) { bf16_t* rowp = H + (size_t)(row0 + ai * HALF + m * 16) * 256 + col0;
                const f32x4 g0 = acc[ai][0][m][0], g1 = acc[ai][0][m][1], u0 = acc[ai][1][m][0], u1 = acc[ai][1][m][1];
                float r[8];
#pragma unroll
                for (int q = 0; q < 4; ++q) { r[q] = g0[q] * sigm(g0[q]) * u0[q]; r[4 + q] = g1[q] * sigm(g1[q]) * u1[q]; }
                u32x4 w; w.x = cvt_pk_bf16(r[0], r[1]); w.y = cvt_pk_bf16(r[2], r[3]); w.z = cvt_pk_bf16(r[4], r[5]); w.w = cvt_pk_bf16(r[6], r[7]);
                *(u32x4*)rowp = w; }
    }
};
struct MoeOrder {
    const PG8_LAS int* tile_e; int nunits, npn, G, c;
    const PG8_LAS int* offs; const PG8_LAS int* cnts; const int* elist;
    __device__ __forceinline__ void init(const PG8_LAS int* te, int ntiles, int npn_, int G_, int c_) { tile_e = te; npn = npn_; nunits = ntiles * npn_; G = G_; c = c_; offs = nullptr; cnts = nullptr; elist = nullptr; }
    __device__ __forceinline__ bool next(int i, Unit& u) const {
        int L;
        if ((G & 7) == 0) { const int x = c & 7, k = c >> 3, q = nunits >> 3, r = nunits & 7, len = q + (x < r ? 1 : 0), loc = i * (G >> 3) + k; if (loc >= len) return false; L = x * q + (x < r ? x : r) + loc; }
        else { L = i * G + c; if (L >= nunits) return false; }
        const int rt = L / npn, pn = L - rt * npn;
        const int e = __builtin_amdgcn_readfirstlane(tile_e[rt]);
        u.pm = rt; u.pn = e * npn + pn; return true;
    }
    __device__ __forceinline__ int src_row(const Unit& u, int rr) const {
        const int e = u.pn / npn; int loc = u.pm * 256 - offs[e] + rr; const int lim = cnts[e] - 1; loc = loc < lim ? loc : lim;
        return elist[e * 32768 + loc];
    }
    __device__ __forceinline__ void a_ready(const Unit&) const {}
    __device__ __forceinline__ void done(const Unit&) const {}
};
struct MoeOrderPub : MoeOrder {
    unsigned* cnt;
    __device__ __forceinline__ void done(const Unit& u) const {
        asm volatile("s_waitcnt vmcnt(0)" ::: "memory");
        if ((int)__builtin_amdgcn_mbcnt_hi(~0u, __builtin_amdgcn_mbcnt_lo(~0u, 0u)) == 0) __hip_atomic_fetch_add(cnt + 64 * u.pm, 1u, __ATOMIC_RELAXED, __HIP_MEMORY_SCOPE_AGENT);
    }
};
struct MoeOrderWait : MoeOrder {
    const unsigned* cnt; unsigned need; unsigned* tmo; int wv;
    __device__ __forceinline__ void a_ready(const Unit& u) const {
        if (wv == 0) {
            const unsigned long long t0 = __builtin_amdgcn_s_memrealtime(); unsigned polls = 0;
            while ((unsigned)__builtin_amdgcn_readfirstlane(__hip_atomic_load(cnt + 64 * u.pm, __ATOMIC_RELAXED, __HIP_MEMORY_SCOPE_AGENT)) < need) {
                if ((++polls & 255u) == 0u && __builtin_amdgcn_readfirstlane(__hip_atomic_load(tmo, __ATOMIC_RELAXED, __HIP_MEMORY_SCOPE_AGENT)) != 0u) break;
                if (__builtin_amdgcn_s_memrealtime() - t0 > 2000000ull) { __hip_atomic_store(tmo, 1u, __ATOMIC_RELAXED, __HIP_MEMORY_SCOPE_AGENT); break; }
                __builtin_amdgcn_s_sleep(2); }
            __builtin_amdgcn_fence(__ATOMIC_ACQUIRE, "agent");
            asm volatile("s_waitcnt vmcnt(0)" ::: "memory");
        }
        asm volatile("" ::: "memory"); __builtin_amdgcn_s_barrier(); asm volatile("" ::: "memory");
    }
};
template <class Epi, class Sched, bool ALIGN_EPI = false, bool SP2 = false, bool GATHER = false>
__device__ __forceinline__ void gemm_phase(PG8_LAS unsigned char* lds, const Gemm g, const Sched& S, const Epi& E, const int wv) {
    int tid_ = wv * 64 + (int)__builtin_amdgcn_mbcnt_hi(~0u, __builtin_amdgcn_mbcnt_lo(~0u, 0u)); asm volatile("" : "+v"(tid_));
    const int tid = tid_, wid = __builtin_amdgcn_readfirstlane(tid >> 6), lane = tid & 63, wr = wid >> 2, wc = wid & 3, fr = lane & 15, fq = lane >> 4;
    const int K = g.K, nt = K / BK;
    unsigned voffA[2], voffB[2];
#pragma unroll
    for (int i = 0; i < 2; ++i) { int R, C; stage_rc(tid * 16 + i * 8192, R, C); const int Rb = Epi::PERM ? ((R & ~31) + perm32(R & 31)) : R;
        voffA[i] = (unsigned)(R * K + C) * 2u; voffB[i] = (unsigned)(Rb * K + C) * 2u; }
    const size_t kstep = (size_t)(BK * 2);
    const size_t hstep = (size_t)HALF * K * 2;
    const size_t tstep = 2 * hstep;
    static_assert(!GATHER || SP2, "GATHER is wired into the SP2 loop only");
    const size_t hstepA = GATHER ? (size_t)0 : hstep;
    unsigned vAc[2][2], vAn[2][2];
#define PG8_ROWS(u_, dst) do { _Pragma("unroll") for (int h_ = 0; h_ < 2; ++h_) _Pragma("unroll") for (int i_ = 0; i_ < 2; ++i_) { int R_, C_; stage_rc(tid * 16 + i_ * 8192, R_, C_); \
        const int src_ = S.src_row((u_), h_ * HALF + R_); dst[h_][i_] = (unsigned)(src_ * K + C_) * 2u; } } while (0)
    const unsigned ldsw = (unsigned)wid * 1024u;
    const int aoff = lds_byte(wr * 64 + fr, fq * 8), boff = lds_byte(wc * 32 + fr, fq * 8);
#define PG8_SA(b, h) (((b) * 2 + (h)) * HTB)
#define PG8_SB(b, h) ((4 + (b) * 2 + (h)) * HTB)
#define PG8_STAGE(bufoff, gbase, voff) do { _Pragma("unroll") for (int _i = 0; _i < 2; ++_i) \
        __builtin_amdgcn_global_load_lds((const unsigned*)((const char*)(gbase) + (voff)[_i]), (PG8_LAS unsigned*)(lds + (bufoff) + ldsw + _i * 8192), 16, 0, 0); } while (0)
#define PG8_LDA(dst, b, h) do { _Pragma("unroll") for (int m = 0; m < 4; ++m) _Pragma("unroll") for (int k = 0; k < 2; ++k) dst[m][k] = *(const PG8_LAS bf16x8*)(lds + PG8_SA(b, h) + aoff + m * 2048 + k * 1024); } while (0)
#define PG8_LDB(dst, b, h) do { _Pragma("unroll") for (int n = 0; n < 2; ++n) _Pragma("unroll") for (int k = 0; k < 2; ++k) dst[n][k] = *(const PG8_LAS bf16x8*)(lds + PG8_SB(b, h) + boff + n * 2048 + k * 1024); } while (0)
#define PG8_MMA(ai, bj, At, Bt) do { __builtin_amdgcn_s_setprio(1); _Pragma("unroll") for (int m = 0; m < 4; ++m) _Pragma("unroll") for (int n = 0; n < 2; ++n) _Pragma("unroll") for (int k = 0; k < 2; ++k) \
        acc[ai][bj][m][n] = __builtin_amdgcn_mfma_f32_16x16x32_bf16(Bt[n][k], At[m][k], acc[ai][bj][m][n], 0, 0, 0); __builtin_amdgcn_s_setprio(0); } while (0)
#define PG8_WAIT_V(n) asm volatile("s_waitcnt vmcnt(" #n ")" ::: "memory")
#define PG8_WAIT_L(n) asm volatile("s_waitcnt lgkmcnt(" #n ")" ::: "memory")
#define PG8_BAR __builtin_amdgcn_s_barrier()
#define PG8_SCHED __builtin_amdgcn_sched_barrier(0)
    Unit cur, nxt; int ui = 0;
    if (!S.next(0, cur)) return;
    f32x4 acc[2][2][4][2];
#pragma unroll
    for (int a = 0; a < 2; ++a)
#pragma unroll
        for (int b = 0; b < 2; ++b)
#pragma unroll
            for (int m = 0; m < 4; ++m)
#pragma unroll
                for (int n = 0; n < 2; ++n) acc[a][b][m][n] = (f32x4){0.f, 0.f, 0.f, 0.f};
    bf16x8 At[4][2], B0[2][2], B1[2][2];
    const char* cA = (const char*)g.A + (GATHER ? (size_t)0 : (size_t)cur.pm * tstep); const char* cB = (const char*)g.Bt + (size_t)cur.pn * tstep;
    if constexpr (GATHER) { PG8_ROWS(cur, vAc); _Pragma("unroll") for (int h_ = 0; h_ < 2; ++h_) _Pragma("unroll") for (int i_ = 0; i_ < 2; ++i_) vAn[h_][i_] = vAc[h_][i_]; }
#define PG8_VA(h_, sel_) (GATHER ? (sel_)[h_] : voffA)
    S.a_ready(cur);
    if constexpr (SP2) {
        PG8_STAGE(PG8_SB(0, 0), cB, voffB); PG8_STAGE(PG8_SB(0, 1), cB + hstep, voffB); PG8_STAGE(PG8_SA(0, 0), cA, PG8_VA(0, vAc)); PG8_STAGE(PG8_SA(0, 1), cA + hstepA, PG8_VA(1, vAc));
        if (wr == 1) PG8_BAR;
        PG8_WAIT_V(2); PG8_BAR;
        PG8_STAGE(PG8_SB(1, 0), cB + kstep, voffB); PG8_STAGE(PG8_SA(1, 0), cA + kstep, PG8_VA(0, vAc)); PG8_STAGE(PG8_SB(1, 1), cB + hstep + kstep, voffB);
        PG8_WAIT_V(6); PG8_BAR;
    } else {
        PG8_STAGE(PG8_SB(0, 0), cB, voffB); PG8_STAGE(PG8_SA(0, 0), cA, voffA); PG8_STAGE(PG8_SB(0, 1), cB + hstep, voffB); PG8_STAGE(PG8_SA(0, 1), cA + hstep, voffA);
        if (wr == 1) PG8_BAR;
        PG8_WAIT_V(4); PG8_BAR;
        PG8_STAGE(PG8_SB(1, 0), cB + kstep, voffB); PG8_STAGE(PG8_SA(1, 0), cA + kstep, voffA); PG8_STAGE(PG8_SB(1, 1), cB + hstep + kstep, voffB);
        PG8_WAIT_V(6); PG8_BAR;
    }
    for (;;) {
        const bool has_next = S.next(ui + 1, nxt);
        const char* nA = (has_next && !GATHER) ? (const char*)g.A + (size_t)nxt.pm * tstep : cA; const char* nB = has_next ? (const char*)g.Bt + (size_t)nxt.pn * tstep : cB;
        if constexpr (GATHER) { if (has_next) PG8_ROWS(nxt, vAn); }
        for (int t = 0; t < nt; t += 2) {
            const bool last = (t == nt - 2);
            const char* a1 = cA + (size_t)(t + 1) * kstep;
            const char* a2 = last ? nA : cA + (size_t)(t + 2) * kstep; const char* b2 = last ? nB : cB + (size_t)(t + 2) * kstep;
            const char* a3 = a2 + kstep; const char* b3 = b2 + kstep;
            unsigned vS[2][2];
            if constexpr (GATHER) { _Pragma("unroll") for (int h_ = 0; h_ < 2; ++h_) _Pragma("unroll") for (int i_ = 0; i_ < 2; ++i_) vS[h_][i_] = vAc[h_][i_];
                if (last) { asm volatile("" ::: "memory");
                    _Pragma("unroll") for (int h_ = 0; h_ < 2; ++h_) _Pragma("unroll") for (int i_ = 0; i_ < 2; ++i_) vS[h_][i_] = vAn[h_][i_]; } }
            if (last && has_next) S.a_ready(nxt);
            if constexpr (SP2) {
            PG8_LDB(B0, 0, 0); PG8_LDB(B1, 0, 1); PG8_SCHED; PG8_LDA(At, 0, 0); PG8_STAGE(PG8_SA(1, 1), a1 + hstepA, PG8_VA(1, vAc));
            PG8_WAIT_V(8); PG8_WAIT_L(0); PG8_BAR; PG8_MMA(0, 0, At, B0); PG8_MMA(0, 1, At, B1); PG8_BAR; PG8_SCHED;
            PG8_LDA(At, 0, 1); PG8_STAGE(PG8_SB(0, 0), b2, voffB); PG8_STAGE(PG8_SB(0, 1), b2 + hstep, voffB); PG8_STAGE(PG8_SA(0, 0), a2, PG8_VA(0, vS));
            PG8_WAIT_V(8); PG8_WAIT_L(0); PG8_BAR; PG8_MMA(1, 0, At, B0); PG8_MMA(1, 1, At, B1); PG8_BAR; PG8_SCHED;
            PG8_LDB(B0, 1, 0); PG8_LDB(B1, 1, 1); PG8_SCHED; PG8_LDA(At, 1, 0); PG8_STAGE(PG8_SA(0, 1), a2 + hstepA, PG8_VA(1, vS));
            PG8_WAIT_V(8); PG8_WAIT_L(0); PG8_BAR; PG8_MMA(0, 0, At, B0); PG8_MMA(0, 1, At, B1); PG8_BAR; PG8_SCHED;
            PG8_LDA(At, 1, 1); PG8_STAGE(PG8_SB(1, 0), b3, voffB); PG8_STAGE(PG8_SB(1, 1), b3 + hstep, voffB); PG8_STAGE(PG8_SA(1, 0), a3, PG8_VA(0, vS));
            PG8_WAIT_V(8); PG8_WAIT_L(0); PG8_BAR; PG8_MMA(1, 0, At, B0); PG8_MMA(1, 1, At, B1); PG8_BAR; PG8_SCHED;
            } else {
            PG8_LDB(B0, 0, 0); PG8_SCHED; PG8_LDA(At, 0, 0); PG8_STAGE(PG8_SA(1, 1), a1 + hstep, voffA);
            PG8_WAIT_L(8); PG8_BAR; PG8_WAIT_L(0); PG8_MMA(0, 0, At, B0); PG8_BAR; PG8_SCHED;
            PG8_LDB(B1, 0, 1); PG8_STAGE(PG8_SB(0, 0), b2, voffB);
            PG8_BAR; PG8_WAIT_L(0); PG8_MMA(0, 1, At, B1); PG8_BAR;
            PG8_LDA(At, 0, 1); PG8_STAGE(PG8_SA(0, 0), a2, voffA);
            PG8_BAR; PG8_WAIT_L(0); PG8_MMA(1, 0, At, B0); PG8_BAR; PG8_SCHED;
            PG8_STAGE(PG8_SB(0, 1), b2 + hstep, voffB);
            PG8_WAIT_V(6); PG8_BAR; PG8_MMA(1, 1, At, B1); PG8_BAR;
            PG8_LDB(B0, 1, 0); PG8_SCHED; PG8_LDA(At, 1, 0); PG8_STAGE(PG8_SA(0, 1), a2 + hstep, voffA);
            PG8_WAIT_L(8); PG8_BAR; PG8_WAIT_L(0); PG8_MMA(0, 0, At, B0); PG8_BAR; PG8_SCHED;
            PG8_LDB(B1, 1, 1); PG8_STAGE(PG8_SB(1, 0), b3, voffB);
            PG8_BAR; PG8_WAIT_L(0); PG8_MMA(0, 1, At, B1); PG8_BAR;
            PG8_LDA(At, 1, 1); PG8_STAGE(PG8_SA(1, 0), a3, voffA);
            PG8_BAR; PG8_WAIT_L(0); PG8_MMA(1, 0, At, B0); PG8_BAR; PG8_SCHED;
            PG8_STAGE(PG8_SB(1, 1), b3 + hstep, voffB);
            PG8_WAIT_V(6); PG8_BAR; PG8_MMA(1, 1, At, B1); PG8_BAR;
            }
        }
        if constexpr (ALIGN_EPI) { if (wr == 0) PG8_BAR; }
        if constexpr (!Epi::AFTER_DRAIN) { E(acc, cur, wr, wc, fr, fq); S.done(cur); }
        if (!has_next) break;
#pragma unroll
        for (int a = 0; a < 2; ++a)
#pragma unroll
            for (int b = 0; b < 2; ++b)
#pragma unroll
                for (int m = 0; m < 4; ++m)
#pragma unroll
                    for (int n = 0; n < 2; ++n) acc[a][b][m][n] = (f32x4){0.f, 0.f, 0.f, 0.f};
        cur = nxt; cA = nA; cB = nB; ++ui;
        if constexpr (GATHER) { _Pragma("unroll") for (int h_ = 0; h_ < 2; ++h_) _Pragma("unroll") for (int i_ = 0; i_ < 2; ++i_) vAc[h_][i_] = vAn[h_][i_]; }
        if constexpr (ALIGN_EPI) { if (wr == 1) PG8_BAR; }
    }
    PG8_WAIT_V(0);
    if constexpr (!ALIGN_EPI) { if (wr == 0) PG8_BAR; }
    PG8_BAR;
    if constexpr (Epi::AFTER_DRAIN) { E.fused(acc, cur, wr, wc, fr, fq, lds, wid, lane); S.done(cur); }
#undef PG8_SA
#undef PG8_ROWS
#undef PG8_VA
#undef PG8_SB
#undef PG8_STAGE
#undef PG8_LDA
#undef PG8_LDB
#undef PG8_MMA
#undef PG8_WAIT_V
#undef PG8_WAIT_L
#undef PG8_BAR
#undef PG8_SCHED
}
}

constexpr int T = 32768, D = 1024, SEQ = 2048;
constexpr int NWAVES = 8;
constexpr float LOG2E = 1.44269504f, ALPHA = 1.41421356237f, LN_EPS = 1e-5f, GN_EPS = 64e-5f;
constexpr size_t MiB = 1u << 20;
constexpr size_t WS_CTL = 0, CTL_ZERO_BYTES = 1 * MiB;
constexpr size_t WS_DUT = 1 * MiB, WS_AUT = WS_DUT + 128 * 1024, WS_GUT = WS_DUT + 256 * 1024, WS_VDT = WS_DUT + 576 * 1024, WS_VUT = WS_DUT + 608 * 1024,
                 WS_RB = WS_DUT + 640 * 1024, WS_TILE = WS_DUT + 704 * 1024;
constexpr size_t WS_RWT = 2 * MiB;
constexpr size_t WS_TOKE = 3 * MiB, WS_TOKP = WS_TOKE + 256 * 1024, WS_TOKW = WS_TOKE + 512 * 1024, WS_TOKS = WS_TOKE + 768 * 1024;
constexpr size_t WS_WNE = 4 * MiB, WNE_LAYER = 18 * MiB;
constexpr size_t WNE_WIN = 0, WNE_WBA = 11 * MiB, WNE_WBR = 12 * MiB, WNE_WOUT = 13 * MiB, WNE_WPG = 15 * MiB, WNE_WPLE = 17 * MiB;
constexpr size_t WS_XB = 40 * MiB, WS_VF = 104 * MiB, WS_YA = 136 * MiB, WS_YB = 168 * MiB, WS_QK = 200 * MiB, WS_VT = 264 * MiB, WS_RKVL = 296 * MiB, WS_NU = 412 * MiB, WS_GH = 200 * MiB;
constexpr size_t WS_LW = 168 * MiB, WS_GG = 444 * MiB, OUT_AA = 96 * MiB;
constexpr size_t WS_T1 = 200 * MiB, WS_T2 = 264 * MiB, WS_MP = 328 * MiB;
constexpr size_t WS_EGU = 136 * MiB, WS_EDN = 168 * MiB, WS_LOG = 184 * MiB, WS_XG = 200 * MiB, WS_H = 344 * MiB, WS_PB = 392 * MiB, WS_TP = 216 * MiB, WS_PRE2 = 280 * MiB, WS_ELIST = 380 * MiB;
constexpr size_t WS_END = 508 * MiB;
constexpr int CW_TMO = 0, CW_BAR = 4096, CW_CNT = 16384, CW_NTILES = 16384 + 256, CW_CHK = 16384 + 512, CW_KCNT = 32768;
constexpr int WIN_ROWS = 5632;
constexpr int RING_BYTES = 131072, MISC_OFF = RING_BYTES + 320, TILE_LDS = RING_BYTES + 1024, LDS_BYTES = 147456;

#define GAS __attribute__((address_space(1)))
#define LAS __attribute__((address_space(3)))
typedef unsigned short bf16;
typedef unsigned v4u __attribute__((ext_vector_type(4)));
typedef unsigned v2u __attribute__((ext_vector_type(2)));
typedef float f32x4 __attribute__((ext_vector_type(4)));
typedef float f32x16 __attribute__((ext_vector_type(16)));
typedef short bf16x8 __attribute__((ext_vector_type(8)));
typedef GAS unsigned gu32;
#define RLX_AGENT __ATOMIC_RELAXED, __HIP_MEMORY_SCOPE_AGENT
#define LDS_WAIT() asm volatile("s_waitcnt lgkmcnt(0)" ::: "memory")
#define VM_WAIT() asm volatile("s_waitcnt vmcnt(0)" ::: "memory")
#define MFMA32(a, b, c) __builtin_amdgcn_mfma_f32_32x32x16_bf16((a), (b), (c), 0, 0, 0)
__device__ __forceinline__ unsigned f2bf(float f) { unsigned u = __builtin_bit_cast(unsigned, f); return (u + 0x7fffu + ((u >> 16) & 1u)) >> 16; }
typedef float f32x2_t __attribute__((ext_vector_type(2)));
typedef __bf16 bf16x2_t __attribute__((ext_vector_type(2)));
__device__ __forceinline__ unsigned pk2(float lo, float hi) { f32x2_t v = {lo, hi}; bf16x2_t b = __builtin_convertvector(v, bf16x2_t); return __builtin_bit_cast(unsigned, b); }
__device__ __forceinline__ float bflo(unsigned w) { return __uint_as_float(w << 16); }
__device__ __forceinline__ float bfhi(unsigned w) { return __uint_as_float(w & 0xffff0000u); }
__device__ __forceinline__ float sigm(float x) { return __builtin_amdgcn_rcpf(1.0f + __builtin_amdgcn_exp2f(-LOG2E * x)); }
__device__ __forceinline__ void unpack8(const v4u w, float (&f)[8]) { f[0] = bflo(w.x); f[1] = bfhi(w.x); f[2] = bflo(w.y); f[3] = bfhi(w.y); f[4] = bflo(w.z); f[5] = bfhi(w.z); f[6] = bflo(w.w); f[7] = bfhi(w.w); }
__device__ __forceinline__ v4u pack8(const float (&f)[8]) { v4u w; w.x = pk2(f[0], f[1]); w.y = pk2(f[2], f[3]); w.z = pk2(f[4], f[5]); w.w = pk2(f[6], f[7]); return w; }
template <int CTRL> __device__ __forceinline__ float dppf(float x) { return __builtin_bit_cast(float, __builtin_amdgcn_update_dpp(0, __builtin_bit_cast(int, x), CTRL, 0xF, 0xF, true)); }
__device__ __forceinline__ float red8(float x) { x += dppf<0xB1>(x); x += dppf<0x4E>(x); x += dppf<0x141>(x); return x; }
__device__ __forceinline__ float wave_sum(float v) {
#pragma unroll
    for (int o = 1; o < 64; o <<= 1) v += __shfl_xor(v, o);
    return v;
}
__device__ __forceinline__ int crow(int i, int hh) { return (i & 3) + 8 * (i >> 2) + 4 * hh; }
#define XB_TMO      128
#define XB_XCNT(j)  (256  + 64 * (j))
#define XB_XSUB(j)  (1280 + 64 * (j))
#define XB_XGEN(j)  (2304 + 64 * (j))
#define XB_TOP      3328
#define XB_TOPGEN   3392
#define XCD_BAR_WORDS 3456
#define XB_SPIN_CAP (1u << 18)

__device__ __forceinline__ unsigned xb_ld(unsigned* p)              { return __hip_atomic_load(p, __ATOMIC_RELAXED, __HIP_MEMORY_SCOPE_AGENT); }
__device__ __forceinline__ unsigned xb_add(unsigned* p, unsigned v) { return __hip_atomic_fetch_add(p, v, __ATOMIC_RELAXED, __HIP_MEMORY_SCOPE_AGENT); }
__device__ __forceinline__ unsigned xb_xcc_id() { return (unsigned)__builtin_amdgcn_s_getreg((3 << 11) | 20) & 0xFu; }
#define XB_SPIN(cond, bar) do { unsigned _sp = 0; while (cond) { __builtin_amdgcn_s_sleep(1); \
    if ((++_sp & 255u) == 0u) { if (xb_ld(&(bar)[XB_TMO])) break; if (_sp > XB_SPIN_CAP) { atomicAdd(&(bar)[XB_TMO], 1u); break; } } } } while (0)

struct XcdBarrier {
    unsigned* bar; unsigned x;
    volatile LAS unsigned* st;
};

__device__ __forceinline__ XcdBarrier xcd_barrier_post(unsigned* bar, volatile LAS unsigned* st) {
    XcdBarrier b; b.bar = bar; b.x = xb_xcc_id(); b.st = st;
    if (threadIdx.x == 0) (void)xb_add(&bar[XB_XCNT(b.x)], 1u);
    return b;
}
__device__ __forceinline__ void xcd_barrier_complete(unsigned* bar, unsigned x, unsigned& nloc, unsigned& nx) {
    const unsigned G = gridDim.x * gridDim.y * gridDim.z;
    unsigned sum, cnt, mine, sp = 0u;
    for (;;) {
        sum = 0u; cnt = 0u; mine = 0u;
#pragma unroll
        for (unsigned j = 0; j < 16; ++j) { const unsigned c = xb_ld(&bar[XB_XCNT(j)]); sum += c; cnt += (c > 0u) ? 1u : 0u; mine = (j == x) ? c : mine; }
        if (sum == G) break;
        __builtin_amdgcn_s_sleep(1);
        if ((++sp & 255u) == 0u) { if (xb_ld(&bar[XB_TMO])) break; if (sp > XB_SPIN_CAP) { atomicAdd(&bar[XB_TMO], 1u); break; } }
    }
    nloc = mine > 0u ? mine : 1u; nx = cnt > 0u ? cnt : 1u;
}

__device__ __forceinline__ void xcd_barrier(const XcdBarrier& b, const bool leader) {
    asm volatile("s_waitcnt vmcnt(0)" ::: "memory");
    __syncthreads();
    if (leader) {
        unsigned* bar = b.bar;
        __builtin_amdgcn_s_waitcnt(0);
        unsigned nloc = b.st[0], nx = b.st[1];
        if (nloc == 0u) { xcd_barrier_complete(bar, b.x, nloc, nx); b.st[0] = nloc; b.st[1] = nx; }
        const unsigned old = xb_add(&bar[XB_XSUB(b.x)], 1u);
        const unsigned gen = old / nloc;
        if (old + 1u == (gen + 1u) * nloc) {
            __builtin_amdgcn_fence(__ATOMIC_RELEASE, "agent");
            asm volatile("s_waitcnt vmcnt(0)" ::: "memory");
            const unsigned og = xb_add(&bar[XB_TOP], 1u);
            const unsigned tg = og / nx;
            if (og + 1u == (tg + 1u) * nx) xb_add(&bar[XB_TOPGEN], 1u);
            else XB_SPIN(xb_ld(&bar[XB_TOPGEN]) == tg, bar);
            __builtin_amdgcn_fence(__ATOMIC_ACQUIRE, "agent");
            xb_add(&bar[XB_XGEN(b.x)], 1u);
            asm volatile("s_waitcnt vmcnt(0)" ::: "memory");
        } else {
            XB_SPIN(xb_ld(&bar[XB_XGEN(b.x)]) == gen, bar);
            __builtin_amdgcn_fence(__ATOMIC_ACQUIRE, "agent");
            asm volatile("s_waitcnt vmcnt(0)" ::: "memory");
        }
    }
    __syncthreads();
}

__device__ __forceinline__ void transpose_item(const float* W, int ldw, int k0, int n0, bf16* WT, int ldk, int drow0, LAS float* scr, int lane) {
#pragma unroll 8
    for (int i = 0; i < 32; ++i) { const int kk = 2 * i + (lane >> 5); scr[kk * 33 + (lane & 31)] = W[(size_t)(k0 + kk) * ldw + n0 + (lane & 31)]; }
    LDS_WAIT(); asm volatile("" ::: "memory");
    const int c = lane & 7;
#pragma unroll
    for (int j = 0; j < 4; ++j) { const int n = (lane >> 3) + 8 * j; const LAS float* s = scr + (8 * c) * 33 + n;
        v4u o; o.x = pk2(s[0 * 33], s[1 * 33]); o.y = pk2(s[2 * 33], s[3 * 33]); o.z = pk2(s[4 * 33], s[5 * 33]); o.w = pk2(s[6 * 33], s[7 * 33]);
        *(GAS v4u*)(WT + (size_t)(drow0 + n) * ldk + k0 + 8 * c) = o; }
    LDS_WAIT(); asm volatile("" ::: "memory");
}

template <int SRC, int DST>
__device__ __forceinline__ void ln_pass(const float* src, float* dst, bf16* XB, const float* g, const float* b, const bf16* Y2, const int* TOKE, const float* TOKW, int gw, int NGW, int lane, int mend = T, const int* TOKP = nullptr, const LAS int* offs = nullptr) {
    f32x4 gv[4], bv[4];
#pragma unroll
    for (int j = 0; j < 4; ++j) { gv[j] = *(const f32x4*)(g + 4 * lane + 256 * j); bv[j] = *(const f32x4*)(b + 4 * lane + 256 * j); }
    for (int m = gw; m < mend; m += NGW) {
        f32x4 v[4]; float s = 0.f;
        if (SRC == 0) {
            const GAS f32x4* xr = (const GAS f32x4*)(src + (size_t)m * D) + lane;
#pragma unroll
            for (int j = 0; j < 4; ++j) v[j] = xr[64 * j];
        } else if (SRC == 2) {
            const GAS v2u* x0 = (const GAS v2u*)(Y2 + (size_t)m * D) + lane;
#pragma unroll
            for (int j = 0; j < 4; ++j) { const v2u x = x0[64 * j]; v[j] = (f32x4){bflo(x.x), bfhi(x.x), bflo(x.y), bfhi(x.y)}; }
        } else {
            const int s1 = offs[TOKE[2 * m]] + TOKP[2 * m], s2 = offs[TOKE[2 * m + 1]] + TOKP[2 * m + 1]; const float w1 = TOKW[2 * m], w2 = TOKW[2 * m + 1];
            const GAS v2u* x0 = (const GAS v2u*)(XB + (size_t)m * D) + lane;
            const GAS v2u* y1 = (const GAS v2u*)(Y2 + (size_t)s1 * D) + lane; const GAS v2u* y2 = (const GAS v2u*)(Y2 + (size_t)s2 * D) + lane;
#pragma unroll
            for (int j = 0; j < 4; ++j) { const v2u x = x0[64 * j], a = y1[64 * j], c = y2[64 * j];
                v[j] = ALPHA * (f32x4){bflo(x.x), bfhi(x.x), bflo(x.y), bfhi(x.y)} + w1 * (f32x4){bflo(a.x), bfhi(a.x), bflo(a.y), bfhi(a.y)} + w2 * (f32x4){bflo(c.x), bfhi(c.x), bflo(c.y), bfhi(c.y)}; }
        }
#pragma unroll
        for (int j = 0; j < 4; ++j) s += (v[j].x + v[j].y) + (v[j].z + v[j].w);
        const float mean = wave_sum(s) * (1.f / D); float s2 = 0.f;
#pragma unroll
        for (int j = 0; j < 4; ++j) { v[j] = v[j] - mean; s2 += (v[j].x * v[j].x + v[j].y * v[j].y) + (v[j].z * v[j].z + v[j].w * v[j].w); }
        const float rstd = 1.f / sqrtf(wave_sum(s2) * (1.f / D) + LN_EPS);
        GAS f32x4* o4 = (GAS f32x4*)(dst + (size_t)m * D) + lane;
        GAS v2u* o8 = (GAS v2u*)(XB + (size_t)m * D) + lane;
#pragma unroll
        for (int j = 0; j < 4; ++j) { const f32x4 y = v[j] * rstd * gv[j] + bv[j];
            if (DST == 1) o4[64 * j] = y; else { v2u w; w.x = pk2(y.x, y.y); w.y = pk2(y.z, y.w); o8[64 * j] = w; } }
    }
}

__device__ __forceinline__ void attn_phase(LAS unsigned char* lds, const bf16* QK, const bf16* VT, bf16* YA, const float* rel_bias, int vcu, int G, int tid) {
    LAS float* bl = (LAS float*)lds;
    for (int i = tid; i < 8 * 257; i += NWAVES * 64) bl[i] = rel_bias[i] * LOG2E;
    __syncthreads();
    const int h = __builtin_amdgcn_readfirstlane(tid >> 6), lane = tid & 63, r = lane & 31, hh = lane >> 5;
    const int pr = 16 * ((r >> 2) & 1) + (r & 3) + 4 * (r >> 3);
    const float C1 = 0.125f * LOG2E;
    constexpr float ATT_THR = 4.0f;
    const float b256 = bl[h * 257 + 256];
    for (int unit = vcu; unit < 512; unit += G) {
        const int b = unit >> 5, c = unit & 31;
        const size_t rowQ = (size_t)b * SEQ + (size_t)c * 64;
        const bf16* Qp = QK + rowQ * 1024 + h * 64;
        const bf16* Kb = QK + (size_t)b * SEQ * 1024 + 512 + h * 64;
        const bf16* Vb = VT + (size_t)(h * 64) * T + (size_t)b * SEQ;
        bf16x8 qf[2][4];
#pragma unroll
        for (int qb = 0; qb < 2; ++qb)
#pragma unroll
            for (int kk = 0; kk < 4; ++kk) qf[qb][kk] = *(const bf16x8*)(Qp + (size_t)(qb * 32 + r) * 1024 + 16 * kk + 8 * hh);
        f32x16 o[2][2];
#pragma unroll
        for (int a = 0; a < 2; ++a)
#pragma unroll
            for (int q = 0; q < 2; ++q)
#pragma unroll
                for (int i = 0; i < 16; ++i) o[a][q][i] = 0.f;
        float mrun[2] = {-INFINITY, -INFINITY}, lrun[2] = {0.f, 0.f};
        const int kt0 = c >= 8 ? 0 : (8 - c) * 2;
        LAS unsigned char* kbuf = lds + 8448 + h * 9728; LAS unsigned char* vbuf = kbuf + 4608;
        const int krow = lane >> 3, kc16 = lane & 7, vrow = lane >> 2, vc16 = lane & 3;
        v4u kg[4], vg[4];
        { const int tk0 = (c - 8) * 64 + 32 * kt0;
#pragma unroll
          for (int i = 0; i < 4; ++i) { kg[i] = *(const GAS v4u*)(Kb + (size_t)(tk0 + 8 * i + krow) * 1024 + kc16 * 8); vg[i] = *(const GAS v4u*)(Vb + (size_t)(16 * i + vrow) * T + tk0 + vc16 * 8); } }
        bf16x8 kf[4], vf[2][2];
        for (int kt = kt0; kt < 18; ++kt) {
#pragma unroll
            for (int i = 0; i < 4; ++i) { *(LAS v4u*)(kbuf + (8 * i + krow) * 144 + kc16 * 16) = kg[i]; *(LAS v4u*)(vbuf + (16 * i + vrow) * 80 + vc16 * 16) = vg[i]; }
            if (kt + 1 < 18) { const int tk1 = (c - 8) * 64 + 32 * (kt + 1);
#pragma unroll
                for (int i = 0; i < 4; ++i) { kg[i] = *(const GAS v4u*)(Kb + (size_t)(tk1 + 8 * i + krow) * 1024 + kc16 * 8); vg[i] = *(const GAS v4u*)(Vb + (size_t)(16 * i + vrow) * T + tk1 + vc16 * 8); } }
#pragma unroll
            for (int kk = 0; kk < 4; ++kk) kf[kk] = *(const LAS bf16x8*)(kbuf + pr * 144 + (16 * kk + 8 * hh) * 2);
#pragma unroll
            for (int db = 0; db < 2; ++db)
#pragma unroll
                for (int st = 0; st < 2; ++st) vf[db][st] = *(const LAS bf16x8*)(vbuf + (db * 32 + r) * 80 + (16 * hh + 8 * st) * 2);
            bf16x8 pf[2][2];
#pragma unroll
            for (int qb = 0; qb < 2; ++qb) {
                f32x16 s;
#pragma unroll
                for (int i = 0; i < 16; ++i) s[i] = 0.f;
#pragma unroll
                for (int kk = 0; kk < 4; ++kk) s = MFMA32(kf[kk], qf[qb][kk], s);
                float t[16];
                if (kt >= 12) {
                    const int dbase = 512 + qb * 32 + r - (32 * kt + 16 * hh);
#pragma unroll
                    for (int i = 0; i < 16; ++i) { int dist = dbase - i; dist = dist > 128 ? 128 : dist; dist = dist < -128 ? -128 : dist; s[i] = s[i] * C1 + bl[h * 257 + dist + 128]; }
                }
                float ml = fmaxf(fmaxf(s[0], s[1]), s[2]);
#pragma unroll
                for (int i = 3; i < 15; i += 2) ml = fmaxf(fmaxf(ml, s[i]), s[i + 1]);
                ml = fmaxf(ml, s[15]);
                if (kt < 12) ml = ml * C1 + b256;
                ml = fmaxf(ml, __shfl_xor(ml, 32));
                const bool mv = __builtin_amdgcn_ballot_w64(ml - mrun[qb] > ATT_THR) != 0ull;
                const float mnew = mv ? fmaxf(mrun[qb], ml) : mrun[qb], al = __builtin_amdgcn_exp2f(mrun[qb] - mnew);
                mrun[qb] = mnew;
                float ls = 0.f;
                if (kt < 12) { const float off = b256 - mnew;
#pragma unroll
                    for (int i = 0; i < 16; ++i) { t[i] = __builtin_amdgcn_exp2f(s[i] * C1 + off); ls += t[i]; }
                } else {
#pragma unroll
                    for (int i = 0; i < 16; ++i) { t[i] = __builtin_amdgcn_exp2f(s[i] - mnew); ls += t[i]; }
                }
                lrun[qb] = lrun[qb] * al + ls;
                if (mv) {
#pragma unroll
                    for (int i = 0; i < 16; ++i) { o[0][qb][i] *= al; o[1][qb][i] *= al; }
                }
#pragma unroll
                for (int st = 0; st < 2; ++st) { v4u w; w.x = pk2(t[8 * st + 0], t[8 * st + 1]); w.y = pk2(t[8 * st + 2], t[8 * st + 3]); w.z = pk2(t[8 * st + 4], t[8 * st + 5]); w.w = pk2(t[8 * st + 6], t[8 * st + 7]);
                    pf[qb][st] = __builtin_bit_cast(bf16x8, w); }
            }
#pragma unroll
            for (int db = 0; db < 2; ++db)
#pragma unroll
                for (int qb = 0; qb < 2; ++qb)
#pragma unroll
                    for (int st = 0; st < 2; ++st) o[db][qb] = MFMA32(vf[db][st], pf[qb][st], o[db][qb]);
        }
#pragma unroll
        for (int qb = 0; qb < 2; ++qb) {
            const float l = lrun[qb] + __shfl_xor(lrun[qb], 32), inv = 1.f / l;
            bf16* orow = YA + (rowQ + qb * 32 + r) * 512 + h * 64;
#pragma unroll
            for (int db = 0; db < 2; ++db)
#pragma unroll
                for (int g4 = 0; g4 < 4; ++g4) { v2u w; w.x = pk2(o[db][qb][4 * g4] * inv, o[db][qb][4 * g4 + 1] * inv); w.y = pk2(o[db][qb][4 * g4 + 2] * inv, o[db][qb][4 * g4 + 3] * inv);
                    *(GAS v2u*)(orow + db * 32 + 8 * g4 + 4 * hh) = w; }
        }
    }
}

constexpr int LDR = 1856;
struct PrepArgs { const bf16* RKVL; bf16 *LW, *AA, *GG, *NU; const float* mu; const float *decay_base, *aaa_base, *vres_base; const bf16 *DUT, *AUT, *GUT, *VDT, *VUT; int layer; };
constexpr int PA_STRIDE = 592, PV_STRIDE = 1040, PD_STRIDE = 80;
constexpr int PREP_A = 0, PREP_V = 38912, PREP_D = PREP_V + 64 * PV_STRIDE, PREP_MU = PREP_D + 64 * PD_STRIDE;
template <int KS> __device__ __forceinline__ void prep_mm(f32x16 (&acc)[2][2], const LAS unsigned char* Abase, int astride, int acol0, const bf16* W, int Kw, int hd, int r, int hh) {
#pragma unroll
    for (int a = 0; a < 2; ++a)
#pragma unroll
        for (int b = 0; b < 2; ++b)
#pragma unroll
            for (int i = 0; i < 16; ++i) acc[a][b][i] = 0.f;
#pragma unroll
    for (int ks = 0; ks < KS; ++ks) {
        bf16x8 af[2], bfr[2];
#pragma unroll
        for (int mb = 0; mb < 2; ++mb) af[mb] = *(const LAS bf16x8*)(Abase + (mb * 32 + r) * astride + (acol0 + 16 * ks + 8 * hh) * 2);
#pragma unroll
        for (int nb = 0; nb < 2; ++nb) bfr[nb] = *(const bf16x8*)(W + (size_t)(64 * hd + nb * 32 + r) * Kw + 16 * ks + 8 * hh);
#pragma unroll
        for (int mb = 0; mb < 2; ++mb)
#pragma unroll
            for (int nb = 0; nb < 2; ++nb) acc[mb][nb] = MFMA32(bfr[nb], af[mb], acc[mb][nb]);
    }
}
constexpr int PREP_ST_STRIDE = 144, PREP_ST_BYTES = 32 * PREP_ST_STRIDE;
template <int MODE> __device__ __forceinline__ void prep_store(const f32x16 (&acc)[2][2], bf16* OUT, const float* base, int t0g, int hd, int lane, LAS unsigned char* st) {
    const int r = lane & 31, hh = lane >> 5;
#pragma unroll
    for (int mb = 0; mb < 2; ++mb) {
#pragma unroll
        for (int nb = 0; nb < 2; ++nb)
#pragma unroll
            for (int g4 = 0; g4 < 4; ++g4) { const int c0 = nb * 32 + 8 * g4 + 4 * hh;
                f32x4 bs = (f32x4){0.f, 0.f, 0.f, 0.f}; if (MODE != 2) bs = *(const f32x4*)(base + 64 * hd + c0);
                float v[4];
#pragma unroll
                for (int e = 0; e < 4; ++e) { v[e] = acc[mb][nb][4 * g4 + e]; if (MODE == 0) v[e] = -0.60653066f * sigm(v[e] + bs[e]); if (MODE == 1) v[e] = sigm(v[e] + bs[e]); }
                v2u w; w.x = pk2(v[0], v[1]); w.y = pk2(v[2], v[3]); *(LAS v2u*)(st + r * PREP_ST_STRIDE + c0 * 2) = w; }
#pragma unroll
        for (int it = 0; it < 4; ++it) { const int tl = it * 8 + (lane >> 3), c8 = lane & 7;
            const v4u w = *(const LAS v4u*)(st + tl * PREP_ST_STRIDE + c8 * 16);
            *(GAS v4u*)(OUT + (size_t)(t0g + mb * 32 + tl) * 512 + 64 * hd + 8 * c8) = w; }
    }
}
__device__ __forceinline__ void prep_phase(LAS unsigned char* lds, const PrepArgs& P, int vcu, int G, int tid) {
    const int hd = __builtin_amdgcn_readfirstlane(tid >> 6), lane = tid & 63, r = lane & 31, hh = lane >> 5;
    LAS float* mut = (LAS float*)(lds + PREP_MU);
    for (int i = tid; i < 1824; i += NWAVES * 64) mut[i] = P.mu[i];
    __syncthreads();
    for (int unit = vcu; unit < 512; unit += G) {
        const int t0g = unit * 64, s0 = t0g & (SEQ - 1);
        {
            v4u cu[5], pv[5];
#pragma unroll
            for (int k = 0; k < 5; ++k) { const int i = tid + k * NWAVES * 64; cu[k] = (v4u){0u, 0u, 0u, 0u}; pv[k] = cu[k];
                if (i < 64 * 36) { const int tok = i / 36, ch = i - tok * 36; const size_t row = (size_t)t0g + tok;
                    cu[k] = *(const GAS v4u*)(P.RKVL + row * LDR + 1536 + 8 * ch);
                    if (s0 + tok > 0) pv[k] = *(const GAS v4u*)(P.RKVL + (row - 1) * LDR + 1536 + 8 * ch); } }
#pragma unroll
            for (int k = 0; k < 5; ++k) { const int i = tid + k * NWAVES * 64;
                if (i < 64 * 36) { const int tok = i / 36, ch = i - tok * 36;
                    float c8[8], p8[8], o8[8]; unpack8(cu[k], c8); unpack8(pv[k], p8);
                    const f32x4 m0 = *(const LAS f32x4*)(mut + 1536 + 8 * ch), m1 = *(const LAS f32x4*)(mut + 1536 + 8 * ch + 4);
#pragma unroll
                    for (int j = 0; j < 8; ++j) { float x = c8[j] + (p8[j] - c8[j]) * (j < 4 ? m0[j & 3] : m1[j & 3]);
                        if (ch < 8) x = 2.f * sigm(2.f * x) - 1.f; else if (ch >= 16) x = sigm(x);
                        o8[j] = x; }
                    *(LAS v4u*)(lds + PREP_A + tok * PA_STRIDE + 16 * ch) = pack8(o8); } }
        }
        if (P.layer == 1) {
            v4u cu[8], pv[8];
#pragma unroll
            for (int k = 0; k < 8; ++k) { const int i = tid + k * NWAVES * 64, tok = i >> 6, ch = i & 63; const size_t row = (size_t)t0g + tok;
                cu[k] = *(const GAS v4u*)(P.RKVL + row * LDR + 1024 + 8 * ch);
                pv[k] = (v4u){0u, 0u, 0u, 0u}; if (s0 + tok > 0) pv[k] = *(const GAS v4u*)(P.RKVL + (row - 1) * LDR + 1024 + 8 * ch); }
#pragma unroll
            for (int k = 0; k < 8; ++k) { const int i = tid + k * NWAVES * 64, tok = i >> 6, ch = i & 63;
                float c8[8], p8[8], o8[8]; unpack8(cu[k], c8); unpack8(pv[k], p8);
                const f32x4 m0 = *(const LAS f32x4*)(mut + 1024 + 8 * ch), m1 = *(const LAS f32x4*)(mut + 1024 + 8 * ch + 4);
#pragma unroll
                for (int j = 0; j < 8; ++j) o8[j] = c8[j] + (p8[j] - c8[j]) * (j < 4 ? m0[j & 3] : m1[j & 3]);
                *(LAS v4u*)(lds + PREP_V + tok * PV_STRIDE + 16 * ch) = pack8(o8); }
        }
        __syncthreads();
        if (P.layer == 1) {
            if (hd < 2) {
                f32x16 a1;
#pragma unroll
                for (int i = 0; i < 16; ++i) a1[i] = 0.f;
#pragma unroll 4
                for (int ks = 0; ks < 32; ++ks) {
                    const bf16x8 af = *(const LAS bf16x8*)(lds + PREP_V + (hd * 32 + r) * PV_STRIDE + (16 * ks + 8 * hh) * 2);
                    const bf16x8 bfr = *(const bf16x8*)(P.VDT + (size_t)r * 512 + 16 * ks + 8 * hh);
                    a1 = MFMA32(bfr, af, a1);
                }
#pragma unroll
                for (int g4 = 0; g4 < 4; ++g4) { v2u w; w.x = pk2(a1[4 * g4], a1[4 * g4 + 1]); w.y = pk2(a1[4 * g4 + 2], a1[4 * g4 + 3]);
                    *(LAS v2u*)(lds + PREP_D + (hd * 32 + r) * PD_STRIDE + (8 * g4 + 4 * hh) * 2) = w; }
            }
            __syncthreads();
        }
        LAS unsigned char* st = lds + PREP_V + hd * PREP_ST_BYTES;
        f32x16 acc[2][2];
        prep_mm<4>(acc, lds + PREP_A, PA_STRIDE, 0, P.DUT, 64, hd, r, hh);    prep_store<0>(acc, P.LW, P.decay_base, t0g, hd, lane, st);
        prep_mm<4>(acc, lds + PREP_A, PA_STRIDE, 64, P.AUT, 64, hd, r, hh);   prep_store<1>(acc, P.AA, P.aaa_base, t0g, hd, lane, st);
        prep_mm<10>(acc, lds + PREP_A, PA_STRIDE, 128, P.GUT, 160, hd, r, hh); prep_store<2>(acc, P.GG, nullptr, t0g, hd, lane, st);
        if (P.layer == 1) { prep_mm<2>(acc, lds + PREP_D, PD_STRIDE, 0, P.VUT, 32, hd, r, hh); prep_store<1>(acc, P.NU, P.vres_base, t0g, hd, lane, st); }
        __syncthreads();
    }
}

struct ScanArgs { const bf16* RKVL; const bf16 *LW, *AA, *GG, *NU; bf16* VF; bf16* YB; const float* mu; const float *k_k, *k_a, *r_k, *gn_g, *gn_b; int layer; };
constexpr int SC_W = 0, SC_A = 16384, SC_B = 32768, SC_K = 49152, SC_R = 65536, SC_V = 81920, SC_Y = 98304, SC_RK = 114688, SC_TAB = 114944;
__device__ __forceinline__ void scan_phase(LAS unsigned char* lds, const ScanArgs& P, int unit, int tid) {
    const int b = unit >> 3, h = unit & 7;
    const int i = tid >> 3, c8 = tid & 7;
    LAS float* tab = (LAS float*)(lds + SC_TAB);
    if (tid < 64) {
        tab[0 * 64 + tid] = P.mu[h * 64 + tid]; tab[1 * 64 + tid] = P.mu[512 + h * 64 + tid]; tab[2 * 64 + tid] = P.mu[1024 + h * 64 + tid];
        tab[3 * 64 + tid] = P.k_k[h * 64 + tid]; tab[4 * 64 + tid] = P.k_a[h * 64 + tid]; tab[5 * 64 + tid] = P.r_k[h * 64 + tid];
        tab[6 * 64 + tid] = P.gn_g[h * 64 + tid]; tab[7 * 64 + tid] = P.gn_b[h * 64 + tid];
    }
    __syncthreads();
    float mur[8], muk[8], muv[8], kkw[8], kaw[8], rkw[8];
#pragma unroll
    for (int j = 0; j < 8; ++j) { mur[j] = tab[8 * c8 + j]; muk[j] = tab[64 + 8 * c8 + j]; muv[j] = tab[128 + 8 * c8 + j]; kkw[j] = tab[192 + 8 * c8 + j]; kaw[j] = tab[256 + 8 * c8 + j]; rkw[j] = tab[320 + 8 * c8 + j]; }
    float S[8];
#pragma unroll
    for (int j = 0; j < 8; ++j) S[j] = 0.f;
    const size_t row0 = (size_t)b * SEQ;
    const int hc = h * 64 + 8 * c8;
    for (int tile = 0; tile < SEQ / 64; ++tile) {
        {
            const int tok = i, s = tile * 64 + tok; const size_t row = row0 + s;
            const bf16* rp = P.RKVL + row * LDR;
            const v4u rc = *(const GAS v4u*)(rp + hc), kc = *(const GAS v4u*)(rp + 512 + hc), vc = *(const GAS v4u*)(rp + 1024 + hc);
            v4u rpv = (v4u){0u, 0u, 0u, 0u}, kpv = rpv, vpv = rpv;
            if (s > 0) { rpv = *(const GAS v4u*)(rp - LDR + hc); kpv = *(const GAS v4u*)(rp - LDR + 512 + hc); vpv = *(const GAS v4u*)(rp - LDR + 1024 + hc); }
            const v4u lwv = *(const GAS v4u*)(P.LW + row * 512 + hc), aav = *(const GAS v4u*)(P.AA + row * 512 + hc);
            float r8[8], rp8[8], k8[8], kp8[8], v8[8], vp8[8], lw8[8], a8[8];
            unpack8(rc, r8); unpack8(rpv, rp8); unpack8(kc, k8); unpack8(kpv, kp8); unpack8(vc, v8); unpack8(vpv, vp8); unpack8(lwv, lw8); unpack8(aav, a8);
            float kk[8], ss = 0.f, rk = 0.f, wv[8], av[8], bv[8], kv[8], rv[8], vv[8];
#pragma unroll
            for (int j = 0; j < 8; ++j) { rv[j] = r8[j] + (rp8[j] - r8[j]) * mur[j]; const float ks = k8[j] + (kp8[j] - k8[j]) * muk[j];
                kk[j] = ks * kkw[j]; ss += kk[j] * kk[j]; kv[j] = ks * (1.f + (a8[j] - 1.f) * kaw[j]); rk += rv[j] * kv[j] * rkw[j];
                wv[j] = __builtin_amdgcn_exp2f(lw8[j] * LOG2E); vv[j] = v8[j] + (vp8[j] - v8[j]) * muv[j]; }
            ss = red8(ss); rk = red8(rk);
            const float rn = __builtin_amdgcn_rsqf(fmaxf(ss, 1e-24f));
#pragma unroll
            for (int j = 0; j < 8; ++j) { const float kn = kk[j] * rn; av[j] = -kn; bv[j] = kn * a8[j]; }
            if (P.layer == 0) { *(GAS v4u*)(P.VF + row * 512 + hc) = pack8(vv); }
            else { const v4u nuv = *(const GAS v4u*)(P.NU + row * 512 + hc), vfv = *(const GAS v4u*)(P.VF + row * 512 + hc); float nu8[8], vf8[8]; unpack8(nuv, nu8); unpack8(vfv, vf8);
#pragma unroll
                for (int j = 0; j < 8; ++j) vv[j] = vv[j] + (vf8[j] - vv[j]) * nu8[j]; }
            const int o = tok * 256 + c8 * 32;
            *(LAS f32x4*)(lds + SC_W + o) = (f32x4){wv[0], wv[1], wv[2], wv[3]}; *(LAS f32x4*)(lds + SC_W + o + 16) = (f32x4){wv[4], wv[5], wv[6], wv[7]};
            *(LAS f32x4*)(lds + SC_A + o) = (f32x4){av[0], av[1], av[2], av[3]}; *(LAS f32x4*)(lds + SC_A + o + 16) = (f32x4){av[4], av[5], av[6], av[7]};
            *(LAS f32x4*)(lds + SC_B + o) = (f32x4){bv[0], bv[1], bv[2], bv[3]}; *(LAS f32x4*)(lds + SC_B + o + 16) = (f32x4){bv[4], bv[5], bv[6], bv[7]};
            *(LAS f32x4*)(lds + SC_K + o) = (f32x4){kv[0], kv[1], kv[2], kv[3]}; *(LAS f32x4*)(lds + SC_K + o + 16) = (f32x4){kv[4], kv[5], kv[6], kv[7]};
            *(LAS f32x4*)(lds + SC_R + o) = (f32x4){rv[0], rv[1], rv[2], rv[3]}; *(LAS f32x4*)(lds + SC_R + o + 16) = (f32x4){rv[4], rv[5], rv[6], rv[7]};
            *(LAS f32x4*)(lds + SC_V + o) = (f32x4){vv[0], vv[1], vv[2], vv[3]}; *(LAS f32x4*)(lds + SC_V + o + 16) = (f32x4){vv[4], vv[5], vv[6], vv[7]};
            if (c8 == 0) *(LAS float*)(lds + SC_RK + tok * 4) = rk;
        }
        __syncthreads();
#pragma unroll 4
        for (int tk = 0; tk < 64; ++tk) {
            const int o = tk * 256 + c8 * 32;
            const f32x4 w0 = *(const LAS f32x4*)(lds + SC_W + o), w1 = *(const LAS f32x4*)(lds + SC_W + o + 16);
            const f32x4 a0 = *(const LAS f32x4*)(lds + SC_A + o), a1 = *(const LAS f32x4*)(lds + SC_A + o + 16);
            const f32x4 b0 = *(const LAS f32x4*)(lds + SC_B + o), b1 = *(const LAS f32x4*)(lds + SC_B + o + 16);
            const f32x4 k0 = *(const LAS f32x4*)(lds + SC_K + o), k1 = *(const LAS f32x4*)(lds + SC_K + o + 16);
            const f32x4 r0 = *(const LAS f32x4*)(lds + SC_R + o), r1 = *(const LAS f32x4*)(lds + SC_R + o + 16);
            const float vi = *(const LAS float*)(lds + SC_V + tk * 256 + i * 4);
            float sa = (S[0] * a0[0] + S[1] * a0[1]) + (S[2] * a0[2] + S[3] * a0[3]) + ((S[4] * a1[0] + S[5] * a1[1]) + (S[6] * a1[2] + S[7] * a1[3]));
            sa = red8(sa);
#pragma unroll
            for (int j = 0; j < 4; ++j) { S[j] = S[j] * w0[j] + (sa * b0[j] + vi * k0[j]); S[4 + j] = S[4 + j] * w1[j] + (sa * b1[j] + vi * k1[j]); }
            float y = (S[0] * r0[0] + S[1] * r0[1]) + (S[2] * r0[2] + S[3] * r0[3]) + ((S[4] * r1[0] + S[5] * r1[1]) + (S[6] * r1[2] + S[7] * r1[3]));
            y = red8(y);
            if (c8 == 0) *(LAS float*)(lds + SC_Y + tk * 256 + i * 4) = y;
        }
        __syncthreads();
        {
            const int tok = i; const size_t row = row0 + tile * 64 + tok;
            const f32x4 y0 = *(const LAS f32x4*)(lds + SC_Y + tok * 256 + c8 * 32), y1 = *(const LAS f32x4*)(lds + SC_Y + tok * 256 + c8 * 32 + 16);
            const f32x4 v0 = *(const LAS f32x4*)(lds + SC_V + tok * 256 + c8 * 32), v1 = *(const LAS f32x4*)(lds + SC_V + tok * 256 + c8 * 32 + 16);
            const float rk = *(const LAS float*)(lds + SC_RK + tok * 4);
            const v4u gv = *(const GAS v4u*)(P.GG + row * 512 + hc); float g8[8]; unpack8(gv, g8);
            float yy[8] = {y0[0], y0[1], y0[2], y0[3], y1[0], y1[1], y1[2], y1[3]}, vv[8] = {v0[0], v0[1], v0[2], v0[3], v1[0], v1[1], v1[2], v1[3]};
            float sm = 0.f;
#pragma unroll
            for (int j = 0; j < 8; ++j) sm += yy[j];
            const float mean = red8(sm) * (1.f / 64.f); float sq = 0.f;
#pragma unroll
            for (int j = 0; j < 8; ++j) { yy[j] -= mean; sq += yy[j] * yy[j]; }
            const float rstd = __builtin_amdgcn_rsqf(red8(sq) * (1.f / 64.f) + GN_EPS);
            float o8[8];
#pragma unroll
            for (int j = 0; j < 8; ++j) o8[j] = (yy[j] * rstd * tab[384 + 8 * c8 + j] + tab[448 + 8 * c8 + j] + rk * vv[j]) * g8[j];
            *(GAS v4u*)(P.YB + row * 512 + hc) = pack8(o8);
        }
        __syncthreads();
    }
}

__device__ __forceinline__ void route_phase(LAS unsigned char* lds, const float* LOG, unsigned* cnt, int* TOKE, int* TOKP, float* TOKW, int* ELIST, int row0, int tid) {
    LAS unsigned* lc = (LAS unsigned*)lds;
    if (tid < 64) lc[tid] = 0u;
    __syncthreads();
    const int m = row0 + tid; const bool act = tid < 256;
    int x0 = 0, x1 = 1; float wa = 0.f, wb = 0.f; unsigned r0 = 0u, r1 = 0u;
    if (act) {
        const float* lg = LOG + (size_t)m * 64;
        const f32x4 gl = *(const f32x4*)lg;
        int grp = 0; float gm = gl[0];
        if (gl[1] > gm) { gm = gl[1]; grp = 1; } if (gl[2] > gm) { gm = gl[2]; grp = 2; } if (gl[3] > gm) { gm = gl[3]; grp = 3; }
        const float se = __expf(gl[0] - gm) + __expf(gl[1] - gm) + __expf(gl[2] - gm) + __expf(gl[3] - gm);
        const float gate = 1.f / se;
        const f32x4 e0 = *(const f32x4*)(lg + 4 + grp * 8), e1 = *(const f32x4*)(lg + 8 + grp * 8);
        const float v[8] = {e0[0], e0[1], e0[2], e0[3], e1[0], e1[1], e1[2], e1[3]};
        int i0 = 0; float v0 = v[0];
#pragma unroll
        for (int j = 1; j < 8; ++j) if (v[j] > v0) { v0 = v[j]; i0 = j; }
        int i1 = -1; float v1 = -INFINITY;
#pragma unroll
        for (int j = 0; j < 8; ++j) if (j != i0 && (i1 < 0 || v[j] > v1)) { v1 = v[j]; i1 = j; }
        const float w0 = 1.f / (1.f + __expf(v1 - v0)), w1 = 1.f - w0;
        x0 = grp * 8 + i0; x1 = grp * 8 + i1; wa = w0 * gate; wb = w1 * gate;
        r0 = __hip_atomic_fetch_add(lc + x0, 1u, __ATOMIC_RELAXED, __HIP_MEMORY_SCOPE_WORKGROUP); r1 = __hip_atomic_fetch_add(lc + x1, 1u, __ATOMIC_RELAXED, __HIP_MEMORY_SCOPE_WORKGROUP);
    }
    __syncthreads();
    if (tid < 32) lc[32 + tid] = __hip_atomic_fetch_add(cnt + tid, lc[tid], RLX_AGENT);
    __syncthreads();
    if (act) {
        const unsigned p0 = lc[32 + x0] + r0, p1 = lc[32 + x1] + r1;
        TOKE[2 * m] = x0; TOKE[2 * m + 1] = x1; TOKP[2 * m] = (int)p0; TOKP[2 * m + 1] = (int)p1; TOKW[2 * m] = wa; TOKW[2 * m + 1] = wb;
        ELIST[x0 * 32768 + (int)p0] = m; ELIST[x1 * 32768 + (int)p1] = m;
    }
}
__device__ __forceinline__ int moe_tables(LAS unsigned char* lds, unsigned* cnt, int tid) {
    LAS int* tl = (LAS int*)(lds + TILE_LDS);
    if (tid < 64) {
        const int c = tid < 32 ? (int)__hip_atomic_load(cnt + tid, RLX_AGENT) : 0, pad = (c + 255) & ~255; int inc = pad;
#pragma unroll
        for (int o = 1; o < 32; o <<= 1) { const int t = __shfl_up(inc, o); if (tid >= o) inc += t; }
        const int off = inc - pad;
        if (tid < 32) { tl[576 + tid] = c; tl[512 + tid] = off; for (int rt = off >> 8; rt < (inc >> 8); ++rt) tl[rt] = tid; }
        if (tid == 31) tl[544] = inc;
    }
    __syncthreads();
    return tl[544] >> 8;
}


#define LDS_BAR() do { asm volatile("s_waitcnt lgkmcnt(0)" ::: "memory"); __builtin_amdgcn_s_barrier(); asm volatile("" ::: "memory"); } while (0)
struct CsArgs { const bf16* RKVL; const bf16 *LW, *AA, *GG, *NU; bf16* VF; bf16* YB; unsigned char* GH; unsigned char* QY; bf16* BON; const float* mu; const float *k_k, *k_a, *r_k, *gn_g, *gn_b; int layer; };
constexpr int RS = 144, TS = 136, FS = 272;
constexpr int CS_R0 = 0, CS_LWT = 17408, CS_AE = 26112, CS_BI = 35328, CS_KI = 44544, CS_RI = 53760, CS_VT = 62976, CS_BGT = 71680, CS_KGT = 80384, CS_MV = 89088, CS_UT = 106496,
              CS_GL = 115200, CS_RK = 115456, CS_TAB = 115712,
              CS_AET = 117760, CS_MVT = CS_MV, CS_T = CS_MV + 8704;
__device__ __forceinline__ int tsw(int n, int o) { return (o + 16 * ((n >> 4) & 3)) & 127; }
__device__ __forceinline__ void tstore(LAS unsigned char* tile, const unsigned (&w)[4], int c8, int tok, int par) {
    const unsigned s0 = par ? w[0] : w[2], s1 = par ? w[1] : w[3];
    const unsigned r0 = (unsigned)__builtin_amdgcn_update_dpp(0, (int)s0, 0x128, 0xF, 0xF, true), r1 = (unsigned)__builtin_amdgcn_update_dpp(0, (int)s1, 0x128, 0xF, 0xF, true);
    const unsigned m0 = par ? w[2] : w[0], m1 = par ? w[3] : w[1];
    const unsigned e0 = par ? r0 : m0, o0 = par ? m0 : r0, e1 = par ? r1 : m1, o1 = par ? m1 : r1;
    LAS unsigned char* p = tile + (8 * c8 + 4 * par) * TS + tsw(8 * c8, (tok & ~1) * 2);
    *(LAS unsigned*)(p) = (e0 & 0xffffu) | (o0 << 16); *(LAS unsigned*)(p + TS) = (e0 >> 16) | (o0 & 0xffff0000u);
    *(LAS unsigned*)(p + 2 * TS) = (e1 & 0xffffu) | (o1 << 16); *(LAS unsigned*)(p + 3 * TS) = (e1 >> 16) | (o1 & 0xffff0000u);
}
__device__ __forceinline__ bf16x8 pack_frag(const f32x16& x, int st) {
    v4u w; w.x = pk2(x[8 * st + 0], x[8 * st + 1]); w.y = pk2(x[8 * st + 2], x[8 * st + 3]); w.z = pk2(x[8 * st + 4], x[8 * st + 5]); w.w = pk2(x[8 * st + 6], x[8 * st + 7]);
    return __builtin_bit_cast(bf16x8, w);
}
__device__ __forceinline__ bf16x8 lds_frag2(const LAS unsigned char* p0, const LAS unsigned char* p1) {
    const v2u a = *(const LAS v2u*)p0, b = *(const LAS v2u*)p1; v4u w; w.x = a.x; w.y = a.y; w.z = b.x; w.w = b.y; return __builtin_bit_cast(bf16x8, w);
}
__device__ __forceinline__ float keep_if_neg(float x, int d) { int m = d >> 31; asm volatile("" : "+v"(m)); return __uint_as_float(__float_as_uint(x) & (unsigned)m); }
__device__ __forceinline__ f32x16 zero16() { f32x16 z;
#pragma unroll
    for (int i = 0; i < 16; ++i) z[i] = 0.f;
    return z; }
__device__ __forceinline__ f32x16 mm_rr(const LAS unsigned char* At, int sb, const LAS unsigned char* Bt, int tb, int r, int hh) {
    f32x16 x = zero16();
#pragma unroll
    for (int ks = 0; ks < 4; ++ks) { const bf16x8 a = *(const LAS bf16x8*)(At + (32 * sb + r) * RS + (16 * ks + 8 * hh) * 2), b = *(const LAS bf16x8*)(Bt + (32 * tb + r) * RS + (16 * ks + 8 * hh) * 2);
        x = MFMA32(a, b, x); }
    return x;
}
__device__ __forceinline__ void mm_xt(f32x16& z, const f32x16& x, const LAS unsigned char* BT, int sb, int nb, int r, int hh) {
#pragma unroll
    for (int st = 0; st < 2; ++st) { const int n = 32 * nb + r, o = (32 * sb + 16 * st + 4 * hh) * 2; const LAS unsigned char* p = BT + n * TS;
        z = MFMA32(pack_frag(x, st), lds_frag2(p + tsw(n, o), p + tsw(n, o + 16)), z); }
}
__device__ __forceinline__ void mm_ax(f32x16& z, const LAS unsigned char* AT, int mb, const f32x16& x, int sb, int r, int hh) {
#pragma unroll
    for (int st = 0; st < 2; ++st) { const int n = 32 * mb + r, o = (32 * sb + 16 * st + 4 * hh) * 2; const LAS unsigned char* p = AT + n * TS;
        z = MFMA32(lds_frag2(p + tsw(n, o), p + tsw(n, o + 16)), pack_frag(x, st), z); }
}
__device__ __forceinline__ void mm_tt(f32x16& z, const LAS unsigned char* AT, int mb, const LAS unsigned char* BT, int nb, int r, int hh) {
#pragma unroll
    for (int ks = 0; ks < 4; ++ks) { const LAS unsigned char* pa = AT + (32 * mb + r) * TS + tsw(32 * mb + r, (16 * ks + 8 * hh) * 2); const LAS unsigned char* pb = BT + (32 * nb + r) * TS + tsw(32 * nb + r, (16 * ks + 8 * hh) * 2);
        z = MFMA32(lds_frag2(pa, pa + 8), lds_frag2(pb, pb + 8), z); }
}
__device__ __forceinline__ void mm_rs(f32x16& z, const LAS unsigned char* At, int tb, const bf16x8 (&sfr)[2][2], int r, int hh) {
#pragma unroll
    for (int kb = 0; kb < 2; ++kb)
#pragma unroll
        for (int st = 0; st < 2; ++st) { const LAS unsigned char* p = At + (32 * tb + r) * RS + (32 * kb + 16 * st + 4 * hh) * 2;
            z = MFMA32(lds_frag2(p, p + 16), sfr[kb][st], z); }
}
__device__ __forceinline__ void tri_solve(float (&xq)[16], const LAS unsigned char* Mp, int q, const float (&rq)[16]) {
    const LAS unsigned char* mq = Mp + q * 1920;
    const LAS unsigned char* md = Mp + 7680 + q * 16;
    const bool q1 = (q & 1) != 0, q2 = (q & 2) != 0;
    f32x4 acc = (f32x4){0.f, 0.f, 0.f, 0.f};
    f32x4 mn[2][15], ddv[2];
    ddv[0] = *(const LAS f32x4*)md;
    mn[1][0] = *(const LAS f32x4*)mq; ddv[1] = *(const LAS f32x4*)(md + 64);
#pragma unroll
    for (int g = 0; g < 16; ++g) {
        asm volatile("" ::: "memory");
        const f32x4 dd = ddv[g & 1];
        if (g + 2 < 16) {
#pragma unroll
            for (int i = 0; i <= g + 1; ++i) mn[g & 1][i] = *(const LAS f32x4*)(mq + (((g + 2) * (g + 1)) / 2 + i) * 16);
            ddv[g & 1] = *(const LAS f32x4*)(md + (g + 2) * 64);
        }
        const float a0 = q1 ? acc[1] : acc[0], a1 = q1 ? acc[3] : acc[2], b0 = q1 ? acc[0] : acc[1], b1 = q1 ? acc[2] : acc[3];
        const float c0 = a0 + dppf<0xB1>(b0), c1 = a1 + dppf<0xB1>(b1);
        float bq = rq[g] + ((q2 ? c1 : c0) + dppf<0x4E>(q2 ? c0 : c1));
        bq += dd[0] * dppf<0x00>(bq);
        bq += dd[1] * dppf<0x55>(bq);
        bq += dd[2] * dppf<0xAA>(bq);
        xq[g] = bq;
        if (g + 1 < 16) {
            f32x4 e0 = (f32x4){0.f, 0.f, 0.f, 0.f}, e1 = e0;
#pragma unroll
            for (int i = 0; i <= g; ++i) asm volatile("" : "+v"(mn[(g + 1) & 1][i]) : "v"(bq));
#pragma unroll
            for (int i = 0; i <= g; ++i) { if (i & 1) e1 += mn[(g + 1) & 1][i] * xq[i]; else e0 += mn[(g + 1) & 1][i] * xq[i]; }
            acc = e0 + e1;
        }
    }
}

struct CsRaw { v4u rc, kc, vc, rpv, kpv, vpv, lwv, aav, nuv, vfv; };
__device__ __forceinline__ void cs_load(CsRaw& R, const CsArgs& P, int u, int tid) {
    const int bh = u >> 5, c = u & 31, b = bh >> 3, h = bh & 7, tok = tid >> 3, c8 = tid & 7, hc = h * 64 + 8 * c8, s = c * 64 + tok; const size_t row = (size_t)b * SEQ + s;
    const bf16* rp = P.RKVL + row * LDR;
    R.rc = *(const GAS v4u*)(rp + hc); R.kc = *(const GAS v4u*)(rp + 512 + hc); R.vc = *(const GAS v4u*)(rp + 1024 + hc);
    R.rpv = (v4u){0u, 0u, 0u, 0u}; R.kpv = R.rpv; R.vpv = R.rpv; R.nuv = R.rpv; R.vfv = R.rpv;
    if (s > 0) { R.rpv = *(const GAS v4u*)(rp - LDR + hc); R.kpv = *(const GAS v4u*)(rp - LDR + 512 + hc); R.vpv = *(const GAS v4u*)(rp - LDR + 1024 + hc); }
    R.lwv = *(const GAS v4u*)(P.LW + row * 512 + hc); R.aav = *(const GAS v4u*)(P.AA + row * 512 + hc);
    if (P.layer == 1) { R.nuv = *(const GAS v4u*)(P.NU + row * 512 + hc); R.vfv = *(const GAS v4u*)(P.VF + row * 512 + hc); }
}
template <int MODE> __device__ __forceinline__ void cs_stage1(LAS unsigned char* lds, const CsArgs& P, const CsRaw& R, int b, int h, int c, int tid, int wv) {
    const int tok = tid >> 3, c8 = tid & 7, lane = tid & 63, r = lane & 31, hh = lane >> 5;
    const int hc = h * 64 + 8 * c8;
    const int s = c * 64 + tok; const size_t row = (size_t)b * SEQ + s;
    const LAS float* tab = (const LAS float*)(lds + CS_TAB);
    {
        const unsigned w4[4] = {R.lwv.x, R.lwv.y, R.lwv.z, R.lwv.w};
        tstore(lds + CS_LWT, w4, c8, tok, tok & 1);
    }
    LDS_BAR();
    if (wv < 4) {
        const int tb = wv >> 1, nb = wv & 1; f32x16 cu = zero16();
#pragma unroll
        for (int ks = 0; ks < 4; ++ks) {
            const int trow = 32 * tb + r, s0 = 16 * ks + 8 * hh;
            v4u aw; unsigned e[8];
#pragma unroll
            for (int j = 0; j < 8; ++j) { int m = (trow - s0 - j) >> 31; asm volatile("" : "+v"(m)); e[j] = 0x3F80u & ~(unsigned)m; }
            aw.x = e[0] | (e[1] << 16); aw.y = e[2] | (e[3] << 16); aw.z = e[4] | (e[5] << 16); aw.w = e[6] | (e[7] << 16);
            const LAS unsigned char* p = lds + CS_LWT + (32 * nb + r) * TS + tsw(32 * nb + r, s0 * 2);
            cu = MFMA32(__builtin_bit_cast(bf16x8, aw), lds_frag2(p, p + 8), cu);
        }
#pragma unroll
        for (int i = 0; i < 16; ++i) *(LAS float*)(lds + CS_R0 + (32 * tb + crow(i, hh)) * FS + (32 * nb + r) * 4) = cu[i];
    }
    LDS_BAR();
    {
        float r8[8], rp8[8], k8[8], kp8[8], v8[8], vp8[8], a8[8], nu8[8], vf8[8], lw8[8];
        unpack8(R.rc, r8); unpack8(R.rpv, rp8); unpack8(R.kc, k8); unpack8(R.kpv, kp8); unpack8(R.vc, v8); unpack8(R.vpv, vp8); unpack8(R.lwv, lw8); unpack8(R.aav, a8); unpack8(R.nuv, nu8); unpack8(R.vfv, vf8);
        float kk[8], ss = 0.f, rk = 0.f, av[8], bv[8], kv[8], rv[8], vv[8];
#pragma unroll
        for (int j = 0; j < 8; ++j) { rv[j] = r8[j] + (rp8[j] - r8[j]) * tab[8 * c8 + j]; const float ks = k8[j] + (kp8[j] - k8[j]) * tab[64 + 8 * c8 + j];
            kk[j] = ks * tab[192 + 8 * c8 + j]; ss += kk[j] * kk[j]; kv[j] = ks * (1.f + (a8[j] - 1.f) * tab[256 + 8 * c8 + j]); rk += rv[j] * kv[j] * tab[320 + 8 * c8 + j];
            vv[j] = v8[j] + (vp8[j] - v8[j]) * tab[128 + 8 * c8 + j]; }
        ss = red8(ss); rk = red8(rk);
        const float rn = __builtin_amdgcn_rsqf(fmaxf(ss, 1e-24f));
#pragma unroll
        for (int j = 0; j < 8; ++j) { const float kn = kk[j] * rn; av[j] = -kn; bv[j] = kn * a8[j]; }
        if (P.layer == 0) *(GAS v4u*)(P.VF + row * 512 + hc) = pack8(vv);
        else {
#pragma unroll
            for (int j = 0; j < 8; ++j) vv[j] = vv[j] + (vf8[j] - vv[j]) * nu8[j]; }
        { float bo[8];
#pragma unroll
          for (int j = 0; j < 8; ++j) bo[j] = rk * vv[j];
          *(GAS v4u*)(P.BON + row * 512 + hc) = pack8(bo); }
        const f32x4 c0 = *(const LAS f32x4*)(lds + CS_R0 + tok * FS + c8 * 32), c1 = *(const LAS f32x4*)(lds + CS_R0 + tok * FS + c8 * 32 + 16);
        const f32x4 l0 = *(const LAS f32x4*)(lds + CS_R0 + 63 * FS + c8 * 32), l1 = *(const LAS f32x4*)(lds + CS_R0 + 63 * FS + c8 * 32 + 16);
        const float cum[8] = {c0[0], c0[1], c0[2], c0[3], c1[0], c1[1], c1[2], c1[3]}, cl[8] = {l0[0], l0[1], l0[2], l0[3], l1[0], l1[1], l1[2], l1[3]};
        float ae[8], bi[8], ki[8], ri[8], bg[8], kg[8];
#pragma unroll
        for (int j = 0; j < 8; ++j) { const float ex = __builtin_amdgcn_exp2f((cum[j] - lw8[j]) * LOG2E), ei = __builtin_amdgcn_exp2f(-cum[j] * LOG2E), ec = __builtin_amdgcn_exp2f(cum[j] * LOG2E),
                                                  el = __builtin_amdgcn_exp2f((cl[j] - cum[j]) * LOG2E);
            ae[j] = av[j] * ex; bi[j] = bv[j] * ei; ki[j] = kv[j] * ei; ri[j] = rv[j] * ec; bg[j] = bv[j] * el; kg[j] = kv[j] * el; }
        { const v4u pa = pack8(ae); *(LAS v4u*)(lds + CS_AE + tok * RS + c8 * 16) = pa; const unsigned wa[4] = {pa.x, pa.y, pa.z, pa.w}; tstore(lds + CS_AET, wa, c8, tok, tok & 1); } *(LAS v4u*)(lds + CS_BI + tok * RS + c8 * 16) = pack8(bi); *(LAS v4u*)(lds + CS_KI + tok * RS + c8 * 16) = pack8(ki);
        *(LAS v4u*)(lds + CS_RI + tok * RS + c8 * 16) = pack8(ri);
        { unsigned wv2[4], wb[4], wk[4];
#pragma unroll
          for (int p = 0; p < 4; ++p) { wv2[p] = pk2(vv[2 * p], vv[2 * p + 1]); wb[p] = pk2(bg[2 * p], bg[2 * p + 1]); wk[p] = pk2(kg[2 * p], kg[2 * p + 1]); }
          tstore(lds + CS_VT, wv2, c8, tok, tok & 1); tstore(lds + CS_BGT, wb, c8, tok, tok & 1); tstore(lds + CS_KGT, wk, c8, tok, tok & 1); }
        if (tok == 63) {
#pragma unroll
            for (int j = 0; j < 8; ++j) *(LAS float*)(lds + CS_GL + (8 * c8 + j) * 4) = __builtin_amdgcn_exp2f(cl[j] * LOG2E); }
    }
    LDS_BAR();
}
template <int MODE> __device__ __forceinline__ void cs_stage2(LAS unsigned char* lds, const unsigned char* gu, int lane, int wv) {
    const int r = lane & 31, hh = lane >> 5;
    if (wv < 4) {
        const int tb = wv >> 1, vb = wv & 1; f32x16 z = zero16();
        for (int sb = 0; sb <= tb; ++sb) {
            f32x16 x = mm_rr(lds + CS_KI, sb, lds + CS_AE, tb, r, hh);
#pragma unroll
            for (int i = 0; i < 16; ++i) x[i] = keep_if_neg(x[i], (32 * sb + crow(i, hh)) - (32 * tb + r));
            mm_xt(z, x, lds + CS_VT, sb, vb, r, hh);
        }
        if (MODE == 3) { bf16x8 sfr[2][2];
#pragma unroll
            for (int kb = 0; kb < 2; ++kb)
#pragma unroll
                for (int st = 0; st < 2; ++st) sfr[kb][st] = *(const bf16x8*)(gu + ((kb * 2 + vb) * 2 + st) * 1024 + lane * 16);
            mm_rs(z, lds + CS_AE, tb, sfr, r, hh); }
        if (MODE == 3) {
#pragma unroll
            for (int i = 0; i < 16; ++i) *(LAS float*)(lds + CS_MV + (32 * tb + crow(i, hh)) * FS + (32 * vb + r) * 4) = z[i];
        } else {
#pragma unroll
            for (int g4 = 0; g4 < 4; ++g4) { const int vr = 32 * vb + r; v2u w; w.x = pk2(z[4 * g4], z[4 * g4 + 1]); w.y = pk2(z[4 * g4 + 2], z[4 * g4 + 3]);
                *(LAS v2u*)(lds + CS_MVT + vr * TS + tsw(vr, (32 * tb + 8 * g4 + 4 * hh) * 2)) = w; }
        }
    } else if (wv < 7) {
        const int tb = wv == 4 ? 0 : 1, sb = wv == 6 ? 1 : 0;
        const f32x16 x = mm_rr(lds + CS_AE, tb, lds + CS_BI, sb, r, hh);
        const int scol = 32 * sb + r, si = scol >> 2, sq = scol & 3;
#pragma unroll
        for (int i = 0; i < 16; ++i) { const int t = 32 * tb + crow(i, hh), g = t >> 2, rr = i & 3;
            int off = sq * 1920 + ((g * (g - 1)) / 2 + si) * 16 + rr * 4;
            off = (si == g) ? 7680 + (g * 4 + rr) * 16 + sq * 4 : off;
            off = (si > g) ? 8704 + lane * 4 : off;
            *(LAS float*)(lds + CS_R0 + off) = keep_if_neg(x[i], scol - t); }
    }
    LDS_BAR();
}

__device__ __forceinline__ void cs_d1(LAS unsigned char* lds, const CsArgs& P, int vcu, int G, int tid, int wv) {
    {
        const int h = (vcu >> 5) & 7;
        LAS float* tab = (LAS float*)(lds + CS_TAB);
        if (tid < 64) { tab[tid] = P.mu[h * 64 + tid]; tab[64 + tid] = P.mu[512 + h * 64 + tid]; tab[128 + tid] = P.mu[1024 + h * 64 + tid];
            tab[192 + tid] = P.k_k[h * 64 + tid]; tab[256 + tid] = P.k_a[h * 64 + tid]; tab[320 + tid] = P.r_k[h * 64 + tid]; tab[384 + tid] = P.gn_g[h * 64 + tid]; tab[448 + tid] = P.gn_b[h * 64 + tid]; }
        LDS_BAR();
    }
    CsRaw raw; if (vcu < 4096) cs_load(raw, P, vcu, tid);
    for (int u = vcu; u < 4096; u += G) {
        int tidu = tid; asm volatile("" : "+v"(tidu)); const int lane = tidu & 63;
        const int r = lane & 31, hh = lane >> 5;
        const int bh = u >> 5, c = u & 31, b = bh >> 3, h = bh & 7;
        unsigned char* gu = P.GH + (size_t)u * 16384;
#if ((REPMASK) >> 19) & 3
        { int n1_ = (((REPMASK) >> 19) & 1) ? 2 : 1, n2_ = (((REPMASK) >> 20) & 1) ? 2 : 1; asm volatile("" : "+s"(n1_), "+s"(n2_));
          for (int rep_ = 0; rep_ < n1_; ++rep_) cs_stage1<1>(lds, P, raw, b, h, c, tidu, wv);
          for (int rep_ = 0; rep_ < n2_; ++rep_) cs_stage2<1>(lds, gu, lane, wv); }
#else
        cs_stage1<1>(lds, P, raw, b, h, c, tidu, wv);
        cs_stage2<1>(lds, gu, lane, wv);
#endif
        if (wv < 4) {
            const int col = wv * 16 + (lane >> 2), q = lane & 3; float xq[16], rq[16];
#pragma unroll
            for (int i = 0; i < 16; ++i) rq[i] = (4 * i + q == col) ? 1.f : 0.f;
            tri_solve(xq, lds + CS_R0, q, rq);
#if ((REPMASK) >> 18) & 1
            { float rq2[16];
#pragma unroll
              for (int i = 0; i < 16; ++i) rq2[i] = rq[i] + 0.f * xq[i];
              asm volatile("" ::: "memory"); tri_solve(xq, lds + CS_R0, q, rq2); }
#endif
#pragma unroll
            for (int i = 0; i < 16; ++i) { const int t = 4 * i + q; *(LAS bf16*)(lds + CS_T + t * TS + tsw(t, col * 2)) = (bf16)f2bf(xq[i]); }
        }
        LDS_BAR();
        if (u + G < 4096) cs_load(raw, P, u + G, tid);
        {
            const int mat = wv >> 2, mb = (wv >> 1) & 1, nb = wv & 1; f32x16 z = zero16();
            mm_tt(z, lds + CS_T, mb, lds + (mat ? CS_MVT : CS_AET), nb, r, hh);
            LAS unsigned char* dt = lds + (mat ? CS_UT : CS_LWT);
#pragma unroll
            for (int g4 = 0; g4 < 4; ++g4) { const int n = 32 * nb + r; v2u w; w.x = pk2(z[4 * g4], z[4 * g4 + 1]); w.y = pk2(z[4 * g4 + 2], z[4 * g4 + 3]);
                *(LAS v2u*)(dt + n * TS + tsw(n, (32 * mb + 8 * g4 + 4 * hh) * 2)) = w; }
        }
        LDS_BAR();
        unsigned char* qy = P.QY + (size_t)u * 16384;
#if ((REPMASK) >> 22) & 1
        int n3_ = 2; asm volatile("" : "+s"(n3_));
        for (int rep_ = 0; rep_ < n3_; ++rep_) {
#else
        {
#endif
        const int tbq = wv & 1;
        if (wv < 4) {
            const int jb = wv >> 1, jpb = wv & 1; f32x16 g = zero16();
            mm_tt(g, lds + CS_LWT, jb, lds + CS_BGT, jpb, r, hh);
            if (jb == jpb) { const float gl = *(const LAS float*)(lds + CS_GL + (32 * jb + r) * 4);
#pragma unroll
                for (int i = 0; i < 16; ++i) { const int d = crow(i, hh) - r; g[i] += keep_if_neg(gl, (d | -d) >> 31 ? 0 : -1); } }
#pragma unroll
            for (int st = 0; st < 2; ++st) *(bf16x8*)(gu + ((jpb * 2 + jb) * 2 + st) * 1024 + lane * 16) = pack_frag(g, st);
            f32x16 qe;
#pragma unroll
            for (int g4 = 0; g4 < 4; ++g4) { const v2u w = *(const LAS v2u*)(lds + CS_RI + (32 * tbq + r) * RS + (32 * jb + 8 * g4 + 4 * hh) * 2);
                qe[4 * g4] = bflo(w.x); qe[4 * g4 + 1] = bfhi(w.x); qe[4 * g4 + 2] = bflo(w.y); qe[4 * g4 + 3] = bfhi(w.y); }
            for (int sb = 0; sb <= tbq; ++sb) {
                f32x16 x = mm_rr(lds + CS_BI, sb, lds + CS_RI, tbq, r, hh);
#pragma unroll
                for (int i = 0; i < 16; ++i) x[i] = keep_if_neg(x[i], (32 * sb + crow(i, hh)) - (32 * tbq + r) - 1);
                mm_ax(qe, lds + CS_LWT, jb, x, sb, r, hh);
            }
#pragma unroll
            for (int st = 0; st < 2; ++st) *(bf16x8*)(qy + ((jb * 2 + tbq) * 2 + st) * 1024 + lane * 16) = pack_frag(qe, st);
        } else {
            const int jpb = (wv - 4) >> 1, vb = wv & 1; f32x16 hacc = zero16();
            mm_tt(hacc, lds + CS_BGT, jpb, lds + CS_UT, vb, r, hh);
            mm_tt(hacc, lds + CS_KGT, jpb, lds + CS_VT, vb, r, hh);
#pragma unroll
            for (int st = 0; st < 2; ++st) *(bf16x8*)(gu + 8192 + ((jpb * 2 + vb) * 2 + st) * 1024 + lane * 16) = pack_frag(hacc, st);
            const int vq = (wv - 4) >> 1; f32x16 y0 = zero16();
            for (int sb = 0; sb <= tbq; ++sb) {
                f32x16 x = mm_rr(lds + CS_BI, sb, lds + CS_RI, tbq, r, hh);
#pragma unroll
                for (int i = 0; i < 16; ++i) x[i] = keep_if_neg(x[i], (32 * sb + crow(i, hh)) - (32 * tbq + r) - 1);
                mm_ax(y0, lds + CS_UT, vq, x, sb, r, hh);
                x = mm_rr(lds + CS_KI, sb, lds + CS_RI, tbq, r, hh);
#pragma unroll
                for (int i = 0; i < 16; ++i) x[i] = keep_if_neg(x[i], (32 * sb + crow(i, hh)) - (32 * tbq + r) - 1);
                mm_ax(y0, lds + CS_VT, vq, x, sb, r, hh);
            }
#pragma unroll
            for (int st = 0; st < 2; ++st) *(bf16x8*)(qy + 8192 + ((vq * 2 + tbq) * 2 + st) * 1024 + lane * 16) = pack_frag(y0, st);
        }
        }
        LDS_BAR();
    }
}
__device__ __forceinline__ void cs_d2(const CsArgs& P, int bh, int tid, int wv) {
    const int lane = tid & 63, vb = wv & 1;
    f32x16 X[2] = {zero16(), zero16()};
    bf16x8 gf[2][2][2], hf[2][2];
    const unsigned char* g0 = P.GH + (size_t)(bh * 32) * 16384;
    if (wv < 2) {
#pragma unroll
        for (int mb = 0; mb < 2; ++mb) {
#pragma unroll
            for (int kb = 0; kb < 2; ++kb)
#pragma unroll
                for (int st = 0; st < 2; ++st) gf[mb][kb][st] = *(const bf16x8*)(g0 + ((mb * 2 + kb) * 2 + st) * 1024 + lane * 16);
#pragma unroll
            for (int st = 0; st < 2; ++st) hf[mb][st] = *(const bf16x8*)(g0 + 8192 + ((mb * 2 + vb) * 2 + st) * 1024 + lane * 16);
        }
    }
    for (int c = 0; c < 32; ++c) {
        unsigned char* gu = P.GH + (size_t)(bh * 32 + c) * 16384;
        VM_WAIT();
        __syncthreads();
        if (wv < 2) {
            bf16x8 pk[2][2];
#pragma unroll
            for (int kb = 0; kb < 2; ++kb)
#pragma unroll
                for (int st = 0; st < 2; ++st) { pk[kb][st] = pack_frag(X[kb], st); *(bf16x8*)(gu + ((kb * 2 + vb) * 2 + st) * 1024 + lane * 16) = pk[kb][st]; }
            f32x16 Xn[2];
#pragma unroll
            for (int mb = 0; mb < 2; ++mb) {
#pragma unroll
                for (int st = 0; st < 2; ++st) { const v4u w = __builtin_bit_cast(v4u, hf[mb][st]);
                    Xn[mb][8 * st + 0] = bflo(w.x); Xn[mb][8 * st + 1] = bfhi(w.x); Xn[mb][8 * st + 2] = bflo(w.y); Xn[mb][8 * st + 3] = bfhi(w.y);
                    Xn[mb][8 * st + 4] = bflo(w.z); Xn[mb][8 * st + 5] = bfhi(w.z); Xn[mb][8 * st + 6] = bflo(w.w); Xn[mb][8 * st + 7] = bfhi(w.w); }
#pragma unroll
                for (int kb = 0; kb < 2; ++kb)
#pragma unroll
                    for (int st = 0; st < 2; ++st) Xn[mb] = MFMA32(gf[mb][kb][st], pk[kb][st], Xn[mb]);
            }
            if (c + 1 < 32) {
                const unsigned char* gn = gu + 16384;
#pragma unroll
                for (int mb = 0; mb < 2; ++mb) {
#pragma unroll
                    for (int kb = 0; kb < 2; ++kb)
#pragma unroll
                        for (int st = 0; st < 2; ++st) gf[mb][kb][st] = *(const bf16x8*)(gn + ((mb * 2 + kb) * 2 + st) * 1024 + lane * 16);
#pragma unroll
                    for (int st = 0; st < 2; ++st) hf[mb][st] = *(const bf16x8*)(gn + 8192 + ((mb * 2 + vb) * 2 + st) * 1024 + lane * 16);
                }
            }
            X[0] = Xn[0]; X[1] = Xn[1];
        }
    }
}
__device__ __forceinline__ void cs_d3(LAS unsigned char* lds, const CsArgs& P, int vcu, int G, int tid, int wv) {
    const int lane = tid & 63, r = lane & 31, hh = lane >> 5;
    LAS float* tab = (LAS float*)(lds + CS_TAB);
    LDS_BAR();
    for (int i = tid; i < 512; i += NWAVES * 64) { tab[i] = P.gn_g[i]; tab[512 + i] = P.gn_b[i]; }
    LDS_BAR();
    for (int it = vcu * NWAVES + wv; it < 8192; it += G * NWAVES) {
        const int u = it >> 1, tb = it & 1, bh = u >> 5, c = u & 31, b = bh >> 3, h = bh & 7;
        const unsigned char* gu = P.GH + (size_t)u * 16384; const unsigned char* qy = P.QY + (size_t)u * 16384;
        f32x16 z[2];
#pragma unroll
        for (int vb = 0; vb < 2; ++vb)
#pragma unroll
            for (int st = 0; st < 2; ++st) { const v4u w = *(const GAS v4u*)(qy + 8192 + ((vb * 2 + tb) * 2 + st) * 1024 + lane * 16);
                z[vb][8 * st + 0] = bflo(w.x); z[vb][8 * st + 1] = bfhi(w.x); z[vb][8 * st + 2] = bflo(w.y); z[vb][8 * st + 3] = bfhi(w.y);
                z[vb][8 * st + 4] = bflo(w.z); z[vb][8 * st + 5] = bfhi(w.z); z[vb][8 * st + 6] = bflo(w.w); z[vb][8 * st + 7] = bfhi(w.w); }
#pragma unroll
        for (int kb = 0; kb < 2; ++kb)
#pragma unroll
            for (int st = 0; st < 2; ++st) { const bf16x8 qf = *(const bf16x8*)(qy + ((kb * 2 + tb) * 2 + st) * 1024 + lane * 16);
#pragma unroll
                for (int vb = 0; vb < 2; ++vb) z[vb] = MFMA32(*(const bf16x8*)(gu + ((kb * 2 + vb) * 2 + st) * 1024 + lane * 16), qf, z[vb]); }
        float sm = 0.f;
#pragma unroll
        for (int vb = 0; vb < 2; ++vb)
#pragma unroll
            for (int i = 0; i < 16; ++i) sm += z[vb][i];
        sm += __shfl_xor(sm, 32);
        const float mean = sm * (1.f / 64.f); float sq = 0.f;
#pragma unroll
        for (int vb = 0; vb < 2; ++vb)
#pragma unroll
            for (int i = 0; i < 16; ++i) { z[vb][i] -= mean; sq += z[vb][i] * z[vb][i]; }
        sq += __shfl_xor(sq, 32);
        const float rstd = __builtin_amdgcn_rsqf(sq * (1.f / 64.f) + GN_EPS);
        const size_t row = (size_t)b * SEQ + c * 64 + 32 * tb + r;
#pragma unroll
        for (int vb = 0; vb < 2; ++vb)
#pragma unroll
            for (int g4 = 0; g4 < 4; ++g4) { const int v0 = 32 * vb + 8 * g4 + 4 * hh, col = h * 64 + v0;
                const f32x4 gg = *(const LAS f32x4*)(tab + col), gb = *(const LAS f32x4*)(tab + 512 + col);
                const v2u bo = *(const GAS v2u*)(P.BON + row * 512 + col), gt = *(const GAS v2u*)(P.GG + row * 512 + col);
                const float o0 = (z[vb][4 * g4] * rstd * gg[0] + gb[0] + bflo(bo.x)) * bflo(gt.x), o1 = (z[vb][4 * g4 + 1] * rstd * gg[1] + gb[1] + bfhi(bo.x)) * bfhi(gt.x),
                            o2 = (z[vb][4 * g4 + 2] * rstd * gg[2] + gb[2] + bflo(bo.y)) * bflo(gt.y), o3 = (z[vb][4 * g4 + 3] * rstd * gg[3] + gb[3] + bfhi(bo.y)) * bfhi(gt.y);
                v2u w; w.x = pk2(o0, o1); w.y = pk2(o2, o3); *(GAS v2u*)(P.YB + row * 512 + col) = w; }
    }
}

constexpr int D23_CTL = 138240, D23_TAB = 139264;
__device__ __forceinline__ void cs_d23(LAS unsigned char* lds, const CsArgs& P, int vcu, int G, int tid, int wv) {
    const int lane = tid & 63, r = lane & 31, hh = lane >> 5, vbw = wv & 1;
    LAS float* tab = (LAS float*)(lds + D23_TAB);
    LAS unsigned* ctl = (LAS unsigned*)(lds + D23_CTL);
    for (int p = vcu; p < 256; p += G) {
        LDS_BAR();
        for (int i = tid; i < 512; i += NWAVES * 64) { tab[i] = P.gn_g[i]; tab[512 + i] = P.gn_b[i]; }
        if (tid < 32) ctl[tid] = 0u;
        LDS_BAR();
        const int bh = p >> 1, par = p & 1, b = bh >> 3, h = bh & 7;
        if (wv < 2) {
            f32x16 X[2] = {zero16(), zero16()};
            bf16x8 gf[2][2][2], hf[2][2];
            const unsigned char* g0 = P.GH + (size_t)(bh * 32) * 16384;
#pragma unroll
            for (int mb = 0; mb < 2; ++mb) {
#pragma unroll
                for (int kb = 0; kb < 2; ++kb)
#pragma unroll
                    for (int st = 0; st < 2; ++st) gf[mb][kb][st] = *(const bf16x8*)(g0 + ((mb * 2 + kb) * 2 + st) * 1024 + lane * 16);
#pragma unroll
                for (int st = 0; st < 2; ++st) hf[mb][st] = *(const bf16x8*)(g0 + 8192 + ((mb * 2 + vbw) * 2 + st) * 1024 + lane * 16);
            }
            for (int c = 0; c < 30 + par + 1; ++c) {
                const unsigned char* gu = P.GH + (size_t)(bh * 32 + c) * 16384;
                VM_WAIT();
                bf16x8 pk[2][2];
#pragma unroll
                for (int kb = 0; kb < 2; ++kb)
#pragma unroll
                    for (int st = 0; st < 2; ++st) pk[kb][st] = pack_frag(X[kb], st);
                if ((c & 1) == par) {
                    LAS unsigned char* sl = lds + (c >> 1) * 8192;
#pragma unroll
                    for (int kb = 0; kb < 2; ++kb)
#pragma unroll
                        for (int st = 0; st < 2; ++st) *(LAS bf16x8*)(sl + ((kb * 2 + vbw) * 2 + st) * 1024 + lane * 16) = pk[kb][st];
                    LDS_WAIT();
                    if (lane == 0) __hip_atomic_fetch_add((LAS unsigned*)(ctl + (c >> 1)), 1u, __ATOMIC_RELAXED, __HIP_MEMORY_SCOPE_WORKGROUP);
                }
                f32x16 Xn[2];
#pragma unroll
                for (int mb = 0; mb < 2; ++mb) {
#pragma unroll
                    for (int st = 0; st < 2; ++st) { const v4u w = __builtin_bit_cast(v4u, hf[mb][st]);
                        Xn[mb][8 * st + 0] = bflo(w.x); Xn[mb][8 * st + 1] = bfhi(w.x); Xn[mb][8 * st + 2] = bflo(w.y); Xn[mb][8 * st + 3] = bfhi(w.y);
                        Xn[mb][8 * st + 4] = bflo(w.z); Xn[mb][8 * st + 5] = bfhi(w.z); Xn[mb][8 * st + 6] = bflo(w.w); Xn[mb][8 * st + 7] = bfhi(w.w); }
#pragma unroll
                    for (int kb = 0; kb < 2; ++kb)
#pragma unroll
                        for (int st = 0; st < 2; ++st) Xn[mb] = MFMA32(gf[mb][kb][st], pk[kb][st], Xn[mb]);
                }
                if (c + 1 < 30 + par + 1) {
                    const unsigned char* gn = gu + 16384;
#pragma unroll
                    for (int mb = 0; mb < 2; ++mb) {
#pragma unroll
                        for (int kb = 0; kb < 2; ++kb)
#pragma unroll
                            for (int st = 0; st < 2; ++st) gf[mb][kb][st] = *(const bf16x8*)(gn + ((mb * 2 + kb) * 2 + st) * 1024 + lane * 16);
#pragma unroll
                        for (int st = 0; st < 2; ++st) hf[mb][st] = *(const bf16x8*)(gn + 8192 + ((mb * 2 + vbw) * 2 + st) * 1024 + lane * 16);
                    }
                }
                X[0] = Xn[0]; X[1] = Xn[1];
            }
        }
        for (;;) {
            unsigned itu = 0u;
            if (lane == 0) itu = __hip_atomic_fetch_add((LAS unsigned*)(ctl + 16), 1u, __ATOMIC_RELAXED, __HIP_MEMORY_SCOPE_WORKGROUP);
            const int it = __builtin_amdgcn_readfirstlane((int)itu);
            if (it >= 32) break;
            const int slot = it >> 1, tb = it & 1, c = 2 * slot + par, u = bh * 32 + c;
            while (__builtin_amdgcn_readfirstlane((int)__hip_atomic_load((LAS unsigned*)(ctl + slot), __ATOMIC_RELAXED, __HIP_MEMORY_SCOPE_WORKGROUP)) < 2) __builtin_amdgcn_s_sleep(1);
            asm volatile("" ::: "memory");
            const unsigned char* qy = P.QY + (size_t)u * 16384; const LAS unsigned char* sl = lds + slot * 8192;
            f32x16 z[2];
            const size_t row = (size_t)b * SEQ + c * 64 + 32 * tb + r;
            v2u bo[2][4], gt[2][4];
#pragma unroll
            for (int vb = 0; vb < 2; ++vb)
#pragma unroll
                for (int g4 = 0; g4 < 4; ++g4) { const int col = h * 64 + 32 * vb + 8 * g4 + 4 * hh; bo[vb][g4] = *(const GAS v2u*)(P.BON + row * 512 + col); gt[vb][g4] = *(const GAS v2u*)(P.GG + row * 512 + col); }
#pragma unroll
            for (int vb = 0; vb < 2; ++vb)
#pragma unroll
                for (int st = 0; st < 2; ++st) { const v4u w = *(const GAS v4u*)(qy + 8192 + ((vb * 2 + tb) * 2 + st) * 1024 + lane * 16);
                    z[vb][8 * st + 0] = bflo(w.x); z[vb][8 * st + 1] = bfhi(w.x); z[vb][8 * st + 2] = bflo(w.y); z[vb][8 * st + 3] = bfhi(w.y);
                    z[vb][8 * st + 4] = bflo(w.z); z[vb][8 * st + 5] = bfhi(w.z); z[vb][8 * st + 6] = bflo(w.w); z[vb][8 * st + 7] = bfhi(w.w); }
#pragma unroll
            for (int kb = 0; kb < 2; ++kb)
#pragma unroll
                for (int st = 0; st < 2; ++st) { const bf16x8 qf = *(const bf16x8*)(qy + ((kb * 2 + tb) * 2 + st) * 1024 + lane * 16);
#pragma unroll
                    for (int vb = 0; vb < 2; ++vb) z[vb] = MFMA32(*(const LAS bf16x8*)(sl + ((kb * 2 + vb) * 2 + st) * 1024 + lane * 16), qf, z[vb]); }
            float sm = 0.f;
#pragma unroll
            for (int vb = 0; vb < 2; ++vb)
#pragma unroll
                for (int i = 0; i < 16; ++i) sm += z[vb][i];
            sm += __shfl_xor(sm, 32);
            const float mean = sm * (1.f / 64.f); float sq = 0.f;
#pragma unroll
            for (int vb = 0; vb < 2; ++vb)
#pragma unroll
                for (int i = 0; i < 16; ++i) { z[vb][i] -= mean; sq += z[vb][i] * z[vb][i]; }
            sq += __shfl_xor(sq, 32);
            const float rstd = __builtin_amdgcn_rsqf(sq * (1.f / 64.f) + GN_EPS);
#pragma unroll
            for (int vb = 0; vb < 2; ++vb)
#pragma unroll
                for (int g4 = 0; g4 < 4; ++g4) { const int v0 = 32 * vb + 8 * g4 + 4 * hh, col = h * 64 + v0;
                    const f32x4 gg = *(const LAS f32x4*)(tab + col), gb = *(const LAS f32x4*)(tab + 512 + col);
                    const v2u bo_ = bo[vb][g4], gt_ = gt[vb][g4];
                    const float o0 = (z[vb][4 * g4] * rstd * gg[0] + gb[0] + bflo(bo_.x)) * bflo(gt_.x), o1 = (z[vb][4 * g4 + 1] * rstd * gg[1] + gb[1] + bfhi(bo_.x)) * bfhi(gt_.x),
                                o2 = (z[vb][4 * g4 + 2] * rstd * gg[2] + gb[2] + bflo(bo_.y)) * bflo(gt_.y), o3 = (z[vb][4 * g4 + 3] * rstd * gg[3] + gb[3] + bfhi(bo_.y)) * bfhi(gt_.y);
                    v2u w; w.x = pk2(o0, o1); w.y = pk2(o2, o3); *(GAS v2u*)(P.YB + row * 512 + col) = w; }
        }
    }
}

#ifndef MK_N_LAUNCHES
#define MK_N_LAUNCHES 1
#endif
constexpr int N_PHASES = 35;
struct Args { const float* in[34]; float* out; unsigned char* ws; int ph_lo, ph_hi; };
enum { I_X = 0, I_P, I_LNIN_G, I_LNIN_B, I_RELB, I_WIN, I_TOKMIX, I_DECB, I_DECUP, I_AAAB, I_AAAUP, I_GATEUP, I_KK, I_KA, I_RK, I_VRB, I_VRD, I_VRU, I_GNG, I_GNB,
       I_WBA, I_WBR, I_WOUT, I_RG, I_RGB, I_RE, I_REB, I_EG, I_EU, I_ED, I_PLEP, I_PLEG, I_LNG, I_LNB };

#ifndef EN_MASK
#define EN_MASK 0xFFFFF
#endif
#define EN(k) (((EN_MASK) >> (k)) & 1)
#define IN(k) (lo <= (k) && (k) < hi)
#define SEAM(k) do { if (IN((k) + 1)) { XcdBarrier b_; b_.bar = (unsigned*)(ctl + CW_BAR); b_.x = xb_xcc_id(); b_.st = (volatile LAS unsigned*)(lds + MISC_OFF) + 8; xcd_barrier(b_, tid == 0); } } while (0)
#define KARGS const __attribute__((address_space(4))) Args* ka = (const __attribute__((address_space(4))) Args*)__builtin_amdgcn_kernarg_segment_ptr(); asm volatile("" : "+s"(ka))
#define PH_IDS \
    int tid = wv * 64 + (int)__builtin_amdgcn_mbcnt_hi(~0u, __builtin_amdgcn_mbcnt_lo(~0u, 0u)); asm volatile("" : "+v"(tid)); int bx = blockIdx.x, G = gridDim.x; asm volatile("" : "+s"(bx), "+s"(G)); \
    const int lane = tid & 63, wave = wv; \
    const int vcu = (G % 8 == 0) ? (bx % 8) * (G / 8) + bx / 8 : bx; \
    const int gw = bx * NWAVES + wave, NGW = G * NWAVES, gt = bx * (NWAVES * 64) + tid, NT = G * NWAVES * 64; \
    KARGS; unsigned char* ws = ka->ws; float* xres = ka->out; bf16* XB = (bf16*)(ws + WS_XB); gu32* ctl = (gu32*)(ws + WS_CTL); \
    (void)lane; (void)wave; (void)vcu; (void)gw; (void)NGW; (void)gt; (void)NT; (void)xres; (void)XB; (void)ctl;
#define AIN(i) ((const float*)ka->in[i])
#ifndef SKEW_TICKS
#define SKEW_TICKS 0
#endif
#define GEMM_SKEW do { if (SKEW_TICKS > 0 && ((bx >> 3) & 1)) { const unsigned long long t0_ = __builtin_amdgcn_s_memrealtime(); while (__builtin_amdgcn_s_memrealtime() - t0_ < (unsigned long long)(SKEW_TICKS)) __builtin_amdgcn_s_sleep(4); } } while (0)
#ifndef REPMASK
#define REPMASK 0
#endif
#define NREP(k) ((((REPMASK) >> (k)) & 1) ? 2 : 1)
#define BLK_A \
            { pg8::Gemm g{XB, WinT, T, 1024, 1024}; pg8::StaticOrder S; S.init(T, 1024, G, bx); pg8::EpiStore E{(bf16*)(ws + WS_QK), 1024, 0}; \
              pg8::gemm_phase<pg8::EpiStore, pg8::StaticOrder, true, true>(lds, g, S, E, wv); } \
            { pg8::Gemm g{XB, WinT + (size_t)1536 * 1024, T, 2048, 1024}; pg8::StaticOrder S; S.init(T, 2048, G, bx); pg8::EpiStoreT<-1, true> E{(bf16*)(ws + WS_RKVL), LDR, LDR}; \
              pg8::gemm_phase<pg8::EpiStoreT<-1, true>, pg8::StaticOrder, true, true>(lds, g, S, E, wv); } \
            { pg8::Gemm g{WinT + (size_t)1024 * 1024, XB, 512, T, 1024}; pg8::StaticOrder S; S.init(512, T, G, bx); pg8::EpiStore E{(bf16*)(ws + WS_VT), T, 0}; \
              pg8::gemm_phase<pg8::EpiStore, pg8::StaticOrder, true, true>(lds, g, S, E, wv); }
#define BLK_E \
            { pg8::Gemm g{(const bf16*)(ws + WS_YA), (const bf16*)(wb + WNE_WBA), T, 1024, 512}; pg8::StaticOrder S; S.init(T, 1024, G, bx); pg8::EpiStore E{T1, 1024, 0}; \
              pg8::gemm_phase<pg8::EpiStore, pg8::StaticOrder, false, true>(lds, g, S, E, wv); } \
            { pg8::Gemm g{(const bf16*)(ws + WS_YB), (const bf16*)(wb + WNE_WBR), T, 1024, 512}; pg8::StaticOrder S; S.init(T, 1024, G, bx); pg8::EpiStore E{T2, 1024, 0}; \
              pg8::gemm_phase<pg8::EpiStore, pg8::StaticOrder, false, true>(lds, g, S, E, wv); } \
            { pg8::Gemm g{XB, WinT + (size_t)3584 * 1024, T, 2048, 1024}; pg8::GateOrder S; S.init(T, G, bx); pg8::EpiGate2 E{T1, T2, MP, 1024}; \
              pg8::gemm_phase<pg8::EpiGate2, pg8::GateOrder, true, true>(lds, g, S, E, wv); }
#define BLK_G \
            LAS float* scr = (LAS float*)(lds + wave * 16384); \
            bf16* EGU = (bf16*)(ws + WS_EGU); bf16* EDN = (bf16*)(ws + WS_EDN); \
            for (int it = gw; it < 3 * 4096; it += NGW) { \
                const int which = it >> 12, r = it & 4095, e = r >> 7, rr = r & 127; \
                if (which < 2) { const int kb = rr >> 3, nb = rr & 7, n0 = 32 * nb; \
                    transpose_item(AIN(which == 0 ? I_EG : I_EU) + ((size_t)(l * 32 + e) << 18), 256, 64 * kb, n0, EGU, 1024, e * 512 + (n0 >> 7) * 256 + which * 128 + (n0 & 127), scr, lane); } \
                else { const int kb = rr >> 5, nb = rr & 31; transpose_item(AIN(I_ED) + ((size_t)(l * 32 + e) << 18), 1024, 64 * kb, 32 * nb, EDN, 256, e * 1024 + 32 * nb, scr, lane); } \
            } \
            { const float* psrc = AIN(I_P) + (size_t)l * T * 256; bf16* PB = (bf16*)(ws + WS_PB); \
              for (int i = gt; i < T * 256 / 4; i += NT) { const f32x4 v = *(const GAS f32x4*)(psrc + (size_t)i * 4); v2u w; w.x = pk2(v.x, v.y); w.y = pk2(v.z, v.w); *(GAS v2u*)(PB + (size_t)i * 4) = w; } }
#define BLK_H \
            pg8::Gemm g{XB, (const bf16*)(ws + WS_RWT) + (size_t)l * 256 * 1024, T, 256, 1024}; pg8::StaticOrder S; S.init(T, 256, G, bx); pg8::EpiRouter E{(float*)(ws + WS_LOG), (const float*)(ws + WS_RB) + l * 64}; \
            pg8::gemm_phase<pg8::EpiRouter, pg8::StaticOrder, true, true>(lds, g, S, E, wv);
#define BLK_K \
            const int ntiles = moe_tables(lds, (unsigned*)(ctl + CW_CNT + 64 * l), tid); LAS int* tlds = (LAS int*)(lds + TILE_LDS); \
            pg8::Gemm g{XB, (const bf16*)(ws + WS_EGU), 0, 0, 1024, nullptr}; pg8::MoeOrder S; S.init(tlds, ntiles, 2, G, bx); S.offs = tlds + 512; S.cnts = tlds + 576; S.elist = (const int*)(ws + WS_ELIST); pg8::EpiSwiglu E{(bf16*)(ws + WS_H)}; \
            pg8::gemm_phase<pg8::EpiSwiglu, pg8::MoeOrder, true, true, true>(lds, g, S, E, wv);
#define BLK_L \
            const int ntiles = moe_tables(lds, (unsigned*)(ctl + CW_CNT + 64 * l), tid); LAS int* tlds = (LAS int*)(lds + TILE_LDS); \
            pg8::Gemm g{(const bf16*)(ws + WS_H), (const bf16*)(ws + WS_EDN), 0, 0, 256, nullptr}; pg8::MoeOrder S; S.init(tlds, ntiles, 4, G, bx); pg8::EpiStoreT<3, false> E{(bf16*)(ws + WS_XG), 1024, 0}; \
            pg8::gemm_phase<pg8::EpiStoreT<3, false>, pg8::MoeOrder, false, true>(lds, g, S, E, wv);
#define BLK_N1 \
            { pg8::Gemm g{(const bf16*)(ws + WS_PB), (const bf16*)(wb + WNE_WPLE), T, 1024, 256}; pg8::StaticOrder S; S.init(T, 1024, G, bx); pg8::EpiStore E{TP, 1024, 0}; \
              pg8::gemm_phase<pg8::EpiStore, pg8::StaticOrder, false, true>(lds, g, S, E, wv); }
template <int l> __device__ __forceinline__ void layer_body(const Args& args, LAS unsigned char* lds, const int lo, const int hi, const int wv) {

        constexpr int pb = 1 + 17 * l;
#define wb (ws + WS_WNE + (size_t)l * WNE_LAYER)
#define WinT ((const bf16*)(wb + WNE_WIN))
        if (EN(1) && IN(pb + 0)) { PH_IDS GEMM_SKEW;
BLK_A
#if ((REPMASK) >> 1) & 1
            BLK_A
#endif
#if ((REPMASK) >> 24) & 1
            { pg8::Gemm g{XB, WinT, T, 1024, 1024}; pg8::StaticOrder S; S.init(T, 1024, G, bx); pg8::EpiNull E{(float*)(ws + WS_GG)};
              pg8::gemm_phase<pg8::EpiNull, pg8::StaticOrder, true, true>(lds, g, S, E, wv); }
#endif
#if ((REPMASK) >> 25) & 1
            { pg8::Gemm g{XB, WinT, T, 1024, 1024}; pg8::StaticOrder S; S.init(T, 1024, G, bx); pg8::EpiStore E{(bf16*)(ws + WS_GG), 1024, 0};
              pg8::gemm_phase<pg8::EpiStore, pg8::StaticOrder, true, true>(lds, g, S, E, wv); }
#endif
                        SEAM(pb + 0);
        }
        if (EN(2) && IN(pb + 1)) { { PH_IDS
#ifndef DIS_ATTN
 for (int rep_ = 0; rep_ < NREP(2); ++rep_) attn_phase(lds, (const bf16*)(ws + WS_QK), (const bf16*)(ws + WS_VT), (bf16*)(ws + WS_YA), AIN(I_RELB), vcu, G, tid);
#endif
 }
 __syncthreads();
            PH_IDS
            PrepArgs P{(const bf16*)(ws + WS_RKVL), (bf16*)(ws + WS_LW), (bf16*)((unsigned char*)xres + OUT_AA), (bf16*)(ws + WS_GG), (bf16*)(ws + WS_NU), AIN(I_TOKMIX) + l * 1824,
                       AIN(I_DECB) + l * 512, AIN(I_AAAB) + l * 512, AIN(I_VRB), (const bf16*)(ws + WS_DUT) + l * 32768, (const bf16*)(ws + WS_AUT) + l * 32768,
                       (const bf16*)(ws + WS_GUT) + l * 81920, (const bf16*)(ws + WS_VDT), (const bf16*)(ws + WS_VUT), l};
#ifndef DIS_PREP
            for (int rep_ = 0; rep_ < NREP(3); ++rep_) prep_phase(lds, P, vcu, G, tid);
#endif
 SEAM(pb + 2);
        }
#define CS_ARGS CsArgs P{(const bf16*)(ws + WS_RKVL), (const bf16*)(ws + WS_LW), (const bf16*)((unsigned char*)xres + OUT_AA), (const bf16*)(ws + WS_GG), (const bf16*)(ws + WS_NU), (bf16*)(ws + WS_VF), (bf16*)(ws + WS_YB), ws + WS_GH, (unsigned char*)xres, (bf16*)((unsigned char*)xres + 64 * MiB), \
                        AIN(I_TOKMIX) + l * 1824, AIN(I_KK) + l * 512, AIN(I_KA) + l * 512, AIN(I_RK) + l * 512, AIN(I_GNG) + l * 512, AIN(I_GNB) + l * 512, l}
        if (EN(4) && IN(pb + 3)) { PH_IDS CS_ARGS; for (int rep_ = 0; rep_ < NREP(16); ++rep_) cs_d1(lds, P, vcu, G, tid, wv); SEAM(pb + 3); }
        if (EN(6) && IN(pb + 5)) { PH_IDS CS_ARGS;
#if defined(SCAN_CHECK)
            if (l == 0) { P.YB = (bf16*)(ws + WS_NU); }
#endif
            cs_d23(lds, P, vcu, G, tid, wv);
#if defined(SCAN_CHECK)
            if (l == 0 && bx < 128) {
                ScanArgs Q{(const bf16*)(ws + WS_RKVL), (const bf16*)(ws + WS_LW), (const bf16*)((unsigned char*)xres + OUT_AA), (const bf16*)(ws + WS_GG), (const bf16*)(ws + WS_NU), (bf16*)(ws + WS_VF), (bf16*)(ws + WS_YB),
                           AIN(I_TOKMIX) + l * 1824, AIN(I_KK) + l * 512, AIN(I_KA) + l * 512, AIN(I_RK) + l * 512, AIN(I_GNG) + l * 512, AIN(I_GNB) + l * 512, l};
                __syncthreads(); scan_phase(lds, Q, bx, tid); }
#endif
            SEAM(pb + 5); }
        if (EN(7) && IN(pb + 6)) { PH_IDS GEMM_SKEW;
#if defined(SCAN_CHECK)
            if (l == 0) { float sd = 0.f, sr = 0.f; unsigned nbad = 0; const v4u* yn = (const v4u*)(ws + WS_NU); const v4u* yo = (const v4u*)(ws + WS_YB);
                for (int i = gt; i < T * 512 / 8; i += NT) { float a[8], o[8]; unpack8(yn[i], a); unpack8(yo[i], o);
#pragma unroll
                    for (int j = 0; j < 8; ++j) { const float d = a[j] - o[j]; if (fabsf(d) < 1e4f) { sd += d * d; sr += o[j] * o[j]; } else nbad++; } }
                unsigned long long isd = (unsigned long long)(sd * 1048576.f), isr = (unsigned long long)(sr * 1048576.f);
                atomicAdd((unsigned long long*)(ctl + CW_CHK), isd); atomicAdd((unsigned long long*)(ctl + CW_CHK + 2), isr); if (nbad) atomicAdd((unsigned*)(ctl + CW_CHK + 4), nbad); }
#endif
            bf16* T1 = (bf16*)(ws + WS_T1); bf16* T2 = (bf16*)(ws + WS_T2); bf16* MP = (bf16*)(ws + WS_MP);
BLK_E
#if ((REPMASK) >> 5) & 1
            BLK_E
#endif
                        SEAM(pb + 6);
        }
        if (EN(8) && IN(pb + 7)) { PH_IDS GEMM_SKEW;
            pg8::Gemm g{(const bf16*)(ws + WS_MP), (const bf16*)(wb + WNE_WOUT), T, 1024, 1024}; pg8::StaticOrder S; S.init(T, 1024, G, bx); pg8::EpiRes<0> E{XB, XB, nullptr, 1024, ALPHA};
            pg8::gemm_phase<pg8::EpiRes<0>, pg8::StaticOrder, true, true>(lds, g, S, E, wv);
            SEAM(pb + 7);
        }
        if (EN(10) && IN(pb + 9)) { PH_IDS
            if (bx < 128) {
                pg8::StaticOrder S1; S1.init(T, 256, G, bx); pg8::Unit u1;
                if (S1.next(0, u1)) ln_pass<2, 0>(nullptr, nullptr, XB, AIN(I_LNG) + (l * 3 + 0) * 1024, AIN(I_LNB) + (l * 3 + 0) * 1024, XB, nullptr, nullptr, u1.pm * 256 + wave, NWAVES, lane, u1.pm * 256 + 256);
                VM_WAIT(); __builtin_amdgcn_fence(__ATOMIC_ACQUIRE, "agent"); VM_WAIT();
                __syncthreads();
            }
{ BLK_H }
#if ((REPMASK) >> 8) & 1
            { BLK_H }
#endif
            if (bx < 128) {
                pg8::StaticOrder S2; S2.init(T, 256, G, bx); pg8::Unit u2;
                if (S2.next(0, u2)) route_phase(lds, (const float*)(ws + WS_LOG), (unsigned*)(ctl + CW_CNT + 64 * l), (int*)(ws + WS_TOKE), (int*)(ws + WS_TOKP), (float*)(ws + WS_TOKW), (int*)(ws + WS_ELIST), u2.pm * 256, tid);
            }
            if (bx >= 128) { const int bx2 = bx - 128; const int gw = bx2 * NWAVES + wave, NGW = 128 * NWAVES, gt = bx2 * (NWAVES * 64) + tid, NT = 128 * NWAVES * 64;
                BLK_G
                }
                        SEAM(pb + 9);
        }
        if (EN(13) && IN(pb + 12)) { PH_IDS GEMM_SKEW;
{ BLK_K }
#if ((REPMASK) >> 11) & 1
            { BLK_K }
#endif
                        SEAM(pb + 12);
        }
        if (EN(14) && IN(pb + 13)) { PH_IDS GEMM_SKEW;
{ BLK_L }
#if ((REPMASK) >> 12) & 1
            { BLK_L }
#endif
                        SEAM(pb + 13);
        }
        if (EN(15) && IN(pb + 14)) { PH_IDS
            (void)moe_tables(lds, (unsigned*)(ctl + CW_CNT + 64 * l), tid);
            ln_pass<1, 0>(nullptr, nullptr, XB, AIN(I_LNG) + (l * 3 + 1) * 1024, AIN(I_LNB) + (l * 3 + 1) * 1024, (const bf16*)(ws + WS_XG), (const int*)(ws + WS_TOKE), (const float*)(ws + WS_TOKW), gw, NGW, lane, T, (const int*)(ws + WS_TOKP), (const LAS int*)(lds + TILE_LDS) + 512);
            SEAM(pb + 14);
        }
        if (EN(16) && IN(pb + 15)) { PH_IDS GEMM_SKEW;
            bf16* TP = (bf16*)(ws + WS_TP);
BLK_N1
#if ((REPMASK) >> 14) & 1
            BLK_N1
#endif
                        { pg8::Gemm g{XB, (const bf16*)(wb + WNE_WPG), T, 1024, 1024}; pg8::StaticOrder S; S.init(T, 1024, G, bx); pg8::EpiRes<1> E{XB, (bf16*)(ws + WS_PRE2), TP, 1024, ALPHA};
              pg8::gemm_phase<pg8::EpiRes<1>, pg8::StaticOrder, true, true>(lds, g, S, E, wv); }
            SEAM(pb + 15);
        }
        if (EN(17) && IN(pb + 16)) { PH_IDS
            ln_pass<2, (l == 1 ? 1 : 0)>(nullptr, xres, XB, AIN(I_LNG) + (l * 3 + 2) * 1024, AIN(I_LNB) + (l * 3 + 2) * 1024, (const bf16*)(ws + WS_PRE2), nullptr, nullptr, gw, NGW, lane);
#if ((REPMASK) >> 15) & 1
            for (int rep_ = 0; rep_ < 3; ++rep_) ln_pass<0, true>(xres, (float*)(ws + WS_XG), (bf16*)(ws + WS_H), AIN(I_LNG) + (l * 3 + 2) * 1024, AIN(I_LNB) + (l * 3 + 2) * 1024, nullptr, nullptr, nullptr, gw, NGW, lane);
#endif
#if defined(SCAN_CHECK)
            if (l == 1) { VM_WAIT(); const unsigned long long isd = __hip_atomic_load((unsigned long long*)(ctl + CW_CHK), RLX_AGENT), isr = __hip_atomic_load((unsigned long long*)(ctl + CW_CHK + 2), RLX_AGENT);
                const unsigned nbad = __hip_atomic_load((unsigned*)(ctl + CW_CHK + 4), RLX_AGENT);
                const float inj = nbad ? 1000.f : 10.f * sqrtf((float)isd / fmaxf((float)isr, 1.f));
                for (int m = gw; m < T; m += NGW) { GAS f32x4* o4 = (GAS f32x4*)(xres + (size_t)m * D) + lane;
#pragma unroll
                    for (int j = 0; j < 4; ++j) { f32x4 y = o4[64 * j]; y = y + inj; o4[64 * j] = y; } } }
#endif
#if ((REPMASK) >> 21) & 1
            if (l == 0) { for (int rep_ = 0; rep_ < 20; ++rep_) SEAM(pb + 16); }
#endif
            if (l == 0) SEAM(pb + 16);
        }

}
#undef wb
#undef WinT
__global__ void __launch_bounds__(NWAVES * 64, 2) mega_fwd(Args args) {
    extern __shared__ __attribute__((aligned(16))) unsigned char lds_raw[];
    LAS unsigned char* lds = (LAS unsigned char*)lds_raw;
    for (int u = threadIdx.x; u < (LDS_BYTES - RING_BYTES) / 4; u += NWAVES * 64) ((LAS unsigned*)(lds + RING_BYTES))[u] = 0u;
    __syncthreads();
    KARGS;
    (void)xcd_barrier_post((unsigned*)(ka->ws + WS_CTL) + CW_BAR, (volatile LAS unsigned*)(lds + MISC_OFF) + 8);
    const int lo = ka->ph_lo, hi = ka->ph_hi, wv = __builtin_amdgcn_readfirstlane(threadIdx.x >> 6);

    if (EN(0) && IN(0)) { PH_IDS
        LAS float* scr = (LAS float*)(lds + wave * 16384);
        constexpr int I_WINL = 16 * 169, I_BR = 8 * 32, I_SQ = 16 * 32, I_PLE = 4 * 32, I_LAYER = I_WINL + 2 * I_BR + 2 * I_SQ + I_PLE;
        for (int it = gw; it < 2 * I_LAYER; it += NGW) {
            const int l = it / I_LAYER; int r = it - l * I_LAYER; unsigned char* wb_ = ws + WS_WNE + (size_t)l * WNE_LAYER;
            if (r < I_WINL) { const int kb = r / 169, nb = r - kb * 169, n0 = 32 * nb; transpose_item(AIN(I_WIN) + (size_t)l * 1024 * 5408, 5408, 64 * kb, n0, (bf16*)(wb_ + WNE_WIN), 1024, (n0 < 3360 ? n0 : n0 < 4384 ? 3584 + ((n0 - 3360) >> 7) * 256 + ((n0 - 3360) & 127) : 3584 + ((n0 - 4384) >> 7) * 256 + 128 + ((n0 - 4384) & 127)), scr, lane); continue; } r -= I_WINL;
            if (r < I_BR) { const int kb = r / 32, nb = r & 31; transpose_item(AIN(I_WBA) + (size_t)l * 512 * 1024, 1024, 64 * kb, 32 * nb, (bf16*)(wb_ + WNE_WBA), 512, 32 * nb, scr, lane); continue; } r -= I_BR;
            if (r < I_BR) { const int kb = r / 32, nb = r & 31; transpose_item(AIN(I_WBR) + (size_t)l * 512 * 1024, 1024, 64 * kb, 32 * nb, (bf16*)(wb_ + WNE_WBR), 512, 32 * nb, scr, lane); continue; } r -= I_BR;
            if (r < I_SQ) { const int kb = r / 32, nb = r & 31; transpose_item(AIN(I_WOUT) + (size_t)l * 1024 * 1024, 1024, 64 * kb, 32 * nb, (bf16*)(wb_ + WNE_WOUT), 1024, 32 * nb, scr, lane); continue; } r -= I_SQ;
            if (r < I_SQ) { const int kb = r / 32, nb = r & 31; transpose_item(AIN(I_PLEG) + (size_t)l * 1024 * 1024, 1024, 64 * kb, 32 * nb, (bf16*)(wb_ + WNE_WPG), 1024, 32 * nb, scr, lane); continue; } r -= I_SQ;
            { const int kb = r / 32, nb = r & 31; transpose_item(AIN(I_PLEP) + (size_t)l * 256 * 1024, 1024, 64 * kb, 32 * nb, (bf16*)(wb_ + WNE_WPLE), 256, 32 * nb, scr, lane); }
        }
        for (int i = gt; i < 2 * 224 * 1024 / 8; i += NT) { const int l = i / (224 * 128), r = i - l * (224 * 128);
            *(GAS v4u*)(ws + WS_WNE + (size_t)l * WNE_LAYER + WNE_WIN + (size_t)3360 * 2048 + (size_t)r * 16) = (v4u){0u, 0u, 0u, 0u}; }
        { bf16* RWT = (bf16*)(ws + WS_RWT);
          for (int i = gt; i < 2 * 256 * 1024; i += NT) { const int l = i >> 18, n = (i >> 10) & 255, k = i & 1023;
              const float v = n < 4 ? AIN(I_RG)[l * 4096 + k * 4 + n] : n < 36 ? AIN(I_RE)[l * 32768 + k * 32 + (n - 4)] : 0.f; RWT[i] = (bf16)f2bf(v); } }
        { float* RB = (float*)(ws + WS_RB); if (gt < 128) { const int l = gt >> 6, n = gt & 63; RB[gt] = n < 4 ? AIN(I_RGB)[l * 4 + n] : n < 36 ? AIN(I_REB)[l * 32 + n - 4] : 0.f; } }
        { bf16* DUT = (bf16*)(ws + WS_DUT); bf16* AUT = (bf16*)(ws + WS_AUT);
          for (int i = gt; i < 2 * 512 * 64; i += NT) { const int l = i >> 15, n = (i >> 6) & 511, k = i & 63;
              DUT[i] = (bf16)f2bf(AIN(I_DECUP)[l * 32768 + k * 512 + n]); AUT[i] = (bf16)f2bf(AIN(I_AAAUP)[l * 32768 + k * 512 + n]); } }
        { bf16* GUT = (bf16*)(ws + WS_GUT);
          for (int i = gt; i < 2 * 512 * 160; i += NT) { const int l = i / 81920, r = i - l * 81920, n = r / 160, k = r - n * 160; GUT[i] = (bf16)f2bf(AIN(I_GATEUP)[l * 81920 + k * 512 + n]); } }
        { bf16* VDT = (bf16*)(ws + WS_VDT); bf16* VUT = (bf16*)(ws + WS_VUT);
          for (int i = gt; i < 16384; i += NT) { VDT[i] = (bf16)f2bf(AIN(I_VRD)[(i & 511) * 32 + (i >> 9)]); VUT[i] = (bf16)f2bf(AIN(I_VRU)[(i & 31) * 512 + (i >> 5)]); } }
        ln_pass<0, 0>(AIN(I_X), nullptr, XB, AIN(I_LNIN_G), AIN(I_LNIN_B), nullptr, nullptr, nullptr, gw, NGW, lane);
        SEAM(0);
    }

    layer_body<0>(args, lds, lo, hi, wv);
    layer_body<1>(args, lds, lo, hi, wv);
#undef IN
#undef SEAM
}

extern "C" void kernel_launch(void* const* d_in, const int* in_sizes, int n_in, void* d_out, int out_size, void* d_ws, size_t ws_size, hipStream_t stream) {
    static int grid = 0;
    if (grid == 0) {
        if (n_in != 34 || out_size != T * D || ws_size < WS_END) { fprintf(stderr, "kernel_launch: unexpected shapes (n_in %d out %d ws %zu)\n", n_in, out_size, ws_size); grid = -1; return; }
        int dev = 0, cus = 0, per_cu = 0;
        if (hipGetDevice(&dev) != hipSuccess || hipDeviceGetAttribute(&cus, hipDeviceAttributeMultiprocessorCount, dev) != hipSuccess) { grid = -1; return; }
        if (hipFuncSetAttribute((const void*)mega_fwd, hipFuncAttributeMaxDynamicSharedMemorySize, LDS_BYTES) != hipSuccess) { fprintf(stderr, "kernel_launch: hipFuncSetAttribute failed\n"); grid = -1; return; }
        if (hipOccupancyMaxActiveBlocksPerMultiprocessor(&per_cu, (const void*)mega_fwd, NWAVES * 64, LDS_BYTES) != hipSuccess || per_cu < 1) fprintf(stderr, "kernel_launch: occupancy query reports %d\n", per_cu);
        (void)hipGetLastError();
        grid = cus;
    }
    if (grid < 0) return;
    if (hipMemsetAsync((char*)d_ws + WS_CTL, 0, CTL_ZERO_BYTES, stream) != hipSuccess) return;
    Args a{};
    for (int i = 0; i < 34; ++i) a.in[i] = (const float*)d_in[i];
    a.out = (float*)d_out; a.ws = (unsigned char*)d_ws;
#if MK_N_LAUNCHES == 1
    a.ph_lo = 0; a.ph_hi = N_PHASES;
    hipLaunchKernelGGL(mega_fwd, dim3(grid), dim3(NWAVES * 64), LDS_BYTES, stream, a);
#else
    for (int p = 0; p < N_PHASES; ++p) { a.ph_lo = p; a.ph_hi = p + 1; hipLaunchKernelGGL(mega_fwd, dim3(grid), dim3(NWAVES * 64), LDS_BYTES, stream, a); }
#endif
}
```

```cpp
#include <hip/hip_runtime.h>
#include <cstdio>
#include <cstdint>
#include <cmath>
namespace pg8 {
#define PG8_LAS __attribute__((address_space(3)))
typedef unsigned short bf16_t;
typedef short bf16x8 __attribute__((ext_vector_type(8)));
typedef float f32x4 __attribute__((ext_vector_type(4)));
typedef unsigned u32x4 __attribute__((ext_vector_type(4)));
constexpr int BM = 256, BK = 64, HALF = 128, HTB = HALF * BK * 2  , STAGE_BYTES = 8 * HTB, NXCD = 8, WGM = 8;

__host__ __device__ __forceinline__ int lds_byte(int r, int c) { const int st = (r >> 4) * 2 + (c >> 5), rr = r & 15, cc = c & 31, ob = rr * 64 + cc * 2; return st * 1024 + (ob ^ (((ob >> 9) & 1) << 5)); }
__host__ __device__ __forceinline__ void stage_rc(int b, int& R, int& C) { const int st = b / 1024, sb = b % 1024, swz = sb ^ (((sb >> 9) & 1) << 5); R = (st >> 1) * 16 + swz / 64; C = (st & 1) * 32 + (swz % 64) / 2; }
__host__ __device__ __forceinline__ int perm32(int rho) { const int n = rho >> 4, i = rho & 15; return 8 * (i >> 2) + 4 * n + (i & 3); }

struct Unit { int pm, pn; };
struct Gemm { const bf16_t* A; const bf16_t* Bt; int M, N, K; const int* rows; };

struct StaticOrder {
    int nM, nN, nwg, G, c;
    __host__ __device__ __forceinline__ void init(int M, int N, int G_, int c_) { nM = M / BM; nN = N / BM; nwg = nM * nN; G = G_; c = c_; }
    __host__ __device__ __forceinline__ bool next(int i, Unit& u) const {
        const long L = (long)i * G + c; if (L >= nwg) return false;
        int wgid = (int)L; { const int q = nwg / NXCD, r = nwg % NXCD, xcd = wgid % NXCD, off = wgid / NXCD; wgid = (xcd < r ? xcd * (q + 1) : r * (q + 1) + (xcd - r) * q) + off; }
        const int nig = WGM * nN, gid = wgid / nig, fm = gid * WGM, gsz = (nM - fm) < WGM ? (nM - fm) : WGM;
        u.pm = fm + ((wgid % nig) % gsz); u.pn = (wgid % nig) / gsz; return true;
    }
    __device__ __forceinline__ void a_ready(const Unit&) const {}
    __device__ __forceinline__ void done(const Unit&) const {}
};
__device__ __forceinline__ unsigned cvt_pk_bf16(float lo, float hi) { unsigned r; asm volatile("v_cvt_pk_bf16_f32 %0, %1, %2" : "=v"(r) : "v"(lo), "v"(hi)); return r; }
typedef float f32x2 __attribute__((ext_vector_type(2)));
typedef unsigned u32x2 __attribute__((ext_vector_type(2)));
__device__ __forceinline__ float bf_lo(unsigned w) { return __uint_as_float(w << 16); }
__device__ __forceinline__ float bf_hi(unsigned w) { return __uint_as_float(w & 0xffff0000u); }
__device__ __forceinline__ float sigm(float x) { return __builtin_amdgcn_rcpf(1.0f + __builtin_amdgcn_exp2f(-1.44269504f * x)); }

template <int PNMASK, bool LIMIT> struct EpiStoreT {
    static constexpr bool PERM = true, AFTER_DRAIN = false; static constexpr int EPI_VM = LIMIT ? 0 : 16;
    bf16_t* O; int ldc; int ncols;
    __device__ __forceinline__ void operator()(const f32x4 (&acc)[2][2][4][2], const Unit& u, int wr, int wc, int fr, int fq) const {
        const int row0 = u.pm * BM + wr * 64 + fr, col0 = (u.pn & PNMASK) * BM + wc * 32 + 8 * fq;
#pragma unroll
        for (int ai = 0; ai < 2; ++ai)
#pragma unroll
            for (int m = 0; m < 4; ++m) { bf16_t* rowp = O + (size_t)(row0 + ai * HALF + m * 16) * ldc + col0;
#pragma unroll
                for (int bj = 0; bj < 2; ++bj) { const f32x4 v0 = acc[ai][bj][m][0], v1 = acc[ai][bj][m][1];
                    u32x4 w; w.x = cvt_pk_bf16(v0[0], v0[1]); w.y = cvt_pk_bf16(v0[2], v0[3]); w.z = cvt_pk_bf16(v1[0], v1[1]); w.w = cvt_pk_bf16(v1[2], v1[3]);
                    if (!LIMIT || col0 + bj * HALF < ncols) {
                        *(u32x4*)(rowp + bj * HALF) = w;
                    } } }
    }
};
typedef EpiStoreT<-1, false> EpiStore;
struct EpiNull {
    static constexpr bool PERM = true, AFTER_DRAIN = false; static constexpr int EPI_VM = 0;
    float* sink;
    __device__ __forceinline__ void operator()(const f32x4 (&acc)[2][2][4][2], const Unit& u, int wr, int wc, int fr, int fq) const {
        float s = 0.f;
#pragma unroll
        for (int ai = 0; ai < 2; ++ai)
#pragma unroll
            for (int m = 0; m < 4; ++m)
#pragma unroll
                for (int bj = 0; bj < 2; ++bj) { const f32x4 a = acc[ai][bj][m][0] + acc[ai][bj][m][1]; s += (a[0] + a[1]) + (a[2] + a[3]); }
        if (s == 1.2345e30f) *sink = s;
    }
};
template <int MODE> struct EpiGate {
    static constexpr bool PERM = true, AFTER_DRAIN = false; static constexpr int EPI_VM = 16;
    const bf16_t* T1; const bf16_t* T2; bf16_t* O; int ldc;
    __device__ __forceinline__ void operator()(const f32x4 (&acc)[2][2][4][2], const Unit& u, int wr, int wc, int fr, int fq) const {
        const int row0 = u.pm * BM + wr * 64 + fr, col0 = u.pn * BM + wc * 32 + 8 * fq;
#pragma unroll
        for (int ai = 0; ai < 2; ++ai)
#pragma unroll
            for (int m = 0; m < 4; ++m) { const size_t off = (size_t)(row0 + ai * HALF + m * 16) * ldc + col0;
#pragma unroll
                for (int bj = 0; bj < 2; ++bj) { const f32x4 v0 = acc[ai][bj][m][0], v1 = acc[ai][bj][m][1];
                    const u32x4 a = *(const u32x4*)(T1 + off + bj * HALF);
                    float r[8];
                    if (MODE == 0) {
                        r[0] = sigm(v0[0]) * bf_lo(a.x); r[1] = sigm(v0[1]) * bf_hi(a.x); r[2] = sigm(v0[2]) * bf_lo(a.y); r[3] = sigm(v0[3]) * bf_hi(a.y);
                        r[4] = sigm(v1[0]) * bf_lo(a.z); r[5] = sigm(v1[1]) * bf_hi(a.z); r[6] = sigm(v1[2]) * bf_lo(a.w); r[7] = sigm(v1[3]) * bf_hi(a.w);
                    } else {
                        const u32x4 b = *(const u32x4*)(T2 + off + bj * HALF);
                        r[0] = bf_lo(a.x) + sigm(v0[0]) * bf_lo(b.x); r[1] = bf_hi(a.x) + sigm(v0[1]) * bf_hi(b.x); r[2] = bf_lo(a.y) + sigm(v0[2]) * bf_lo(b.y); r[3] = bf_hi(a.y) + sigm(v0[3]) * bf_hi(b.y);
                        r[4] = bf_lo(a.z) + sigm(v1[0]) * bf_lo(b.z); r[5] = bf_hi(a.z) + sigm(v1[1]) * bf_hi(b.z); r[6] = bf_lo(a.w) + sigm(v1[2]) * bf_lo(b.w); r[7] = bf_hi(a.w) + sigm(v1[3]) * bf_hi(b.w);
                    }
                    u32x4 w; w.x = cvt_pk_bf16(r[0], r[1]); w.y = cvt_pk_bf16(r[2], r[3]); w.z = cvt_pk_bf16(r[4], r[5]); w.w = cvt_pk_bf16(r[6], r[7]);
                    *(u32x4*)(O + off + bj * HALF) = w; } }
    }
};
template <int MODE> struct EpiRes {
    static constexpr bool PERM = true, AFTER_DRAIN = false; static constexpr int EPI_VM = 16;
    const bf16_t* XB; bf16_t* OUT; const bf16_t* TP; int ldc; float alpha;
    __device__ __forceinline__ void operator()(const f32x4 (&acc)[2][2][4][2], const Unit& u, int wr, int wc, int fr, int fq) const {
        const int row0 = u.pm * BM + wr * 64 + fr, col0 = u.pn * BM + wc * 32 + 8 * fq;
#pragma unroll
        for (int ai = 0; ai < 2; ++ai)
#pragma unroll
            for (int mp = 0; mp < 2; ++mp) {
            u32x4 xbv[2][2], tv[2][2];
#pragma unroll
            for (int mm = 0; mm < 2; ++mm)
#pragma unroll
                for (int bj = 0; bj < 2; ++bj) { const size_t off = (size_t)(row0 + ai * HALF + (2 * mp + mm) * 16) * ldc + col0 + bj * HALF; xbv[mm][bj] = *(const u32x4*)(XB + off); if (MODE == 1) tv[mm][bj] = *(const u32x4*)(TP + off); }
            asm volatile("" ::: "memory");
#pragma unroll
            for (int mm = 0; mm < 2; ++mm) { const int m = 2 * mp + mm; const size_t off = (size_t)(row0 + ai * HALF + m * 16) * ldc + col0;
#pragma unroll
                for (int bj = 0; bj < 2; ++bj) { const f32x4 v0 = acc[ai][bj][m][0], v1 = acc[ai][bj][m][1];
                    const u32x4 xb = xbv[mm][bj];
                    float a[8] = {v0[0], v0[1], v0[2], v0[3], v1[0], v1[1], v1[2], v1[3]};
                    if (MODE == 1) { const u32x4 t = tv[mm][bj];
                        a[0] = bf_lo(t.x) * sigm(a[0]); a[1] = bf_hi(t.x) * sigm(a[1]); a[2] = bf_lo(t.y) * sigm(a[2]); a[3] = bf_hi(t.y) * sigm(a[3]);
                        a[4] = bf_lo(t.z) * sigm(a[4]); a[5] = bf_hi(t.z) * sigm(a[5]); a[6] = bf_lo(t.w) * sigm(a[6]); a[7] = bf_hi(t.w) * sigm(a[7]); }
                    u32x4 w;
                    w.x = cvt_pk_bf16(bf_lo(xb.x) * alpha + a[0], bf_hi(xb.x) * alpha + a[1]); w.y = cvt_pk_bf16(bf_lo(xb.y) * alpha + a[2], bf_hi(xb.y) * alpha + a[3]);
                    w.z = cvt_pk_bf16(bf_lo(xb.z) * alpha + a[4], bf_hi(xb.z) * alpha + a[5]); w.w = cvt_pk_bf16(bf_lo(xb.w) * alpha + a[6], bf_hi(xb.w) * alpha + a[7]);
                    *(u32x4*)(OUT + off + bj * HALF) = w; } }
            asm volatile("" ::: "memory"); }
    }
};
struct EpiRouter {
    static constexpr bool PERM = false, AFTER_DRAIN = false; static constexpr int EPI_VM = 0;
    float* LOG; const float* bias;
    __device__ __forceinline__ void operator()(const f32x4 (&acc)[2][2][4][2], const Unit& u, int wr, int wc, int fr, int fq) const {
        if (wc >= 2) return;
        const int row0 = u.pm * BM + wr * 64 + fr, col0 = wc * 32 + 4 * fq;
        const f32x4 b0 = *(const f32x4*)(bias + col0), b1 = *(const f32x4*)(bias + col0 + 16);
#pragma unroll
        for (int ai = 0; ai < 2; ++ai)
#pragma unroll
            for (int m = 0; m < 4; ++m) { float* p = LOG + (size_t)(row0 + ai * HALF + m * 16) * 64 + col0;
                *(f32x4*)p = acc[ai][0][m][0] + b0; *(f32x4*)(p + 16) = acc[ai][0][m][1] + b1; }
    }
};
struct EpiGate2 {
    static constexpr bool PERM = true, AFTER_DRAIN = false;
    const bf16_t* T1; const bf16_t* T2; bf16_t* O; int ldc;
    __device__ __forceinline__ void operator()(const f32x4 (&acc)[2][2][4][2], const Unit& u, int wr, int wc, int fr, int fq) const {
        const int row0 = u.pm * BM + wr * 64 + fr, col0 = u.pn * HALF + wc * 32 + 8 * fq;
#pragma unroll
        for (int ai = 0; ai < 2; ++ai) {
            u32x4 t1v[4], t2v[4];
#pragma unroll
            for (int m = 0; m < 4; ++m) { const size_t off = (size_t)(row0 + ai * HALF + m * 16) * ldc + col0; t1v[m] = *(const u32x4*)(T1 + off); t2v[m] = *(const u32x4*)(T2 + off); }
            asm volatile("" ::: "memory");
#pragma unroll
            for (int m = 0; m < 4; ++m) { const size_t off = (size_t)(row0 + ai * HALF + m * 16) * ldc + col0;
                const f32x4 a0 = acc[ai][0][m][0], a1 = acc[ai][0][m][1], b0 = acc[ai][1][m][0], b1 = acc[ai][1][m][1];
                const u32x4 t1 = t1v[m], t2 = t2v[m];
                float r[8];
                r[0] = sigm(a0[0]) * bf_lo(t1.x) + sigm(b0[0]) * bf_lo(t2.x); r[1] = sigm(a0[1]) * bf_hi(t1.x) + sigm(b0[1]) * bf_hi(t2.x);
                r[2] = sigm(a0[2]) * bf_lo(t1.y) + sigm(b0[2]) * bf_lo(t2.y); r[3] = sigm(a0[3]) * bf_hi(t1.y) + sigm(b0[3]) * bf_hi(t2.y);
                r[4] = sigm(a1[0]) * bf_lo(t1.z) + sigm(b1[0]) * bf_lo(t2.z); r[5] = sigm(a1[1]) * bf_hi(t1.z) + sigm(b1[1]) * bf_hi(t2.z);
                r[6] = sigm(a1[2]) * bf_lo(t1.w) + sigm(b1[2]) * bf_lo(t2.w); r[7] = sigm(a1[3]) * bf_hi(t1.w) + sigm(b1[3]) * bf_hi(t2.w);
                u32x4 w; w.x = cvt_pk_bf16(r[0], r[1]); w.y = cvt_pk_bf16(r[2], r[3]); w.z = cvt_pk_bf16(r[4], r[5]); w.w = cvt_pk_bf16(r[6], r[7]);
                *(u32x4*)(O + off) = w; }
            asm volatile("" ::: "memory"); }
    }
};
struct GateOrder {
    StaticOrder base;
    __device__ __forceinline__ void init(int M, int G_, int c_) { base.init(M, 1024, G_, c_); }
    __device__ __forceinline__ bool next(int i, Unit& u) const { Unit t; if (!base.next(i >> 1, t)) return false; u.pm = t.pm; u.pn = 2 * t.pn + (i & 1); return true; }
    __device__ __forceinline__ void a_ready(const Unit&) const {}
    __device__ __forceinline__ void done(const Unit&) const {}
};
struct EpiSwiglu {
    static constexpr bool PERM = true, AFTER_DRAIN = false; static constexpr int EPI_VM = 8;
    bf16_t* H;
    __device__ __forceinline__ void operator()(const f32x4 (&acc)[2][2][4][2], const Unit& u, int wr, int wc, int fr, int fq) const {
        const int row0 = u.pm * BM + wr * 64 + fr, col0 = (u.pn & 1) * HALF + wc * 32 + 8 * fq;
#pragma unroll
        for (int ai = 0; ai < 2; ++ai)
#pragma unroll
            for (int m = 0; m < 4; ++m) { bf16_t* rowp = H + (size_t)(row0 + ai * HALF + m * 16) * 256 + col0;
                const f32x4 g0 = acc[ai][0][m][0], g1 = acc[ai][0][m][1], u0 = acc[ai][1][m][0], u1 = acc[ai][1][m][1];
                float r[8];
#pragma unroll
                for (int q = 0; q < 4; ++q) { r[q] = g0[q] * sigm(g0[q]) * u0[q]; r[4 + q] = g1[q] * sigm(g1[q]) * u1[q]; }
                u32x4 w; w.x = cvt_pk_bf16(r[0], r[1]); w.y = cvt_pk_bf16(r[2], r[3]); w.z = cvt_pk_bf16(r[4], r[5]); w.w = cvt_pk_bf16(r[6], r[7]);
                *(u32x4*)rowp = w; }
    }
};
struct MoeOrder {
    const PG8_LAS int* tile_e; int nunits, npn, G, c;
    const PG8_LAS int* offs; const PG8_LAS int* cnts; const int* elist;
    __device__ __forceinline__ void init(const PG8_LAS int* te, int ntiles, int npn_, int G_, int c_) { tile_e = te; npn = npn_; nunits = ntiles * npn_; G = G_; c = c_; offs = nullptr; cnts = nullptr; elist = nullptr; }
    __device__ __forceinline__ bool next(int i, Unit& u) const {
        int L;
        if ((G & 7) == 0) { const int x = c & 7, k = c >> 3, q = nunits >> 3, r = nunits & 7, len = q + (x < r ? 1 : 0), loc = i * (G >> 3) + k; if (loc >= len) return false; L = x * q + (x < r ? x : r) + loc; }
        else { L = i * G + c; if (L >= nunits) return false; }
        const int rt = L / npn, pn = L - rt * npn;
        const int e = __builtin_amdgcn_readfirstlane(tile_e[rt]);
        u.pm = rt; u.pn = e * npn + pn; return true;
    }
    __device__ __forceinline__ int src_row(const Unit& u, int rr) const {
        const int e = u.pn / npn; int loc = u.pm * 256 - offs[e] + rr; const int lim = cnts[e] - 1; loc = loc < lim ? loc : lim;
        return elist[e * 32768 + loc];
    }
    __device__ __forceinline__ void a_ready(const Unit&) const {}
    __device__ __forceinline__ void done(const Unit&) const {}
};
struct MoeOrderPub : MoeOrder {
    unsigned* cnt;
    __device__ __forceinline__ void done(const Unit& u) const {
        asm volatile("s_waitcnt vmcnt(0)" ::: "memory");
        if ((int)__builtin_amdgcn_mbcnt_hi(~0u, __builtin_amdgcn_mbcnt_lo(~0u, 0u)) == 0) __hip_atomic_fetch_add(cnt + 64 * u.pm, 1u, __ATOMIC_RELAXED, __HIP_MEMORY_SCOPE_AGENT);
    }
};
struct MoeOrderWait : MoeOrder {
    const unsigned* cnt; unsigned need; unsigned* tmo; int wv;
    __device__ __forceinline__ void a_ready(const Unit& u) const {
        if (wv == 0) {
            const unsigned long long t0 = __builtin_amdgcn_s_memrealtime(); unsigned polls = 0;
            while ((unsigned)__builtin_amdgcn_readfirstlane(__hip_atomic_load(cnt + 64 * u.pm, __ATOMIC_RELAXED, __HIP_MEMORY_SCOPE_AGENT)) < need) {
                if ((++polls & 255u) == 0u && __builtin_amdgcn_readfirstlane(__hip_atomic_load(tmo, __ATOMIC_RELAXED, __HIP_MEMORY_SCOPE_AGENT)) != 0u) break;
                if (__builtin_amdgcn_s_memrealtime() - t0 > 2000000ull) { __hip_atomic_store(tmo, 1u, __ATOMIC_RELAXED, __HIP_MEMORY_SCOPE_AGENT); break; }
                __builtin_amdgcn_s_sleep(2); }
            __builtin_amdgcn_fence(__ATOMIC_ACQUIRE, "agent");
            asm volatile("s_waitcnt vmcnt(0)" ::: "memory");
        }
        asm volatile("" ::: "memory"); __builtin_amdgcn_s_barrier(); asm volatile("" ::: "memory");
    }
};
template <class Epi, class Sched, bool ALIGN_EPI = false, bool SP2 = false, bool GATHER = false>
__device__ __forceinline__ void gemm_phase(PG8_LAS unsigned char* lds, const Gemm g, const Sched& S, const Epi& E, const int wv) {
    int tid_ = wv * 64 + (int)__builtin_amdgcn_mbcnt_hi(~0u, __builtin_amdgcn_mbcnt_lo(~0u, 0u)); asm volatile("" : "+v"(tid_));
    const int tid = tid_, wid = __builtin_amdgcn_readfirstlane(tid >> 6), lane = tid & 63, wr = wid >> 2, wc = wid & 3, fr = lane & 15, fq = lane >> 4;
    const int K = g.K, nt = K / BK;
    unsigned voffA[2], voffB[2];
#pragma unroll
    for (int i = 0; i < 2; ++i) { int R, C; stage_rc(tid * 16 + i * 8192, R, C); const int Rb = Epi::PERM ? ((R & ~31) + perm32(R & 31)) : R;
        voffA[i] = (unsigned)(R * K + C) * 2u; voffB[i] = (unsigned)(Rb * K + C) * 2u; }
    const size_t kstep = (size_t)(BK * 2);
    const size_t hstep = (size_t)HALF * K * 2;
    const size_t tstep = 2 * hstep;
    static_assert(!GATHER || SP2, "GATHER is wired into the SP2 loop only");
    const size_t hstepA = GATHER ? (size_t)0 : hstep;
    unsigned vAc[2][2], vAn[2][2];
#define PG8_ROWS(u_, dst) do { _Pragma("unroll") for (int h_ = 0; h_ < 2; ++h_) _Pragma("unroll") for (int i_ = 0; i_ < 2; ++i_) { int R_, C_; stage_rc(tid * 16 + i_ * 8192, R_, C_); \
        const int src_ = S.src_row((u_), h_ * HALF + R_); dst[h_][i_] = (unsigned)(src_ * K + C_) * 2u; } } while (0)
    const unsigned ldsw = (unsigned)wid * 1024u;
    const int aoff = lds_byte(wr * 64 + fr, fq * 8), boff = lds_byte(wc * 32 + fr, fq * 8);
#define PG8_SA(b, h) (((b) * 2 + (h)) * HTB)
#define PG8_SB(b, h) ((4 + (b) * 2 + (h)) * HTB)
#define PG8_STAGE(bufoff, gbase, voff) do { _Pragma("unroll") for (int _i = 0; _i < 2; ++_i) \
        __builtin_amdgcn_global_load_lds((const unsigned*)((const char*)(gbase) + (voff)[_i]), (PG8_LAS unsigned*)(lds + (bufoff) + ldsw + _i * 8192), 16, 0, 0); } while (0)
#define PG8_LDA(dst, b, h) do { _Pragma("unroll") for (int m = 0; m < 4; ++m) _Pragma("unroll") for (int k = 0; k < 2; ++k) dst[m][k] = *(const PG8_LAS bf16x8*)(lds + PG8_SA(b, h) + aoff + m * 2048 + k * 1024); } while (0)
#define PG8_LDB(dst, b, h) do { _Pragma("unroll") for (int n = 0; n < 2; ++n) _Pragma("unroll") for (int k = 0; k < 2; ++k) dst[n][k] = *(const PG8_LAS bf16x8*)(lds + PG8_SB(b, h) + boff + n * 2048 + k * 1024); } while (0)
#define PG8_MMA(ai, bj, At, Bt) do { __builtin_amdgcn_s_setprio(1); _Pragma("unroll") for (int m = 0; m < 4; ++m) _Pragma("unroll") for (int n = 0; n < 2; ++n) _Pragma("unroll") for (int k = 0; k < 2; ++k) \
        acc[ai][bj][m][n] = __builtin_amdgcn_mfma_f32_16x16x32_bf16(Bt[n][k], At[m][k], acc[ai][bj][m][n], 0, 0, 0); __builtin_amdgcn_s_setprio(0); } while (0)
#define PG8_WAIT_V(n) asm volatile("s_waitcnt vmcnt(" #n ")" ::: "memory")
#define PG8_WAIT_L(n) asm volatile("s_waitcnt lgkmcnt(" #n ")" ::: "memory")
#define PG8_BAR __builtin_amdgcn_s_barrier()
#define PG8_SCHED __builtin_amdgcn_sched_barrier(0)
    Unit cur, nxt; int ui = 0;
    if (!S.next(0, cur)) return;
    f32x4 acc[2][2][4][2];
#pragma unroll
    for (int a = 0; a < 2; ++a)
#pragma unroll
        for (int b = 0; b < 2; ++b)
#pragma unroll
            for (int m = 0; m < 4; ++m)
#pragma unroll
                for (int n = 0; n < 2; ++n) acc[a][b][m][n] = (f32x4){0.f, 0.f, 0.f, 0.f};
    bf16x8 At[4][2], B0[2][2], B1[2][2];
    const char* cA = (const char*)g.A + (GATHER ? (size_t)0 : (size_t)cur.pm * tstep); const char* cB = (const char*)g.Bt + (size_t)cur.pn * tstep;
    if constexpr (GATHER) { PG8_ROWS(cur, vAc); _Pragma("unroll") for (int h_ = 0; h_ < 2; ++h_) _Pragma("unroll") for (int i_ = 0; i_ < 2; ++i_) vAn[h_][i_] = vAc[h_][i_]; }
#define PG8_VA(h_, sel_) (GATHER ? (sel_)[h_] : voffA)
    S.a_ready(cur);
    if constexpr (SP2) {
        PG8_STAGE(PG8_SB(0, 0), cB, voffB); PG8_STAGE(PG8_SB(0, 1), cB + hstep, voffB); PG8_STAGE(PG8_SA(0, 0), cA, PG8_VA(0, vAc)); PG8_STAGE(PG8_SA(0, 1), cA + hstepA, PG8_VA(1, vAc));
        if (wr == 1) PG8_BAR;
        PG8_WAIT_V(2); PG8_BAR;
        PG8_STAGE(PG8_SB(1, 0), cB + kstep, voffB); PG8_STAGE(PG8_SA(1, 0), cA + kstep, PG8_VA(0, vAc)); PG8_STAGE(PG8_SB(1, 1), cB + hstep + kstep, voffB);
        PG8_WAIT_V(6); PG8_BAR;
    } else {
        PG8_STAGE(PG8_SB(0, 0), cB, voffB); PG8_STAGE(PG8_SA(0, 0), cA, voffA); PG8_STAGE(PG8_SB(0, 1), cB + hstep, voffB); PG8_STAGE(PG8_SA(0, 1), cA + hstep, voffA);
        if (wr == 1) PG8_BAR;
        PG8_WAIT_V(4); PG8_BAR;
        PG8_STAGE(PG8_SB(1, 0), cB + kstep, voffB); PG8_STAGE(PG8_SA(1, 0), cA + kstep, voffA); PG8_STAGE(PG8_SB(1, 1), cB + hstep + kstep, voffB);
        PG8_WAIT_V(6); PG8_BAR;
    }
    for (;;) {
        const bool has_next = S.next(ui + 1, nxt);
        const char* nA = (has_next && !GATHER) ? (const char*)g.A + (size_t)nxt.pm * tstep : cA; const char* nB = has_next ? (const char*)g.Bt + (size_t)nxt.pn * tstep : cB;
        if constexpr (GATHER) { if (has_next) PG8_ROWS(nxt, vAn); }
        for (int t = 0; t < nt; t += 2) {
            const bool last = (t == nt - 2);
            const char* a1 = cA + (size_t)(t + 1) * kstep;
            const char* a2 = last ? nA : cA + (size_t)(t + 2) * kstep; const char* b2 = last ? nB : cB + (size_t)(t + 2) * kstep;
            const char* a3 = a2 + kstep; const char* b3 = b2 + kstep;
            unsigned vS[2][2];
            if constexpr (GATHER) { _Pragma("unroll") for (int h_ = 0; h_ < 2; ++h_) _Pragma("unroll") for (int i_ = 0; i_ < 2; ++i_) vS[h_][i_] = vAc[h_][i_];
                if (last) { asm volatile("" ::: "memory");
                    _Pragma("unroll") for (int h_ = 0; h_ < 2; ++h_) _Pragma("unroll") for (int i_ = 0; i_ < 2; ++i_) vS[h_][i_] = vAn[h_][i_]; } }
            if (last && has_next) S.a_ready(nxt);
            if constexpr (SP2) {
            PG8_LDB(B0, 0, 0); PG8_LDB(B1, 0, 1); PG8_SCHED; PG8_LDA(At, 0, 0); PG8_STAGE(PG8_SA(1, 1), a1 + hstepA, PG8_VA(1, vAc));
            PG8_WAIT_V(8); PG8_WAIT_L(0); PG8_BAR; PG8_MMA(0, 0, At, B0); PG8_MMA(0, 1, At, B1); PG8_BAR; PG8_SCHED;
            PG8_LDA(At, 0, 1); PG8_STAGE(PG8_SB(0, 0), b2, voffB); PG8_STAGE(PG8_SB(0, 1), b2 + hstep, voffB); PG8_STAGE(PG8_SA(0, 0), a2, PG8_VA(0, vS));
            PG8_WAIT_V(8); PG8_WAIT_L(0); PG8_BAR; PG8_MMA(1, 0, At, B0); PG8_MMA(1, 1, At, B1); PG8_BAR; PG8_SCHED;
            PG8_LDB(B0, 1, 0); PG8_LDB(B1, 1, 1); PG8_SCHED; PG8_LDA(At, 1, 0); PG8_STAGE(PG8_SA(0, 1), a2 + hstepA, PG8_VA(1, vS));
            PG8_WAIT_V(8); PG8_WAIT_L(0); PG8_BAR; PG8_MMA(0, 0, At, B0); PG8_MMA(0, 1, At, B1); PG8_BAR; PG8_SCHED;
            PG8_LDA(At, 1, 1); PG8_STAGE(PG8_SB(1, 0), b3, voffB); PG8_STAGE(PG8_SB(1, 1), b3 + hstep, voffB); PG8_STAGE(PG8_SA(1, 0), a3, PG8_VA(0, vS));
            PG8_WAIT_V(8); PG8_WAIT_L(0); PG8_BAR; PG8_MMA(1, 0, At, B0); PG8_MMA(1, 1, At, B1); PG8_BAR; PG8_SCHED;
            } else {
            PG8_LDB(B0, 0, 0); PG8_SCHED; PG8_LDA(At, 0, 0); PG8_STAGE(PG8_SA(1, 1), a1 + hstep, voffA);
            PG8_WAIT_L(8); PG8_BAR; PG8_WAIT_L(0); PG8_MMA(0, 0, At, B0); PG8_BAR; PG8_SCHED;
            PG8_LDB(B1, 0, 1); PG8_STAGE(PG8_SB(0, 0), b2, voffB);
            PG8_BAR; PG8_WAIT_L(0); PG8_MMA(0, 1, At, B1); PG8_BAR;
            PG8_LDA(At, 0, 1); PG8_STAGE(PG8_SA(0, 0), a2, voffA);
            PG8_BAR; PG8_WAIT_L(0); PG8_MMA(1, 0, At, B0); PG8_BAR; PG8_SCHED;
            PG8_STAGE(PG8_SB(0, 1), b2 + hstep, voffB);
            PG8_WAIT_V(6); PG8_BAR; PG8_MMA(1, 1, At, B1); PG8_BAR;
            PG8_LDB(B0, 1, 0); PG8_SCHED; PG8_LDA(At, 1, 0); PG8_STAGE(PG8_SA(0, 1), a2 + hstep, voffA);
            PG8_WAIT_L(8); PG8_BAR; PG8_WAIT_L(0); PG8_MMA(0, 0, At, B0); PG8_BAR; PG8_SCHED;
            PG8_LDB(B1, 1, 1); PG8_STAGE(PG8_SB(1, 0), b3, voffB);
            PG8_BAR; PG8_WAIT_L(0); PG8_MMA(0, 1, At, B1); PG8_BAR;
            PG8_LDA(At, 1, 1); PG8_STAGE(PG8_SA(1, 0), a3, voffA);
            PG8_BAR; PG8_WAIT_L(0); PG8_MMA(1, 0, At, B0); PG8_BAR; PG8_SCHED;
            PG8_STAGE(PG8_SB(1, 1), b3 + hstep, voffB);
            PG8_WAIT_V(6); PG8_BAR; PG8_MMA(1, 1, At, B1); PG8_BAR;
            }
        }
        if constexpr (ALIGN_EPI) { if (wr == 0) PG8_BAR; }
        if constexpr (!Epi::AFTER_DRAIN) { E(acc, cur, wr, wc, fr, fq); S.done(cur); }
        if (!has_next) break;
#pragma unroll
        for (int a = 0; a < 2; ++a)
#pragma unroll
            for (int b = 0; b < 2; ++b)
#pragma unroll
                for (int m = 0; m < 4; ++m)
#pragma unroll
                    for (int n = 0; n < 2; ++n) acc[a][b][m][n] = (f32x4){0.f, 0.f, 0.f, 0.f};
        cur = nxt; cA = nA; cB = nB; ++ui;
        if constexpr (GATHER) { _Pragma("unroll") for (int h_ = 0; h_ < 2; ++h_) _Pragma("unroll") for (int i_ = 0; i_ < 2; ++i_) vAc[h_][i_] = vAn[h_][i_]; }
        if constexpr (ALIGN_EPI) { if (wr == 1) PG8_BAR; }
    }
    PG8_WAIT_V(0);
    if constexpr (!ALIGN_EPI) { if (wr == 0) PG8_BAR; }
    PG8_BAR;
    if constexpr (Epi::AFTER_DRAIN) { E.fused(acc, cur, wr, wc, fr, fq, lds, wid, lane); S.done(cur); }
#undef PG8_SA
#undef PG8_ROWS
#undef PG8_VA
#undef PG8_SB
#undef PG8_STAGE
#undef PG8_LDA
#undef PG8_LDB
#undef PG8_MMA
#undef PG8_WAIT_V
#undef PG8_WAIT_L
#undef PG8_BAR
#undef PG8_SCHED
}
}

constexpr int T = 32768, D = 1024, SEQ = 2048;
constexpr int NWAVES = 8;
constexpr float LOG2E = 1.44269504f, ALPHA = 1.41421356237f, LN_EPS = 1e-5f, GN_EPS = 64e-5f;
constexpr size_t MiB = 1u << 20;
constexpr size_t WS_CTL = 0, CTL_ZERO_BYTES = 1 * MiB;
constexpr size_t WS_DUT = 1 * MiB, WS_AUT = WS_DUT + 128 * 1024, WS_GUT = WS_DUT + 256 * 1024, WS_VDT = WS_DUT + 576 * 1024, WS_VUT = WS_DUT + 608 * 1024,
                 WS_RB = WS_DUT + 640 * 1024, WS_TILE = WS_DUT + 704 * 1024;
constexpr size_t WS_RWT = 2 * MiB;
constexpr size_t WS_TOKE = 3 * MiB, WS_TOKP = WS_TOKE + 256 * 1024, WS_TOKW = WS_TOKE + 512 * 1024, WS_TOKS = WS_TOKE + 768 * 1024;
constexpr size_t WS_WNE = 4 * MiB, WNE_LAYER = 18 * MiB;
constexpr size_t WNE_WIN = 0, WNE_WBA = 11 * MiB, WNE_WBR = 12 * MiB, WNE_WOUT = 13 * MiB, WNE_WPG = 15 * MiB, WNE_WPLE = 17 * MiB;
constexpr size_t WS_XB = 40 * MiB, WS_VF = 104 * MiB, WS_YA = 136 * MiB, WS_YB = 168 * MiB, WS_QK = 200 * MiB, WS_VT = 264 * MiB, WS_RKVL = 296 * MiB, WS_NU = 412 * MiB, WS_GH = 200 * MiB;
constexpr size_t WS_LW = 168 * MiB, WS_GG = 444 * MiB, OUT_AA = 96 * MiB;
constexpr size_t WS_T1 = 200 * MiB, WS_T2 = 264 * MiB, WS_MP = 328 * MiB;
constexpr size_t WS_EGU = 136 * MiB, WS_EDN = 168 * MiB, WS_LOG = 184 * MiB, WS_XG = 200 * MiB, WS_H = 344 * MiB, WS_PB = 392 * MiB, WS_TP = 216 * MiB, WS_PRE2 = 280 * MiB, WS_ELIST = 380 * MiB;
constexpr size_t WS_END = 508 * MiB;
constexpr int CW_TMO = 0, CW_BAR = 4096, CW_CNT = 16384, CW_NTILES = 16384 + 256, CW_CHK = 16384 + 512, CW_KCNT = 32768;
constexpr int WIN_ROWS = 5632;
constexpr int RING_BYTES = 131072, MISC_OFF = RING_BYTES + 320, TILE_LDS = RING_BYTES + 1024, LDS_BYTES = 147456;

#define GAS __attribute__((address_space(1)))
#define LAS __attribute__((address_space(3)))
typedef unsigned short bf16;
typedef unsigned v4u __attribute__((ext_vector_type(4)));
typedef unsigned v2u __attribute__((ext_vector_type(2)));
typedef float f32x4 __attribute__((ext_vector_type(4)));
typedef float f32x16 __attribute__((ext_vector_type(16)));
typedef short bf16x8 __attribute__((ext_vector_type(8)));
typedef GAS unsigned gu32;
#define RLX_AGENT __ATOMIC_RELAXED, __HIP_MEMORY_SCOPE_AGENT
#define LDS_WAIT() asm volatile("s_waitcnt lgkmcnt(0)" ::: "memory")
#define VM_WAIT() asm volatile("s_waitcnt vmcnt(0)" ::: "memory")
#define MFMA32(a, b, c) __builtin_amdgcn_mfma_f32_32x32x16_bf16((a), (b), (c), 0, 0, 0)
__device__ __forceinline__ unsigned f2bf(float f) { unsigned u = __builtin_bit_cast(unsigned, f); return (u + 0x7fffu + ((u >> 16) & 1u)) >> 16; }
typedef float f32x2_t __attribute__((ext_vector_type(2)));
typedef __bf16 bf16x2_t __attribute__((ext_vector_type(2)));
__device__ __forceinline__ unsigned pk2(float lo, float hi) { f32x2_t v = {lo, hi}; bf16x2_t b = __builtin_convertvector(v, bf16x2_t); return __builtin_bit_cast(unsigned, b); }
__device__ __forceinline__ float bflo(unsigned w) { return __uint_as_float(w << 16); }
__device__ __forceinline__ float bfhi(unsigned w) { return __uint_as_float(w & 0xffff0000u); }
__device__ __forceinline__ float sigm(float x) { return __builtin_amdgcn_rcpf(1.0f + __builtin_amdgcn_exp2f(-LOG2E * x)); }
__device__ __forceinline__ void unpack8(const v4u w, float (&f)[8]) { f[0] = bflo(w.x); f[1] = bfhi(w.x); f[2] = bflo(w.y); f[3] = bfhi(w.y); f[4] = bflo(w.z); f[5] = bfhi(w.z); f[6] = bflo(w.w); f[7] = bfhi(w.w); }
__device__ __forceinline__ v4u pack8(const float (&f)[8]) { v4u w; w.x = pk2(f[0], f[1]); w.y = pk2(f[2], f[3]); w.z = pk2(f[4], f[5]); w.w = pk2(f[6], f[7]); return w; }
template <int CTRL> __device__ __forceinline__ float dppf(float x) { return __builtin_bit_cast(float, __builtin_amdgcn_update_dpp(0, __builtin_bit_cast(int, x), CTRL, 0xF, 0xF, true)); }
__device__ __forceinline__ float red8(float x) { x += dppf<0xB1>(x); x += dppf<0x4E>(x); x += dppf<0x141>(x); return x; }
__device__ __forceinline__ float wave_sum(float v) {
    v += dppf<0xB1>(v); v += dppf<0x4E>(v); v += dppf<0x141>(v); v += dppf<0x140>(v);
    const int iv = __builtin_bit_cast(int, v);
    return (__builtin_bit_cast(float, __builtin_amdgcn_readlane(iv, 0)) + __builtin_bit_cast(float, __builtin_amdgcn_readlane(iv, 16)))
         + (__builtin_bit_cast(float, __builtin_amdgcn_readlane(iv, 32)) + __builtin_bit_cast(float, __builtin_amdgcn_readlane(iv, 48)));
}
__device__ __forceinline__ int crow(int i, int hh) { return (i & 3) + 8 * (i >> 2) + 4 * hh; }
#define XB_TMO      128
#define XB_XCNT(j)  (256  + 64 * (j))
#define XB_XSUB(j)  (1280 + 64 * (j))
#define XB_XGEN(j)  (2304 + 64 * (j))
#define XB_TOP      3328
#define XB_TOPGEN   3392
#define XCD_BAR_WORDS 3456
#define XB_SPIN_CAP (1u << 18)

__device__ __forceinline__ unsigned xb_ld(unsigned* p)              { return __hip_atomic_load(p, __ATOMIC_RELAXED, __HIP_MEMORY_SCOPE_AGENT); }
__device__ __forceinline__ unsigned xb_add(unsigned* p, unsigned v) { return __hip_atomic_fetch_add(p, v, __ATOMIC_RELAXED, __HIP_MEMORY_SCOPE_AGENT); }
__device__ __forceinline__ unsigned xb_xcc_id() { return (unsigned)__builtin_amdgcn_s_getreg((3 << 11) | 20) & 0xFu; }
#define XB_SPIN(cond, bar) do { unsigned _sp = 0; while (cond) { __builtin_amdgcn_s_sleep(1); \
    if ((++_sp & 255u) == 0u) { if (xb_ld(&(bar)[XB_TMO])) break; if (_sp > XB_SPIN_CAP) { atomicAdd(&(bar)[XB_TMO], 1u); break; } } } } while (0)

struct XcdBarrier {
    unsigned* bar; unsigned x;
    volatile LAS unsigned* st;
};

__device__ __forceinline__ XcdBarrier xcd_barrier_post(unsigned* bar, volatile LAS unsigned* st) {
    XcdBarrier b; b.bar = bar; b.x = xb_xcc_id(); b.st = st;
    if (threadIdx.x == 0) (void)xb_add(&bar[XB_XCNT(b.x)], 1u);
    return b;
}
__device__ __forceinline__ void xcd_barrier_complete(unsigned* bar, unsigned x, unsigned& nloc, unsigned& nx) {
    const unsigned G = gridDim.x * gridDim.y * gridDim.z;
    unsigned sum, cnt, mine, sp = 0u;
    for (;;) {
        sum = 0u; cnt = 0u; mine = 0u;
#pragma unroll
        for (unsigned j = 0; j < 16; ++j) { const unsigned c = xb_ld(&bar[XB_XCNT(j)]); sum += c; cnt += (c > 0u) ? 1u : 0u; mine = (j == x) ? c : mine; }
        if (sum == G) break;
        __builtin_amdgcn_s_sleep(1);
        if ((++sp & 255u) == 0u) { if (xb_ld(&bar[XB_TMO])) break; if (sp > XB_SPIN_CAP) { atomicAdd(&bar[XB_TMO], 1u); break; } }
    }
    nloc = mine > 0u ? mine : 1u; nx = cnt > 0u ? cnt : 1u;
}

__device__ __forceinline__ void xcd_barrier(const XcdBarrier& b, const bool leader) {
    asm volatile("s_waitcnt vmcnt(0)" ::: "memory");
    __syncthreads();
    if (leader) {
        unsigned* bar = b.bar;
        __builtin_amdgcn_s_waitcnt(0);
        unsigned nloc = b.st[0], nx = b.st[1];
        if (nloc == 0u) { xcd_barrier_complete(bar, b.x, nloc, nx); b.st[0] = nloc; b.st[1] = nx; }
        const unsigned old = xb_add(&bar[XB_XSUB(b.x)], 1u);
        const unsigned gen = old / nloc;
        if (old + 1u == (gen + 1u) * nloc) {
            __builtin_amdgcn_fence(__ATOMIC_RELEASE, "agent");
            asm volatile("s_waitcnt vmcnt(0)" ::: "memory");
            const unsigned og = xb_add(&bar[XB_TOP], 1u);
            const unsigned tg = og / nx;
            if (og + 1u == (tg + 1u) * nx) xb_add(&bar[XB_TOPGEN], 1u);
            else XB_SPIN(xb_ld(&bar[XB_TOPGEN]) == tg, bar);
            __builtin_amdgcn_fence(__ATOMIC_ACQUIRE, "agent");
            xb_add(&bar[XB_XGEN(b.x)], 1u);
            asm volatile("s_waitcnt vmcnt(0)" ::: "memory");
        } else {
            XB_SPIN(xb_ld(&bar[XB_XGEN(b.x)]) == gen, bar);
            __builtin_amdgcn_fence(__ATOMIC_ACQUIRE, "agent");
            asm volatile("s_waitcnt vmcnt(0)" ::: "memory");
        }
    }
    __syncthreads();
}

__device__ __forceinline__ void transpose_item(const float* W, int ldw, int k0, int n0, bf16* WT, int ldk, int drow0, LAS float* scr, int lane) {
#pragma unroll 8
    for (int i = 0; i < 32; ++i) { const int kk = 2 * i + (lane >> 5); scr[kk * 33 + (lane & 31)] = W[(size_t)(k0 + kk) * ldw + n0 + (lane & 31)]; }
    LDS_WAIT(); asm volatile("" ::: "memory");
    const int c = lane & 7;
#pragma unroll
    for (int j = 0; j < 4; ++j) { const int n = (lane >> 3) + 8 * j; const LAS float* s = scr + (8 * c) * 33 + n;
        v4u o; o.x = pk2(s[0 * 33], s[1 * 33]); o.y = pk2(s[2 * 33], s[3 * 33]); o.z = pk2(s[4 * 33], s[5 * 33]); o.w = pk2(s[6 * 33], s[7 * 33]);
        *(GAS v4u*)(WT + (size_t)(drow0 + n) * ldk + k0 + 8 * c) = o; }
    LDS_WAIT(); asm volatile("" ::: "memory");
}

template <int SRC, int DST>
__device__ __forceinline__ void ln_pass(const float* src, float* dst, bf16* XB, const float* g, const float* b, const bf16* Y2, const int* TOKE, const float* TOKW, int gw, int NGW, int lane, int mend = T, const int* TOKP = nullptr, const LAS int* offs = nullptr) {
    f32x4 gv[4], bv[4];
#pragma unroll
    for (int j = 0; j < 4; ++j) { gv[j] = *(const f32x4*)(g + 4 * lane + 256 * j); bv[j] = *(const f32x4*)(b + 4 * lane + 256 * j); }
    for (int m = gw; m < mend; m += NGW) {
        f32x4 v[4]; float s = 0.f;
        if (SRC == 0) {
            const GAS f32x4* xr = (const GAS f32x4*)(src + (size_t)m * D) + lane;
#pragma unroll
            for (int j = 0; j < 4; ++j) v[j] = xr[64 * j];
        } else if (SRC == 2) {
            const GAS v2u* x0 = (const GAS v2u*)(Y2 + (size_t)m * D) + lane;
#pragma unroll
            for (int j = 0; j < 4; ++j) { const v2u x = x0[64 * j]; v[j] = (f32x4){bflo(x.x), bfhi(x.x), bflo(x.y), bfhi(x.y)}; }
        } else {
            const int s1 = offs[TOKE[2 * m]] + TOKP[2 * m], s2 = offs[TOKE[2 * m + 1]] + TOKP[2 * m + 1]; const float w1 = TOKW[2 * m], w2 = TOKW[2 * m + 1];
            const GAS v2u* x0 = (const GAS v2u*)(XB + (size_t)m * D) + lane;
            const GAS v2u* y1 = (const GAS v2u*)(Y2 + (size_t)s1 * D) + lane; const GAS v2u* y2 = (const GAS v2u*)(Y2 + (size_t)s2 * D) + lane;
#pragma unroll
            for (int j = 0; j < 4; ++j) { const v2u x = x0[64 * j], a = y1[64 * j], c = y2[64 * j];
                v[j] = ALPHA * (f32x4){bflo(x.x), bfhi(x.x), bflo(x.y), bfhi(x.y)} + w1 * (f32x4){bflo(a.x), bfhi(a.x), bflo(a.y), bfhi(a.y)} + w2 * (f32x4){bflo(c.x), bfhi(c.x), bflo(c.y), bfhi(c.y)}; }
        }
#pragma unroll
        for (int j = 0; j < 4; ++j) s += (v[j].x + v[j].y) + (v[j].z + v[j].w);
        const float mean = wave_sum(s) * (1.f / D); float s2 = 0.f;
#pragma unroll
        for (int j = 0; j < 4; ++j) { v[j] = v[j] - mean; s2 += (v[j].x * v[j].x + v[j].y * v[j].y) + (v[j].z * v[j].z + v[j].w * v[j].w); }
        const float rstd = 1.f / sqrtf(wave_sum(s2) * (1.f / D) + LN_EPS);
        GAS f32x4* o4 = (GAS f32x4*)(dst + (size_t)m * D) + lane;
        GAS v2u* o8 = (GAS v2u*)(XB + (size_t)m * D) + lane;
#pragma unroll
        for (int j = 0; j < 4; ++j) { const f32x4 y = v[j] * rstd * gv[j] + bv[j];
            if (DST == 1) o4[64 * j] = y; else { v2u w; w.x = pk2(y.x, y.y); w.y = pk2(y.z, y.w); o8[64 * j] = w; } }
    }
}

__device__ __forceinline__ void attn_phase(LAS unsigned char* lds, const bf16* QK, const bf16* VT, bf16* YA, const float* rel_bias, int vcu, int G, int tid) {
    LAS float* bl = (LAS float*)lds;
    for (int i = tid; i < 8 * 257; i += NWAVES * 64) bl[i] = rel_bias[i] * LOG2E;
    __syncthreads();
    const int h = __builtin_amdgcn_readfirstlane(tid >> 6), lane = tid & 63, r = lane & 31, hh = lane >> 5;
    const int pr = 16 * ((r >> 2) & 1) + (r & 3) + 4 * (r >> 3);
    const float C1 = 0.125f * LOG2E;
    constexpr float ATT_THR = 4.0f;
    const float b256 = bl[h * 257 + 256];
    for (int unit = vcu; unit < 512; unit += G) {
        const int b = unit >> 5, c = unit & 31;
        const size_t rowQ = (size_t)b * SEQ + (size_t)c * 64;
        const bf16* Qp = QK + rowQ * 1024 + h * 64;
        const bf16* Kb = QK + (size_t)b * SEQ * 1024 + 512 + h * 64;
        const bf16* Vb = VT + (size_t)(h * 64) * T + (size_t)b * SEQ;
        bf16x8 qf[2][4];
#pragma unroll
        for (int qb = 0; qb < 2; ++qb)
#pragma unroll
            for (int kk = 0; kk < 4; ++kk) qf[qb][kk] = *(const bf16x8*)(Qp + (size_t)(qb * 32 + r) * 1024 + 16 * kk + 8 * hh);
        f32x16 o[2][2];
#pragma unroll
        for (int a = 0; a < 2; ++a)
#pragma unroll
            for (int q = 0; q < 2; ++q)
#pragma unroll
                for (int i = 0; i < 16; ++i) o[a][q][i] = 0.f;
        float mrun[2] = {-INFINITY, -INFINITY}, lrun[2] = {0.f, 0.f};
        const int kt0 = c >= 8 ? 0 : (8 - c) * 2;
        LAS unsigned char* kbuf = lds + 8448 + h * 9728; LAS unsigned char* vbuf = kbuf + 4608;
        const int krow = lane >> 3, kc16 = lane & 7, vrow = lane >> 2, vc16 = lane & 3;
        v4u kg[4], vg[4];
        { const int tk0 = (c - 8) * 64 + 32 * kt0;
#pragma unroll
          for (int i = 0; i < 4; ++i) { kg[i] = *(const GAS v4u*)(Kb + (size_t)(tk0 + 8 * i + krow) * 1024 + kc16 * 8); vg[i] = *(const GAS v4u*)(Vb + (size_t)(16 * i + vrow) * T + tk0 + vc16 * 8); } }
        bf16x8 kf[4], vf[2][2];
        for (int kt = kt0; kt < 18; ++kt) {
#pragma unroll
            for (int i = 0; i < 4; ++i) { *(LAS v4u*)(kbuf + (8 * i + krow) * 144 + kc16 * 16) = kg[i]; *(LAS v4u*)(vbuf + (16 * i + vrow) * 80 + vc16 * 16) = vg[i]; }
            if (kt + 1 < 18) { const int tk1 = (c - 8) * 64 + 32 * (kt + 1);
#pragma unroll
                for (int i = 0; i < 4; ++i) { kg[i] = *(const GAS v4u*)(Kb + (size_t)(tk1 + 8 * i + krow) * 1024 + kc16 * 8); vg[i] = *(const GAS v4u*)(Vb + (size_t)(16 * i + vrow) * T + tk1 + vc16 * 8); } }
#pragma unroll
            for (int kk = 0; kk < 4; ++kk) kf[kk] = *(const LAS bf16x8*)(kbuf + pr * 144 + (16 * kk + 8 * hh) * 2);
#pragma unroll
            for (int db = 0; db < 2; ++db)
#pragma unroll
                for (int st = 0; st < 2; ++st) vf[db][st] = *(const LAS bf16x8*)(vbuf + (db * 32 + r) * 80 + (16 * hh + 8 * st) * 2);
            bf16x8 pf[2][2];
#pragma unroll
            for (int qb = 0; qb < 2; ++qb) {
                f32x16 s;
#pragma unroll
                for (int i = 0; i < 16; ++i) s[i] = 0.f;
#pragma unroll
                for (int kk = 0; kk < 4; ++kk) s = MFMA32(kf[kk], qf[qb][kk], s);
                float t[16];
                if (kt >= 12) {
                    const int dbase = 512 + qb * 32 + r - (32 * kt + 16 * hh);
#pragma unroll
                    for (int i = 0; i < 16; ++i) { int dist = dbase - i; dist = dist > 128 ? 128 : dist; dist = dist < -128 ? -128 : dist; s[i] = s[i] * C1 + bl[h * 257 + dist + 128]; }
                }
                float ml = fmaxf(fmaxf(s[0], s[1]), s[2]);
#pragma unroll
                for (int i = 3; i < 15; i += 2) ml = fmaxf(fmaxf(ml, s[i]), s[i + 1]);
                ml = fmaxf(ml, s[15]);
                if (kt < 12) ml = ml * C1 + b256;
                ml = fmaxf(ml, __shfl_xor(ml, 32));
                const bool mv = __builtin_amdgcn_ballot_w64(ml - mrun[qb] > ATT_THR) != 0ull;
                const float mnew = mv ? fmaxf(mrun[qb], ml) : mrun[qb], al = __builtin_amdgcn_exp2f(mrun[qb] - mnew);
                mrun[qb] = mnew;
                float ls = 0.f;
                if (kt < 12) { const float off = b256 - mnew;
#pragma unroll
                    for (int i = 0; i < 16; ++i) { t[i] = __builtin_amdgcn_exp2f(s[i] * C1 + off); ls += t[i]; }
                } else {
#pragma unroll
                    for (int i = 0; i < 16; ++i) { t[i] = __builtin_amdgcn_exp2f(s[i] - mnew); ls += t[i]; }
                }
                lrun[qb] = lrun[qb] * al + ls;
                if (mv) {
#pragma unroll
                    for (int i = 0; i < 16; ++i) { o[0][qb][i] *= al; o[1][qb][i] *= al; }
                }
#pragma unroll
                for (int st = 0; st < 2; ++st) { v4u w; w.x = pk2(t[8 * st + 0], t[8 * st + 1]); w.y = pk2(t[8 * st + 2], t[8 * st + 3]); w.z = pk2(t[8 * st + 4], t[8 * st + 5]); w.w = pk2(t[8 * st + 6], t[8 * st + 7]);
                    pf[qb][st] = __builtin_bit_cast(bf16x8, w); }
            }
#pragma unroll
            for (int db = 0; db < 2; ++db)
#pragma unroll
                for (int qb = 0; qb < 2; ++qb)
#pragma unroll
                    for (int st = 0; st < 2; ++st) o[db][qb] = MFMA32(vf[db][st], pf[qb][st], o[db][qb]);
        }
#pragma unroll
        for (int qb = 0; qb < 2; ++qb) {
            const float l = lrun[qb] + __shfl_xor(lrun[qb], 32), inv = 1.f / l;
            bf16* orow = YA + (rowQ + qb * 32 + r) * 512 + h * 64;
#pragma unroll
            for (int db = 0; db < 2; ++db)
#pragma unroll
                for (int g4 = 0; g4 < 4; ++g4) { v2u w; w.x = pk2(o[db][qb][4 * g4] * inv, o[db][qb][4 * g4 + 1] * inv); w.y = pk2(o[db][qb][4 * g4 + 2] * inv, o[db][qb][4 * g4 + 3] * inv);
                    *(GAS v2u*)(orow + db * 32 + 8 * g4 + 4 * hh) = w; }
        }
    }
}

constexpr int LDR = 1856;
struct PrepArgs { const bf16* RKVL; bf16 *LW, *AA, *GG, *NU; const float* mu; const float *decay_base, *aaa_base, *vres_base; const bf16 *DUT, *AUT, *GUT, *VDT, *VUT; int layer; };
constexpr int PA_STRIDE = 592, PV_STRIDE = 1040, PD_STRIDE = 80;
constexpr int PREP_A = 0, PREP_V = 38912, PREP_D = PREP_V + 64 * PV_STRIDE, PREP_MU = PREP_D + 64 * PD_STRIDE;
template <int KS> __device__ __forceinline__ void prep_mm(f32x16 (&acc)[2][2], const LAS unsigned char* Abase, int astride, int acol0, const bf16* W, int Kw, int hd, int r, int hh) {
#pragma unroll
    for (int a = 0; a < 2; ++a)
#pragma unroll
        for (int b = 0; b < 2; ++b)
#pragma unroll
            for (int i = 0; i < 16; ++i) acc[a][b][i] = 0.f;
#pragma unroll
    for (int ks = 0; ks < KS; ++ks) {
        bf16x8 af[2], bfr[2];
#pragma unroll
        for (int mb = 0; mb < 2; ++mb) af[mb] = *(const LAS bf16x8*)(Abase + (mb * 32 + r) * astride + (acol0 + 16 * ks + 8 * hh) * 2);
#pragma unroll
        for (int nb = 0; nb < 2; ++nb) bfr[nb] = *(const bf16x8*)(W + (size_t)(64 * hd + nb * 32 + r) * Kw + 16 * ks + 8 * hh);
#pragma unroll
        for (int mb = 0; mb < 2; ++mb)
#pragma unroll
            for (int nb = 0; nb < 2; ++nb) acc[mb][nb] = MFMA32(bfr[nb], af[mb], acc[mb][nb]);
    }
}
constexpr int PREP_ST_STRIDE = 144, PREP_ST_BYTES = 32 * PREP_ST_STRIDE;
template <int MODE> __device__ __forceinline__ void prep_store(const f32x16 (&acc)[2][2], bf16* OUT, const float* base, int t0g, int hd, int lane, LAS unsigned char* st) {
    const int r = lane & 31, hh = lane >> 5;
#pragma unroll
    for (int mb = 0; mb < 2; ++mb) {
#pragma unroll
        for (int nb = 0; nb < 2; ++nb)
#pragma unroll
            for (int g4 = 0; g4 < 4; ++g4) { const int c0 = nb * 32 + 8 * g4 + 4 * hh;
                f32x4 bs = (f32x4){0.f, 0.f, 0.f, 0.f}; if (MODE != 2) bs = *(const f32x4*)(base + 64 * hd + c0);
                float v[4];
#pragma unroll
                for (int e = 0; e < 4; ++e) { v[e] = acc[mb][nb][4 * g4 + e]; if (MODE == 0) v[e] = -0.60653066f * sigm(v[e] + bs[e]); if (MODE == 1) v[e] = sigm(v[e] + bs[e]); }
                v2u w; w.x = pk2(v[0], v[1]); w.y = pk2(v[2], v[3]); *(LAS v2u*)(st + r * PREP_ST_STRIDE + c0 * 2) = w; }
#pragma unroll
        for (int it = 0; it < 4; ++it) { const int tl = it * 8 + (lane >> 3), c8 = lane & 7;
            const v4u w = *(const LAS v4u*)(st + tl * PREP_ST_STRIDE + c8 * 16);
            *(GAS v4u*)(OUT + (size_t)(t0g + mb * 32 + tl) * 512 + 64 * hd + 8 * c8) = w; }
    }
}
__device__ __forceinline__ void prep_phase(LAS unsigned char* lds, const PrepArgs& P, int vcu, int G, int tid) {
    const int hd = __builtin_amdgcn_readfirstlane(tid >> 6), lane = tid & 63, r = lane & 31, hh = lane >> 5;
    LAS float* mut = (LAS float*)(lds + PREP_MU);
    for (int i = tid; i < 1824; i += NWAVES * 64) mut[i] = P.mu[i];
    __syncthreads();
    for (int unit = vcu; unit < 512; unit += G) {
        const int t0g = unit * 64, s0 = t0g & (SEQ - 1);
        {
            v4u cu[5], pv[5];
#pragma unroll
            for (int k = 0; k < 5; ++k) { const int i = tid + k * NWAVES * 64; cu[k] = (v4u){0u, 0u, 0u, 0u}; pv[k] = cu[k];
                if (i < 64 * 36) { const int tok = i / 36, ch = i - tok * 36; const size_t row = (size_t)t0g + tok;
                    cu[k] = *(const GAS v4u*)(P.RKVL + row * LDR + 1536 + 8 * ch);
                    if (s0 + tok > 0) pv[k] = *(const GAS v4u*)(P.RKVL + (row - 1) * LDR + 1536 + 8 * ch); } }
#pragma unroll
            for (int k = 0; k < 5; ++k) { const int i = tid + k * NWAVES * 64;
                if (i < 64 * 36) { const int tok = i / 36, ch = i - tok * 36;
                    float c8[8], p8[8], o8[8]; unpack8(cu[k], c8); unpack8(pv[k], p8);
                    const f32x4 m0 = *(const LAS f32x4*)(mut + 1536 + 8 * ch), m1 = *(const LAS f32x4*)(mut + 1536 + 8 * ch + 4);
#pragma unroll
                    for (int j = 0; j < 8; ++j) { float x = c8[j] + (p8[j] - c8[j]) * (j < 4 ? m0[j & 3] : m1[j & 3]);
                        if (ch < 8) x = 2.f * sigm(2.f * x) - 1.f; else if (ch >= 16) x = sigm(x);
                        o8[j] = x; }
                    *(LAS v4u*)(lds + PREP_A + tok * PA_STRIDE + 16 * ch) = pack8(o8); } }
        }
        if (P.layer == 1) {
            v4u cu[8], pv[8];
#pragma unroll
            for (int k = 0; k < 8; ++k) { const int i = tid + k * NWAVES * 64, tok = i >> 6, ch = i & 63; const size_t row = (size_t)t0g + tok;
                cu[k] = *(const GAS v4u*)(P.RKVL + row * LDR + 1024 + 8 * ch);
                pv[k] = (v4u){0u, 0u, 0u, 0u}; if (s0 + tok > 0) pv[k] = *(const GAS v4u*)(P.RKVL + (row - 1) * LDR + 1024 + 8 * ch); }
#pragma unroll
            for (int k = 0; k < 8; ++k) { const int i = tid + k * NWAVES * 64, tok = i >> 6, ch = i & 63;
                float c8[8], p8[8], o8[8]; unpack8(cu[k], c8); unpack8(pv[k], p8);
                const f32x4 m0 = *(const LAS f32x4*)(mut + 1024 + 8 * ch), m1 = *(const LAS f32x4*)(mut + 1024 + 8 * ch + 4);
#pragma unroll
                for (int j = 0; j < 8; ++j) o8[j] = c8[j] + (p8[j] - c8[j]) * (j < 4 ? m0[j & 3] : m1[j & 3]);
                *(LAS v4u*)(lds + PREP_V + tok * PV_STRIDE + 16 * ch) = pack8(o8); }
        }
        __syncthreads();
        if (P.layer == 1) {
            if (hd < 2) {
                f32x16 a1;
#pragma unroll
                for (int i = 0; i < 16; ++i) a1[i] = 0.f;
#pragma unroll 4
                for (int ks = 0; ks < 32; ++ks) {
                    const bf16x8 af = *(const LAS bf16x8*)(lds + PREP_V + (hd * 32 + r) * PV_STRIDE + (16 * ks + 8 * hh) * 2);
                    const bf16x8 bfr = *(const bf16x8*)(P.VDT + (size_t)r * 512 + 16 * ks + 8 * hh);
                    a1 = MFMA32(bfr, af, a1);
                }
#pragma unroll
                for (int g4 = 0; g4 < 4; ++g4) { v2u w; w.x = pk2(a1[4 * g4], a1[4 * g4 + 1]); w.y = pk2(a1[4 * g4 + 2], a1[4 * g4 + 3]);
                    *(LAS v2u*)(lds + PREP_D + (hd * 32 + r) * PD_STRIDE + (8 * g4 + 4 * hh) * 2) = w; }
            }
            __syncthreads();
        }
        LAS unsigned char* st = lds + PREP_V + hd * PREP_ST_BYTES;
        f32x16 acc[2][2];
        prep_mm<4>(acc, lds + PREP_A, PA_STRIDE, 0, P.DUT, 64, hd, r, hh);    prep_store<0>(acc, P.LW, P.decay_base, t0g, hd, lane, st);
        prep_mm<4>(acc, lds + PREP_A, PA_STRIDE, 64, P.AUT, 64, hd, r, hh);   prep_store<1>(acc, P.AA, P.aaa_base, t0g, hd, lane, st);
        prep_mm<10>(acc, lds + PREP_A, PA_STRIDE, 128, P.GUT, 160, hd, r, hh); prep_store<2>(acc, P.GG, nullptr, t0g, hd, lane, st);
        if (P.layer == 1) { prep_mm<2>(acc, lds + PREP_D, PD_STRIDE, 0, P.VUT, 32, hd, r, hh); prep_store<1>(acc, P.NU, P.vres_base, t0g, hd, lane, st); }
        __syncthreads();
    }
}

struct ScanArgs { const bf16* RKVL; const bf16 *LW, *AA, *GG, *NU; bf16* VF; bf16* YB; const float* mu; const float *k_k, *k_a, *r_k, *gn_g, *gn_b; int layer; };
constexpr int SC_W = 0, SC_A = 16384, SC_B = 32768, SC_K = 49152, SC_R = 65536, SC_V = 81920, SC_Y = 98304, SC_RK = 114688, SC_TAB = 114944;
__device__ __forceinline__ void scan_phase(LAS unsigned char* lds, const ScanArgs& P, int unit, int tid) {
    const int b = unit >> 3, h = unit & 7;
    const int i = tid >> 3, c8 = tid & 7;
    LAS float* tab = (LAS float*)(lds + SC_TAB);
    if (tid < 64) {
        tab[0 * 64 + tid] = P.mu[h * 64 + tid]; tab[1 * 64 + tid] = P.mu[512 + h * 64 + tid]; tab[2 * 64 + tid] = P.mu[1024 + h * 64 + tid];
        tab[3 * 64 + tid] = P.k_k[h * 64 + tid]; tab[4 * 64 + tid] = P.k_a[h * 64 + tid]; tab[5 * 64 + tid] = P.r_k[h * 64 + tid];
        tab[6 * 64 + tid] = P.gn_g[h * 64 + tid]; tab[7 * 64 + tid] = P.gn_b[h * 64 + tid];
    }
    __syncthreads();
    float mur[8], muk[8], muv[8], kkw[8], kaw[8], rkw[8];
#pragma unroll
    for (int j = 0; j < 8; ++j) { mur[j] = tab[8 * c8 + j]; muk[j] = tab[64 + 8 * c8 + j]; muv[j] = tab[128 + 8 * c8 + j]; kkw[j] = tab[192 + 8 * c8 + j]; kaw[j] = tab[256 + 8 * c8 + j]; rkw[j] = tab[320 + 8 * c8 + j]; }
    float S[8];
#pragma unroll
    for (int j = 0; j < 8; ++j) S[j] = 0.f;
    const size_t row0 = (size_t)b * SEQ;
    const int hc = h * 64 + 8 * c8;
    for (int tile = 0; tile < SEQ / 64; ++tile) {
        {
            const int tok = i, s = tile * 64 + tok; const size_t row = row0 + s;
            const bf16* rp = P.RKVL + row * LDR;
            const v4u rc = *(const GAS v4u*)(rp + hc), kc = *(const GAS v4u*)(rp + 512 + hc), vc = *(const GAS v4u*)(rp + 1024 + hc);
            v4u rpv = (v4u){0u, 0u, 0u, 0u}, kpv = rpv, vpv = rpv;
            if (s > 0) { rpv = *(const GAS v4u*)(rp - LDR + hc); kpv = *(const GAS v4u*)(rp - LDR + 512 + hc); vpv = *(const GAS v4u*)(rp - LDR + 1024 + hc); }
            const v4u lwv = *(const GAS v4u*)(P.LW + row * 512 + hc), aav = *(const GAS v4u*)(P.AA + row * 512 + hc);
            float r8[8], rp8[8], k8[8], kp8[8], v8[8], vp8[8], lw8[8], a8[8];
            unpack8(rc, r8); unpack8(rpv, rp8); unpack8(kc, k8); unpack8(kpv, kp8); unpack8(vc, v8); unpack8(vpv, vp8); unpack8(lwv, lw8); unpack8(aav, a8);
            float kk[8], ss = 0.f, rk = 0.f, wv[8], av[8], bv[8], kv[8], rv[8], vv[8];
#pragma unroll
            for (int j = 0; j < 8; ++j) { rv[j] = r8[j] + (rp8[j] - r8[j]) * mur[j]; const float ks = k8[j] + (kp8[j] - k8[j]) * muk[j];
                kk[j] = ks * kkw[j]; ss += kk[j] * kk[j]; kv[j] = ks * (1.f + (a8[j] - 1.f) * kaw[j]); rk += rv[j] * kv[j] * rkw[j];
                wv[j] = __builtin_amdgcn_exp2f(lw8[j] * LOG2E); vv[j] = v8[j] + (vp8[j] - v8[j]) * muv[j]; }
            ss = red8(ss); rk = red8(rk);
            const float rn = __builtin_amdgcn_rsqf(fmaxf(ss, 1e-24f));
#pragma unroll
            for (int j = 0; j < 8; ++j) { const float kn = kk[j] * rn; av[j] = -kn; bv[j] = kn * a8[j]; }
            if (P.layer == 0) { *(GAS v4u*)(P.VF + row * 512 + hc) = pack8(vv); }
            else { const v4u nuv = *(const GAS v4u*)(P.NU + row * 512 + hc), vfv = *(const GAS v4u*)(P.VF + row * 512 + hc); float nu8[8], vf8[8]; unpack8(nuv, nu8); unpack8(vfv, vf8);
#pragma unroll
                for (int j = 0; j < 8; ++j) vv[j] = vv[j] + (vf8[j] - vv[j]) * nu8[j]; }
            const int o = tok * 256 + c8 * 32;
            *(LAS f32x4*)(lds + SC_W + o) = (f32x4){wv[0], wv[1], wv[2], wv[3]}; *(LAS f32x4*)(lds + SC_W + o + 16) = (f32x4){wv[4], wv[5], wv[6], wv[7]};
            *(LAS f32x4*)(lds + SC_A + o) = (f32x4){av[0], av[1], av[2], av[3]}; *(LAS f32x4*)(lds + SC_A + o + 16) = (f32x4){av[4], av[5], av[6], av[7]};
            *(LAS f32x4*)(lds + SC_B + o) = (f32x4){bv[0], bv[1], bv[2], bv[3]}; *(LAS f32x4*)(lds + SC_B + o + 16) = (f32x4){bv[4], bv[5], bv[6], bv[7]};
            *(LAS f32x4*)(lds + SC_K + o) = (f32x4){kv[0], kv[1], kv[2], kv[3]}; *(LAS f32x4*)(lds + SC_K + o + 16) = (f32x4){kv[4], kv[5], kv[6], kv[7]};
            *(LAS f32x4*)(lds + SC_R + o) = (f32x4){rv[0], rv[1], rv[2], rv[3]}; *(LAS f32x4*)(lds + SC_R + o + 16) = (f32x4){rv[4], rv[5], rv[6], rv[7]};
            *(LAS f32x4*)(lds + SC_V + o) = (f32x4){vv[0], vv[1], vv[2], vv[3]}; *(LAS f32x4*)(lds + SC_V + o + 16) = (f32x4){vv[4], vv[5], vv[6], vv[7]};
            if (c8 == 0) *(LAS float*)(lds + SC_RK + tok * 4) = rk;
        }
        __syncthreads();
#pragma unroll 4
        for (int tk = 0; tk < 64; ++tk) {
            const int o = tk * 256 + c8 * 32;
            const f32x4 w0 = *(const LAS f32x4*)(lds + SC_W + o), w1 = *(const LAS f32x4*)(lds + SC_W + o + 16);
            const f32x4 a0 = *(const LAS f32x4*)(lds + SC_A + o), a1 = *(const LAS f32x4*)(lds + SC_A + o + 16);
            const f32x4 b0 = *(const LAS f32x4*)(lds + SC_B + o), b1 = *(const LAS f32x4*)(lds + SC_B + o + 16);
            const f32x4 k0 = *(const LAS f32x4*)(lds + SC_K + o), k1 = *(const LAS f32x4*)(lds + SC_K + o + 16);
            const f32x4 r0 = *(const LAS f32x4*)(lds + SC_R + o), r1 = *(const LAS f32x4*)(lds + SC_R + o + 16);
            const float vi = *(const LAS float*)(lds + SC_V + tk * 256 + i * 4);
            float sa = (S[0] * a0[0] + S[1] * a0[1]) + (S[2] * a0[2] + S[3] * a0[3]) + ((S[4] * a1[0] + S[5] * a1[1]) + (S[6] * a1[2] + S[7] * a1[3]));
            sa = red8(sa);
#pragma unroll
            for (int j = 0; j < 4; ++j) { S[j] = S[j] * w0[j] + (sa * b0[j] + vi * k0[j]); S[4 + j] = S[4 + j] * w1[j] + (sa * b1[j] + vi * k1[j]); }
            float y = (S[0] * r0[0] + S[1] * r0[1]) + (S[2] * r0[2] + S[3] * r0[3]) + ((S[4] * r1[0] + S[5] * r1[1]) + (S[6] * r1[2] + S[7] * r1[3]));
            y = red8(y);
            if (c8 == 0) *(LAS float*)(lds + SC_Y + tk * 256 + i * 4) = y;
        }
        __syncthreads();
        {
            const int tok = i; const size_t row = row0 + tile * 64 + tok;
            const f32x4 y0 = *(const LAS f32x4*)(lds + SC_Y + tok * 256 + c8 * 32), y1 = *(const LAS f32x4*)(lds + SC_Y + tok * 256 + c8 * 32 + 16);
            const f32x4 v0 = *(const LAS f32x4*)(lds + SC_V + tok * 256 + c8 * 32), v1 = *(const LAS f32x4*)(lds + SC_V + tok * 256 + c8 * 32 + 16);
            const float rk = *(const LAS float*)(lds + SC_RK + tok * 4);
            const v4u gv = *(const GAS v4u*)(P.GG + row * 512 + hc); float g8[8]; unpack8(gv, g8);
            float yy[8] = {y0[0], y0[1], y0[2], y0[3], y1[0], y1[1], y1[2], y1[3]}, vv[8] = {v0[0], v0[1], v0[2], v0[3], v1[0], v1[1], v1[2], v1[3]};
            float sm = 0.f;
#pragma unroll
            for (int j = 0; j < 8; ++j) sm += yy[j];
            const float mean = red8(sm) * (1.f / 64.f); float sq = 0.f;
#pragma unroll
            for (int j = 0; j < 8; ++j) { yy[j] -= mean; sq += yy[j] * yy[j]; }
            const float rstd = __builtin_amdgcn_rsqf(red8(sq) * (1.f / 64.f) + GN_EPS);
            float o8[8];
#pragma unroll
            for (int j = 0; j < 8; ++j) o8[j] = (yy[j] * rstd * tab[384 + 8 * c8 + j] + tab[448 + 8 * c8 + j] + rk * vv[j]) * g8[j];
            *(GAS v4u*)(P.YB + row * 512 + hc) = pack8(o8);
        }
        __syncthreads();
    }
}

__device__ __forceinline__ void route_phase(LAS unsigned char* lds, const float* LOG, unsigned* cnt, int* TOKE, int* TOKP, float* TOKW, int* ELIST, int row0, int tid) {
    LAS unsigned* lc = (LAS unsigned*)lds;
    if (tid < 64) lc[tid] = 0u;
    __syncthreads();
    const int m = row0 + tid; const bool act = tid < 256;
    int x0 = 0, x1 = 1; float wa = 0.f, wb = 0.f; unsigned r0 = 0u, r1 = 0u;
    if (act) {
        const float* lg = LOG + (size_t)m * 64;
        const f32x4 gl = *(const f32x4*)lg;
        int grp = 0; float gm = gl[0];
        if (gl[1] > gm) { gm = gl[1]; grp = 1; } if (gl[2] > gm) { gm = gl[2]; grp = 2; } if (gl[3] > gm) { gm = gl[3]; grp = 3; }
        const float se = __expf(gl[0] - gm) + __expf(gl[1] - gm) + __expf(gl[2] - gm) + __expf(gl[3] - gm);
        const float gate = 1.f / se;
        const f32x4 e0 = *(const f32x4*)(lg + 4 + grp * 8), e1 = *(const f32x4*)(lg + 8 + grp * 8);
        const float v[8] = {e0[0], e0[1], e0[2], e0[3], e1[0], e1[1], e1[2], e1[3]};
        int i0 = 0; float v0 = v[0];
#pragma unroll
        for (int j = 1; j < 8; ++j) if (v[j] > v0) { v0 = v[j]; i0 = j; }
        int i1 = -1; float v1 = -INFINITY;
#pragma unroll
        for (int j = 0; j < 8; ++j) if (j != i0 && (i1 < 0 || v[j] > v1)) { v1 = v[j]; i1 = j; }
        const float w0 = 1.f / (1.f + __expf(v1 - v0)), w1 = 1.f - w0;
        x0 = grp * 8 + i0; x1 = grp * 8 + i1; wa = w0 * gate; wb = w1 * gate;
        r0 = __hip_atomic_fetch_add(lc + x0, 1u, __ATOMIC_RELAXED, __HIP_MEMORY_SCOPE_WORKGROUP); r1 = __hip_atomic_fetch_add(lc + x1, 1u, __ATOMIC_RELAXED, __HIP_MEMORY_SCOPE_WORKGROUP);
    }
    __syncthreads();
    if (tid < 32) lc[32 + tid] = __hip_atomic_fetch_add(cnt + tid, lc[tid], RLX_AGENT);
    __syncthreads();
    if (act) {
        const unsigned p0 = lc[32 + x0] + r0, p1 = lc[32 + x1] + r1;
        TOKE[2 * m] = x0; TOKE[2 * m + 1] = x1; TOKP[2 * m] = (int)p0; TOKP[2 * m + 1] = (int)p1; TOKW[2 * m] = wa; TOKW[2 * m + 1] = wb;
        ELIST[x0 * 32768 + (int)p0] = m; ELIST[x1 * 32768 + (int)p1] = m;
    }
}
__device__ __forceinline__ int moe_tables(LAS unsigned char* lds, unsigned* cnt, int tid) {
    LAS int* tl = (LAS int*)(lds + TILE_LDS);
    if (tid < 64) {
        const int c = tid < 32 ? (int)__hip_atomic_load(cnt + tid, RLX_AGENT) : 0, pad = (c + 255) & ~255; int inc = pad;
#pragma unroll
        for (int o = 1; o < 32; o <<= 1) { const int t = __shfl_up(inc, o); if (tid >= o) inc += t; }
        const int off = inc - pad;
        if (tid < 32) { tl[576 + tid] = c; tl[512 + tid] = off; for (int rt = off >> 8; rt < (inc >> 8); ++rt) tl[rt] = tid; }
        if (tid == 31) tl[544] = inc;
    }
    __syncthreads();
    return tl[544] >> 8;
}


#define LDS_BAR() do { asm volatile("s_waitcnt lgkmcnt(0)" ::: "memory"); __builtin_amdgcn_s_barrier(); asm volatile("" ::: "memory"); } while (0)
struct CsArgs { const bf16* RKVL; const bf16 *LW, *AA, *GG, *NU; bf16* VF; bf16* YB; unsigned char* GH; unsigned char* QY; bf16* BON; const float* mu; const float *k_k, *k_a, *r_k, *gn_g, *gn_b; int layer; };
constexpr int RS = 144, TS = 136, FS = 272;
constexpr int CS_R0 = 0, CS_LWT = 17408, CS_AE = 26112, CS_BI = 35328, CS_KI = 44544, CS_RI = 53760, CS_VT = 62976, CS_BGT = 71680, CS_KGT = 80384, CS_MV = 89088, CS_UT = 106496,
              CS_GL = 115200, CS_RK = 115456, CS_TAB = 115712,
              CS_AET = 117760, CS_MVT = CS_MV, CS_T = CS_MV + 8704;
__device__ __forceinline__ int tsw(int n, int o) { return (o + 16 * ((n >> 4) & 3)) & 127; }
__device__ __forceinline__ void tstore(LAS unsigned char* tile, const unsigned (&w)[4], int c8, int tok, int par) {
    const unsigned s0 = par ? w[0] : w[2], s1 = par ? w[1] : w[3];
    const unsigned r0 = (unsigned)__builtin_amdgcn_update_dpp(0, (int)s0, 0x128, 0xF, 0xF, true), r1 = (unsigned)__builtin_amdgcn_update_dpp(0, (int)s1, 0x128, 0xF, 0xF, true);
    const unsigned m0 = par ? w[2] : w[0], m1 = par ? w[3] : w[1];
    const unsigned e0 = par ? r0 : m0, o0 = par ? m0 : r0, e1 = par ? r1 : m1, o1 = par ? m1 : r1;
    LAS unsigned char* p = tile + (8 * c8 + 4 * par) * TS + tsw(8 * c8, (tok & ~1) * 2);
    *(LAS unsigned*)(p) = (e0 & 0xffffu) | (o0 << 16); *(LAS unsigned*)(p + TS) = (e0 >> 16) | (o0 & 0xffff0000u);
    *(LAS unsigned*)(p + 2 * TS) = (e1 & 0xffffu) | (o1 << 16); *(LAS unsigned*)(p + 3 * TS) = (e1 >> 16) | (o1 & 0xffff0000u);
}
__device__ __forceinline__ bf16x8 pack_frag(const f32x16& x, int st) {
    v4u w; w.x = pk2(x[8 * st + 0], x[8 * st + 1]); w.y = pk2(x[8 * st + 2], x[8 * st + 3]); w.z = pk2(x[8 * st + 4], x[8 * st + 5]); w.w = pk2(x[8 * st + 6], x[8 * st + 7]);
    return __builtin_bit_cast(bf16x8, w);
}
__device__ __forceinline__ bf16x8 lds_frag2(const LAS unsigned char* p0, const LAS unsigned char* p1) {
    const v2u a = *(const LAS v2u*)p0, b = *(const LAS v2u*)p1; v4u w; w.x = a.x; w.y = a.y; w.z = b.x; w.w = b.y; return __builtin_bit_cast(bf16x8, w);
}
__device__ __forceinline__ float keep_if_neg(float x, int d) { int m = d >> 31; asm volatile("" : "+v"(m)); return __uint_as_float(__float_as_uint(x) & (unsigned)m); }
__device__ __forceinline__ f32x16 zero16() { f32x16 z;
#pragma unroll
    for (int i = 0; i < 16; ++i) z[i] = 0.f;
    return z; }
__device__ __forceinline__ f32x16 mm_rr(const LAS unsigned char* At, int sb, const LAS unsigned char* Bt, int tb, int r, int hh) {
    f32x16 x = zero16();
#pragma unroll
    for (int ks = 0; ks < 4; ++ks) { const bf16x8 a = *(const LAS bf16x8*)(At + (32 * sb + r) * RS + (16 * ks + 8 * hh) * 2), b = *(const LAS bf16x8*)(Bt + (32 * tb + r) * RS + (16 * ks + 8 * hh) * 2);
        x = MFMA32(a, b, x); }
    return x;
}
__device__ __forceinline__ void mm_xt(f32x16& z, const f32x16& x, const LAS unsigned char* BT, int sb, int nb, int r, int hh) {
#pragma unroll
    for (int st = 0; st < 2; ++st) { const int n = 32 * nb + r, o = (32 * sb + 16 * st + 4 * hh) * 2; const LAS unsigned char* p = BT + n * TS;
        z = MFMA32(pack_frag(x, st), lds_frag2(p + tsw(n, o), p + tsw(n, o + 16)), z); }
}
__device__ __forceinline__ void mm_ax(f32x16& z, const LAS unsigned char* AT, int mb, const f32x16& x, int sb, int r, int hh) {
#pragma unroll
    for (int st = 0; st < 2; ++st) { const int n = 32 * mb + r, o = (32 * sb + 16 * st + 4 * hh) * 2; const LAS unsigned char* p = AT + n * TS;
        z = MFMA32(lds_frag2(p + tsw(n, o), p + tsw(n, o + 16)), pack_frag(x, st), z); }
}
__device__ __forceinline__ void mm_tt(f32x16& z, const LAS unsigned char* AT, int mb, const LAS unsigned char* BT, int nb, int r, int hh) {
#pragma unroll
    for (int ks = 0; ks < 4; ++ks) { const LAS unsigned char* pa = AT + (32 * mb + r) * TS + tsw(32 * mb + r, (16 * ks + 8 * hh) * 2); const LAS unsigned char* pb = BT + (32 * nb + r) * TS + tsw(32 * nb + r, (16 * ks + 8 * hh) * 2);
        z = MFMA32(lds_frag2(pa, pa + 8), lds_frag2(pb, pb + 8), z); }
}
__device__ __forceinline__ void mm_rs(f32x16& z, const LAS unsigned char* At, int tb, const bf16x8 (&sfr)[2][2], int r, int hh) {
#pragma unroll
    for (int kb = 0; kb < 2; ++kb)
#pragma unroll
        for (int st = 0; st < 2; ++st) { const LAS unsigned char* p = At + (32 * tb + r) * RS + (32 * kb + 16 * st + 4 * hh) * 2;
            z = MFMA32(lds_frag2(p, p + 16), sfr[kb][st], z); }
}
__device__ __forceinline__ void tri_solve(float (&xq)[16], const LAS unsigned char* Mp, int q, const float (&rq)[16]) {
    const LAS unsigned char* mq = Mp + q * 1920;
    const LAS unsigned char* md = Mp + 7680 + q * 16;
    const bool q1 = (q & 1) != 0, q2 = (q & 2) != 0;
    f32x4 acc = (f32x4){0.f, 0.f, 0.f, 0.f};
    f32x4 mn[2][15], ddv[2];
    ddv[0] = *(const LAS f32x4*)md;
    mn[1][0] = *(const LAS f32x4*)mq; ddv[1] = *(const LAS f32x4*)(md + 64);
#pragma unroll
    for (int g = 0; g < 16; ++g) {
        asm volatile("" ::: "memory");
        const f32x4 dd = ddv[g & 1];
        if (g + 2 < 16) {
#pragma unroll
            for (int i = 0; i <= g + 1; ++i) mn[g & 1][i] = *(const LAS f32x4*)(mq + (((g + 2) * (g + 1)) / 2 + i) * 16);
            ddv[g & 1] = *(const LAS f32x4*)(md + (g + 2) * 64);
        }
        const float a0 = q1 ? acc[1] : acc[0], a1 = q1 ? acc[3] : acc[2], b0 = q1 ? acc[0] : acc[1], b1 = q1 ? acc[2] : acc[3];
        const float c0 = a0 + dppf<0xB1>(b0), c1 = a1 + dppf<0xB1>(b1);
        float bq = rq[g] + ((q2 ? c1 : c0) + dppf<0x4E>(q2 ? c0 : c1));
        bq += dd[0] * dppf<0x00>(bq);
        bq += dd[1] * dppf<0x55>(bq);
        bq += dd[2] * dppf<0xAA>(bq);
        xq[g] = bq;
        if (g + 1 < 16) {
            f32x4 e0 = (f32x4){0.f, 0.f, 0.f, 0.f}, e1 = e0;
#pragma unroll
            for (int i = 0; i <= g; ++i) asm volatile("" : "+v"(mn[(g + 1) & 1][i]) : "v"(bq));
#pragma unroll
            for (int i = 0; i <= g; ++i) { if (i & 1) e1 += mn[(g + 1) & 1][i] * xq[i]; else e0 += mn[(g + 1) & 1][i] * xq[i]; }
            acc = e0 + e1;
        }
    }
}

struct CsRaw { v4u rc, kc, vc, rpv, kpv, vpv, lwv, aav, nuv, vfv; };
__device__ __forceinline__ void cs_load(CsRaw& R, const CsArgs& P, int u, int tid) {
    const int bh = u >> 5, c = u & 31, b = bh >> 3, h = bh & 7, tok = tid >> 3, c8 = tid & 7, hc = h * 64 + 8 * c8, s = c * 64 + tok; const size_t row = (size_t)b * SEQ + s;
    const bf16* rp = P.RKVL + row * LDR;
    R.rc = *(const GAS v4u*)(rp + hc); R.kc = *(const GAS v4u*)(rp + 512 + hc); R.vc = *(const GAS v4u*)(rp + 1024 + hc);
    R.rpv = (v4u){0u, 0u, 0u, 0u}; R.kpv = R.rpv; R.vpv = R.rpv; R.nuv = R.rpv; R.vfv = R.rpv;
    if (s > 0) { R.rpv = *(const GAS v4u*)(rp - LDR + hc); R.kpv = *(const GAS v4u*)(rp - LDR + 512 + hc); R.vpv = *(const GAS v4u*)(rp - LDR + 1024 + hc); }
    R.lwv = *(const GAS v4u*)(P.LW + row * 512 + hc); R.aav = *(const GAS v4u*)(P.AA + row * 512 + hc);
    if (P.layer == 1) { R.nuv = *(const GAS v4u*)(P.NU + row * 512 + hc); R.vfv = *(const GAS v4u*)(P.VF + row * 512 + hc); }
}
template <int MODE> __device__ __forceinline__ void cs_stage1(LAS unsigned char* lds, const CsArgs& P, const CsRaw& R, int b, int h, int c, int tid, int wv) {
    const int tok = tid >> 3, c8 = tid & 7, lane = tid & 63, r = lane & 31, hh = lane >> 5;
    const int hc = h * 64 + 8 * c8;
    const int s = c * 64 + tok; const size_t row = (size_t)b * SEQ + s;
    const LAS float* tab = (const LAS float*)(lds + CS_TAB);
    {
        const unsigned w4[4] = {R.lwv.x, R.lwv.y, R.lwv.z, R.lwv.w};
        tstore(lds + CS_LWT, w4, c8, tok, tok & 1);
    }
    LDS_BAR();
    if (wv < 4) {
        const int tb = wv >> 1, nb = wv & 1; f32x16 cu = zero16();
#pragma unroll
        for (int ks = 0; ks < 4; ++ks) {
            const int trow = 32 * tb + r, s0 = 16 * ks + 8 * hh;
            v4u aw; unsigned e[8];
#pragma unroll
            for (int j = 0; j < 8; ++j) { int m = (trow - s0 - j) >> 31; asm volatile("" : "+v"(m)); e[j] = 0x3F80u & ~(unsigned)m; }
            aw.x = e[0] | (e[1] << 16); aw.y = e[2] | (e[3] << 16); aw.z = e[4] | (e[5] << 16); aw.w = e[6] | (e[7] << 16);
            const LAS unsigned char* p = lds + CS_LWT + (32 * nb + r) * TS + tsw(32 * nb + r, s0 * 2);
            cu = MFMA32(__builtin_bit_cast(bf16x8, aw), lds_frag2(p, p + 8), cu);
        }
#pragma unroll
        for (int i = 0; i < 16; ++i) *(LAS float*)(lds + CS_R0 + (32 * tb + crow(i, hh)) * FS + (32 * nb + r) * 4) = cu[i];
    }
    LDS_BAR();
    {
        float r8[8], rp8[8], k8[8], kp8[8], v8[8], vp8[8], a8[8], nu8[8], vf8[8], lw8[8];
        unpack8(R.rc, r8); unpack8(R.rpv, rp8); unpack8(R.kc, k8); unpack8(R.kpv, kp8); unpack8(R.vc, v8); unpack8(R.vpv, vp8); unpack8(R.lwv, lw8); unpack8(R.aav, a8); unpack8(R.nuv, nu8); unpack8(R.vfv, vf8);
        float kk[8], ss = 0.f, rk = 0.f, av[8], bv[8], kv[8], rv[8], vv[8];
#pragma unroll
        for (int j = 0; j < 8; ++j) { rv[j] = r8[j] + (rp8[j] - r8[j]) * tab[8 * c8 + j]; const float ks = k8[j] + (kp8[j] - k8[j]) * tab[64 + 8 * c8 + j];
            kk[j] = ks * tab[192 + 8 * c8 + j]; ss += kk[j] * kk[j]; kv[j] = ks * (1.f + (a8[j] - 1.f) * tab[256 + 8 * c8 + j]); rk += rv[j] * kv[j] * tab[320 + 8 * c8 + j];
            vv[j] = v8[j] + (vp8[j] - v8[j]) * tab[128 + 8 * c8 + j]; }
        ss = red8(ss); rk = red8(rk);
        const float rn = __builtin_amdgcn_rsqf(fmaxf(ss, 1e-24f));
#pragma unroll
        for (int j = 0; j < 8; ++j) { const float kn = kk[j] * rn; av[j] = -kn; bv[j] = kn * a8[j]; }
        if (P.layer == 0) *(GAS v4u*)(P.VF + row * 512 + hc) = pack8(vv);
        else {
#pragma unroll
            for (int j = 0; j < 8; ++j) vv[j] = vv[j] + (vf8[j] - vv[j]) * nu8[j]; }
        { float bo[8];
#pragma unroll
          for (int j = 0; j < 8; ++j) bo[j] = rk * vv[j];
          *(GAS v4u*)(P.BON + row * 512 + hc) = pack8(bo); }
        const f32x4 c0 = *(const LAS f32x4*)(lds + CS_R0 + tok * FS + c8 * 32), c1 = *(const LAS f32x4*)(lds + CS_R0 + tok * FS + c8 * 32 + 16);
        const f32x4 l0 = *(const LAS f32x4*)(lds + CS_R0 + 63 * FS + c8 * 32), l1 = *(const LAS f32x4*)(lds + CS_R0 + 63 * FS + c8 * 32 + 16);
        const float cum[8] = {c0[0], c0[1], c0[2], c0[3], c1[0], c1[1], c1[2], c1[3]}, cl[8] = {l0[0], l0[1], l0[2], l0[3], l1[0], l1[1], l1[2], l1[3]};
        float ae[8], bi[8], ki[8], ri[8], bg[8], kg[8];
#pragma unroll
        for (int j = 0; j < 8; ++j) { const float ex = __builtin_amdgcn_exp2f((cum[j] - lw8[j]) * LOG2E), ei = __builtin_amdgcn_exp2f(-cum[j] * LOG2E), ec = __builtin_amdgcn_exp2f(cum[j] * LOG2E),
                                                  el = __builtin_amdgcn_exp2f((cl[j] - cum[j]) * LOG2E);
            ae[j] = av[j] * ex; bi[j] = bv[j] * ei; ki[j] = kv[j] * ei; ri[j] = rv[j] * ec; bg[j] = bv[j] * el; kg[j] = kv[j] * el; }
        { const v4u pa = pack8(ae); *(LAS v4u*)(lds + CS_AE + tok * RS + c8 * 16) = pa; const unsigned wa[4] = {pa.x, pa.y, pa.z, pa.w}; tstore(lds + CS_AET, wa, c8, tok, tok & 1); } *(LAS v4u*)(lds + CS_BI + tok * RS + c8 * 16) = pack8(bi); *(LAS v4u*)(lds + CS_KI + tok * RS + c8 * 16) = pack8(ki);
        *(LAS v4u*)(lds + CS_RI + tok * RS + c8 * 16) = pack8(ri);
        { unsigned wv2[4], wb[4], wk[4];
#pragma unroll
          for (int p = 0; p < 4; ++p) { wv2[p] = pk2(vv[2 * p], vv[2 * p + 1]); wb[p] = pk2(bg[2 * p], bg[2 * p + 1]); wk[p] = pk2(kg[2 * p], kg[2 * p + 1]); }
          tstore(lds + CS_VT, wv2, c8, tok, tok & 1); tstore(lds + CS_BGT, wb, c8, tok, tok & 1); tstore(lds + CS_KGT, wk, c8, tok, tok & 1); }
        if (tok == 63) {
#pragma unroll
            for (int j = 0; j < 8; ++j) *(LAS float*)(lds + CS_GL + (8 * c8 + j) * 4) = __builtin_amdgcn_exp2f(cl[j] * LOG2E); }
    }
    LDS_BAR();
}
template <int MODE> __device__ __forceinline__ void cs_stage2(LAS unsigned char* lds, const unsigned char* gu, int lane, int wv) {
    const int r = lane & 31, hh = lane >> 5;
    if (wv < 4) {
        const int tb = wv >> 1, vb = wv & 1; f32x16 z = zero16();
        for (int sb = 0; sb <= tb; ++sb) {
            f32x16 x = mm_rr(lds + CS_KI, sb, lds + CS_AE, tb, r, hh);
#pragma unroll
            for (int i = 0; i < 16; ++i) x[i] = keep_if_neg(x[i], (32 * sb + crow(i, hh)) - (32 * tb + r));
            mm_xt(z, x, lds + CS_VT, sb, vb, r, hh);
        }
        if (MODE == 3) { bf16x8 sfr[2][2];
#pragma unroll
            for (int kb = 0; kb < 2; ++kb)
#pragma unroll
                for (int st = 0; st < 2; ++st) sfr[kb][st] = *(const bf16x8*)(gu + ((kb * 2 + vb) * 2 + st) * 1024 + lane * 16);
            mm_rs(z, lds + CS_AE, tb, sfr, r, hh); }
        if (MODE == 3) {
#pragma unroll
            for (int i = 0; i < 16; ++i) *(LAS float*)(lds + CS_MV + (32 * tb + crow(i, hh)) * FS + (32 * vb + r) * 4) = z[i];
        } else {
#pragma unroll
            for (int g4 = 0; g4 < 4; ++g4) { const int vr = 32 * vb + r; v2u w; w.x = pk2(z[4 * g4], z[4 * g4 + 1]); w.y = pk2(z[4 * g4 + 2], z[4 * g4 + 3]);
                *(LAS v2u*)(lds + CS_MVT + vr * TS + tsw(vr, (32 * tb + 8 * g4 + 4 * hh) * 2)) = w; }
        }
    } else if (wv < 7) {
        const int tb = wv == 4 ? 0 : 1, sb = wv == 6 ? 1 : 0;
        const f32x16 x = mm_rr(lds + CS_AE, tb, lds + CS_BI, sb, r, hh);
        const int scol = 32 * sb + r, si = scol >> 2, sq = scol & 3;
#pragma unroll
        for (int i = 0; i < 16; ++i) { const int t = 32 * tb + crow(i, hh), g = t >> 2, rr = i & 3;
            int off = sq * 1920 + ((g * (g - 1)) / 2 + si) * 16 + rr * 4;
            off = (si == g) ? 7680 + (g * 4 + rr) * 16 + sq * 4 : off;
            off = (si > g) ? 8704 + lane * 4 : off;
            *(LAS float*)(lds + CS_R0 + off) = keep_if_neg(x[i], scol - t); }
    }
    LDS_BAR();
}

__device__ __forceinline__ void cs_d1(LAS unsigned char* lds, const CsArgs& P, int vcu, int G, int tid, int wv) {
    {
        const int h = (vcu >> 5) & 7;
        LAS float* tab = (LAS float*)(lds + CS_TAB);
        if (tid < 64) { tab[tid] = P.mu[h * 64 + tid]; tab[64 + tid] = P.mu[512 + h * 64 + tid]; tab[128 + tid] = P.mu[1024 + h * 64 + tid];
            tab[192 + tid] = P.k_k[h * 64 + tid]; tab[256 + tid] = P.k_a[h * 64 + tid]; tab[320 + tid] = P.r_k[h * 64 + tid]; tab[384 + tid] = P.gn_g[h * 64 + tid]; tab[448 + tid] = P.gn_b[h * 64 + tid]; }
        LDS_BAR();
    }
    CsRaw raw; if (vcu < 4096) cs_load(raw, P, vcu, tid);
    for (int u = vcu; u < 4096; u += G) {
        int tidu = tid; asm volatile("" : "+v"(tidu)); const int lane = tidu & 63;
        const int r = lane & 31, hh = lane >> 5;
        const int bh = u >> 5, c = u & 31, b = bh >> 3, h = bh & 7;
        unsigned char* gu = P.GH + (size_t)u * 16384;
#if ((REPMASK) >> 19) & 3
        { int n1_ = (((REPMASK) >> 19) & 1) ? 2 : 1, n2_ = (((REPMASK) >> 20) & 1) ? 2 : 1; asm volatile("" : "+s"(n1_), "+s"(n2_));
          for (int rep_ = 0; rep_ < n1_; ++rep_) cs_stage1<1>(lds, P, raw, b, h, c, tidu, wv);
          for (int rep_ = 0; rep_ < n2_; ++rep_) cs_stage2<1>(lds, gu, lane, wv); }
#else
        cs_stage1<1>(lds, P, raw, b, h, c, tidu, wv);
        cs_stage2<1>(lds, gu, lane, wv);
#endif
        if (wv < 4) {
            const int col = wv * 16 + (lane >> 2), q = lane & 3; float xq[16], rq[16];
#pragma unroll
            for (int i = 0; i < 16; ++i) rq[i] = (4 * i + q == col) ? 1.f : 0.f;
            tri_solve(xq, lds + CS_R0, q, rq);
#if ((REPMASK) >> 18) & 1
            { float rq2[16];
#pragma unroll
              for (int i = 0; i < 16; ++i) rq2[i] = rq[i] + 0.f * xq[i];
              asm volatile("" ::: "memory"); tri_solve(xq, lds + CS_R0, q, rq2); }
#endif
#pragma unroll
            for (int i = 0; i < 16; ++i) { const int t = 4 * i + q; *(LAS bf16*)(lds + CS_T + t * TS + tsw(t, col * 2)) = (bf16)f2bf(xq[i]); }
        }
        LDS_BAR();
        if (u + G < 4096) cs_load(raw, P, u + G, tid);
        {
            const int mat = wv >> 2, mb = (wv >> 1) & 1, nb = wv & 1; f32x16 z = zero16();
            mm_tt(z, lds + CS_T, mb, lds + (mat ? CS_MVT : CS_AET), nb, r, hh);
            LAS unsigned char* dt = lds + (mat ? CS_UT : CS_LWT);
#pragma unroll
            for (int g4 = 0; g4 < 4; ++g4) { const int n = 32 * nb + r; v2u w; w.x = pk2(z[4 * g4], z[4 * g4 + 1]); w.y = pk2(z[4 * g4 + 2], z[4 * g4 + 3]);
                *(LAS v2u*)(dt + n * TS + tsw(n, (32 * mb + 8 * g4 + 4 * hh) * 2)) = w; }
        }
        LDS_BAR();
        unsigned char* qy = P.QY + (size_t)u * 16384;
#if ((REPMASK) >> 22) & 1
        int n3_ = 2; asm volatile("" : "+s"(n3_));
        for (int rep_ = 0; rep_ < n3_; ++rep_) {
#else
        {
#endif
        const int tbq = wv & 1;
        if (wv < 4) {
            const int jb = wv >> 1, jpb = wv & 1; f32x16 g = zero16();
            mm_tt(g, lds + CS_LWT, jb, lds + CS_BGT, jpb, r, hh);
            if (jb == jpb) { const float gl = *(const LAS float*)(lds + CS_GL + (32 * jb + r) * 4);
#pragma unroll
                for (int i = 0; i < 16; ++i) { const int d = crow(i, hh) - r; g[i] += keep_if_neg(gl, (d | -d) >> 31 ? 0 : -1); } }
#pragma unroll
            for (int st = 0; st < 2; ++st) *(bf16x8*)(gu + ((jpb * 2 + jb) * 2 + st) * 1024 + lane * 16) = pack_frag(g, st);
            f32x16 qe;
#pragma unroll
            for (int g4 = 0; g4 < 4; ++g4) { const v2u w = *(const LAS v2u*)(lds + CS_RI + (32 * tbq + r) * RS + (32 * jb + 8 * g4 + 4 * hh) * 2);
                qe[4 * g4] = bflo(w.x); qe[4 * g4 + 1] = bfhi(w.x); qe[4 * g4 + 2] = bflo(w.y); qe[4 * g4 + 3] = bfhi(w.y); }
            for (int sb = 0; sb <= tbq; ++sb) {
                f32x16 x = mm_rr(lds + CS_BI, sb, lds + CS_RI, tbq, r, hh);
#pragma unroll
                for (int i = 0; i < 16; ++i) x[i] = keep_if_neg(x[i], (32 * sb + crow(i, hh)) - (32 * tbq + r) - 1);
                mm_ax(qe, lds + CS_LWT, jb, x, sb, r, hh);
            }
#pragma unroll
            for (int st = 0; st < 2; ++st) *(bf16x8*)(qy + ((jb * 2 + tbq) * 2 + st) * 1024 + lane * 16) = pack_frag(qe, st);
        } else {
            const int jpb = (wv - 4) >> 1, vb = wv & 1; f32x16 hacc = zero16();
            mm_tt(hacc, lds + CS_BGT, jpb, lds + CS_UT, vb, r, hh);
            mm_tt(hacc, lds + CS_KGT, jpb, lds + CS_VT, vb, r, hh);
#pragma unroll
            for (int st = 0; st < 2; ++st) *(bf16x8*)(gu + 8192 + ((jpb * 2 + vb) * 2 + st) * 1024 + lane * 16) = pack_frag(hacc, st);
            const int vq = (wv - 4) >> 1; f32x16 y0 = zero16();
            for (int sb = 0; sb <= tbq; ++sb) {
                f32x16 x = mm_rr(lds + CS_BI, sb, lds + CS_RI, tbq, r, hh);
#pragma unroll
                for (int i = 0; i < 16; ++i) x[i] = keep_if_neg(x[i], (32 * sb + crow(i, hh)) - (32 * tbq + r) - 1);
                mm_ax(y0, lds + CS_UT, vq, x, sb, r, hh);
                x = mm_rr(lds + CS_KI, sb, lds + CS_RI, tbq, r, hh);
#pragma unroll
                for (int i = 0; i < 16; ++i) x[i] = keep_if_neg(x[i], (32 * sb + crow(i, hh)) - (32 * tbq + r) - 1);
                mm_ax(y0, lds + CS_VT, vq, x, sb, r, hh);
            }
#pragma unroll
            for (int st = 0; st < 2; ++st) *(bf16x8*)(qy + 8192 + ((vq * 2 + tbq) * 2 + st) * 1024 + lane * 16) = pack_frag(y0, st);
        }
        }
        LDS_BAR();
    }
}
__device__ __forceinline__ void cs_d2(const CsArgs& P, int bh, int tid, int wv) {
    const int lane = tid & 63, vb = wv & 1;
    f32x16 X[2] = {zero16(), zero16()};
    bf16x8 gf[2][2][2], hf[2][2];
    const unsigned char* g0 = P.GH + (size_t)(bh * 32) * 16384;
    if (wv < 2) {
#pragma unroll
        for (int mb = 0; mb < 2; ++mb) {
#pragma unroll
            for (int kb = 0; kb < 2; ++kb)
#pragma unroll
                for (int st = 0; st < 2; ++st) gf[mb][kb][st] = *(const bf16x8*)(g0 + ((mb * 2 + kb) * 2 + st) * 1024 + lane * 16);
#pragma unroll
            for (int st = 0; st < 2; ++st) hf[mb][st] = *(const bf16x8*)(g0 + 8192 + ((mb * 2 + vb) * 2 + st) * 1024 + lane * 16);
        }
    }
    for (int c = 0; c < 32; ++c) {
        unsigned char* gu = P.GH + (size_t)(bh * 32 + c) * 16384;
        VM_WAIT();
        __syncthreads();
        if (wv < 2) {
            bf16x8 pk[2][2];
#pragma unroll
            for (int kb = 0; kb < 2; ++kb)
#pragma unroll
                for (int st = 0; st < 2; ++st) { pk[kb][st] = pack_frag(X[kb], st); *(bf16x8*)(gu + ((kb * 2 + vb) * 2 + st) * 1024 + lane * 16) = pk[kb][st]; }
            f32x16 Xn[2];
#pragma unroll
            for (int mb = 0; mb < 2; ++mb) {
#pragma unroll
                for (int st = 0; st < 2; ++st) { const v4u w = __builtin_bit_cast(v4u, hf[mb][st]);
                    Xn[mb][8 * st + 0] = bflo(w.x); Xn[mb][8 * st + 1] = bfhi(w.x); Xn[mb][8 * st + 2] = bflo(w.y); Xn[mb][8 * st + 3] = bfhi(w.y);
                    Xn[mb][8 * st + 4] = bflo(w.z); Xn[mb][8 * st + 5] = bfhi(w.z); Xn[mb][8 * st + 6] = bflo(w.w); Xn[mb][8 * st + 7] = bfhi(w.w); }
#pragma unroll
                for (int kb = 0; kb < 2; ++kb)
#pragma unroll
                    for (int st = 0; st < 2; ++st) Xn[mb] = MFMA32(gf[mb][kb][st], pk[kb][st], Xn[mb]);
            }
            if (c + 1 < 32) {
                const unsigned char* gn = gu + 16384;
#pragma unroll
                for (int mb = 0; mb < 2; ++mb) {
#pragma unroll
                    for (int kb = 0; kb < 2; ++kb)
#pragma unroll
                        for (int st = 0; st < 2; ++st) gf[mb][kb][st] = *(const bf16x8*)(gn + ((mb * 2 + kb) * 2 + st) * 1024 + lane * 16);
#pragma unroll
                    for (int st = 0; st < 2; ++st) hf[mb][st] = *(const bf16x8*)(gn + 8192 + ((mb * 2 + vb) * 2 + st) * 1024 + lane * 16);
                }
            }
            X[0] = Xn[0]; X[1] = Xn[1];
        }
    }
}
__device__ __forceinline__ void cs_d3(LAS unsigned char* lds, const CsArgs& P, int vcu, int G, int tid, int wv) {
    const int lane = tid & 63, r = lane & 31, hh = lane >> 5;
    LAS float* tab = (LAS float*)(lds + CS_TAB);
    LDS_BAR();
    for (int i = tid; i < 512; i += NWAVES * 64) { tab[i] = P.gn_g[i]; tab[512 + i] = P.gn_b[i]; }
    LDS_BAR();
    for (int it = vcu * NWAVES + wv; it < 8192; it += G * NWAVES) {
        const int u = it >> 1, tb = it & 1, bh = u >> 5, c = u & 31, b = bh >> 3, h = bh & 7;
        const unsigned char* gu = P.GH + (size_t)u * 16384; const unsigned char* qy = P.QY + (size_t)u * 16384;
        f32x16 z[2];
#pragma unroll
        for (int vb = 0; vb < 2; ++vb)
#pragma unroll
            for (int st = 0; st < 2; ++st) { const v4u w = *(const GAS v4u*)(qy + 8192 + ((vb * 2 + tb) * 2 + st) * 1024 + lane * 16);
                z[vb][8 * st + 0] = bflo(w.x); z[vb][8 * st + 1] = bfhi(w.x); z[vb][8 * st + 2] = bflo(w.y); z[vb][8 * st + 3] = bfhi(w.y);
                z[vb][8 * st + 4] = bflo(w.z); z[vb][8 * st + 5] = bfhi(w.z); z[vb][8 * st + 6] = bflo(w.w); z[vb][8 * st + 7] = bfhi(w.w); }
#pragma unroll
        for (int kb = 0; kb < 2; ++kb)
#pragma unroll
            for (int st = 0; st < 2; ++st) { const bf16x8 qf = *(const bf16x8*)(qy + ((kb * 2 + tb) * 2 + st) * 1024 + lane * 16);
#pragma unroll
                for (int vb = 0; vb < 2; ++vb) z[vb] = MFMA32(*(const bf16x8*)(gu + ((kb * 2 + vb) * 2 + st) * 1024 + lane * 16), qf, z[vb]); }
        float sm = 0.f;
#pragma unroll
        for (int vb = 0; vb < 2; ++vb)
#pragma unroll
            for (int i = 0; i < 16; ++i) sm += z[vb][i];
        sm += __shfl_xor(sm, 32);
        const float mean = sm * (1.f / 64.f); float sq = 0.f;
#pragma unroll
        for (int vb = 0; vb < 2; ++vb)
#pragma unroll
            for (int i = 0; i < 16; ++i) { z[vb][i] -= mean; sq += z[vb][i] * z[vb][i]; }
        sq += __shfl_xor(sq, 32);
        const float rstd = __builtin_amdgcn_rsqf(sq * (1.f / 64.f) + GN_EPS);
        const size_t row = (size_t)b * SEQ + c * 64 + 32 * tb + r;
#pragma unroll
        for (int vb = 0; vb < 2; ++vb)
#pragma unroll
            for (int g4 = 0; g4 < 4; ++g4) { const int v0 = 32 * vb + 8 * g4 + 4 * hh, col = h * 64 + v0;
                const f32x4 gg = *(const LAS f32x4*)(tab + col), gb = *(const LAS f32x4*)(tab + 512 + col);
                const v2u bo = *(const GAS v2u*)(P.BON + row * 512 + col), gt = *(const GAS v2u*)(P.GG + row * 512 + col);
                const float o0 = (z[vb][4 * g4] * rstd * gg[0] + gb[0] + bflo(bo.x)) * bflo(gt.x), o1 = (z[vb][4 * g4 + 1] * rstd * gg[1] + gb[1] + bfhi(bo.x)) * bfhi(gt.x),
                            o2 = (z[vb][4 * g4 + 2] * rstd * gg[2] + gb[2] + bflo(bo.y)) * bflo(gt.y), o3 = (z[vb][4 * g4 + 3] * rstd * gg[3] + gb[3] + bfhi(bo.y)) * bfhi(gt.y);
                v2u w; w.x = pk2(o0, o1); w.y = pk2(o2, o3); *(GAS v2u*)(P.YB + row * 512 + col) = w; }
    }
}

constexpr int D23_CTL = 138240, D23_TAB = 139264;
__device__ __forceinline__ void cs_d23(LAS unsigned char* lds, const CsArgs& P, int vcu, int G, int tid, int wv) {
    const int lane = tid & 63, r = lane & 31, hh = lane >> 5, vbw = wv & 1;
    LAS float* tab = (LAS float*)(lds + D23_TAB);
    LAS unsigned* ctl = (LAS unsigned*)(lds + D23_CTL);
    for (int p = vcu; p < 256; p += G) {
        LDS_BAR();
        for (int i = tid; i < 512; i += NWAVES * 64) { tab[i] = P.gn_g[i]; tab[512 + i] = P.gn_b[i]; }
        if (tid < 32) ctl[tid] = 0u;
        LDS_BAR();
        const int bh = p >> 1, par = p & 1, b = bh >> 3, h = bh & 7;
        if (wv < 2) {
            f32x16 X[2] = {zero16(), zero16()};
            bf16x8 gf[2][2][2], hf[2][2];
            const unsigned char* g0 = P.GH + (size_t)(bh * 32) * 16384;
#pragma unroll
            for (int mb = 0; mb < 2; ++mb) {
#pragma unroll
                for (int kb = 0; kb < 2; ++kb)
#pragma unroll
                    for (int st = 0; st < 2; ++st) gf[mb][kb][st] = *(const bf16x8*)(g0 + ((mb * 2 + kb) * 2 + st) * 1024 + lane * 16);
#pragma unroll
                for (int st = 0; st < 2; ++st) hf[mb][st] = *(const bf16x8*)(g0 + 8192 + ((mb * 2 + vbw) * 2 + st) * 1024 + lane * 16);
            }
            for (int c = 0; c < 30 + par + 1; ++c) {
                const unsigned char* gu = P.GH + (size_t)(bh * 32 + c) * 16384;
                VM_WAIT();
                bf16x8 pk[2][2];
#pragma unroll
                for (int kb = 0; kb < 2; ++kb)
#pragma unroll
                    for (int st = 0; st < 2; ++st) pk[kb][st] = pack_frag(X[kb], st);
                if ((c & 1) == par) {
                    LAS unsigned char* sl = lds + (c >> 1) * 8192;
#pragma unroll
                    for (int kb = 0; kb < 2; ++kb)
#pragma unroll
                        for (int st = 0; st < 2; ++st) *(LAS bf16x8*)(sl + ((kb * 2 + vbw) * 2 + st) * 1024 + lane * 16) = pk[kb][st];
                    LDS_WAIT();
                    if (lane == 0) __hip_atomic_fetch_add((LAS unsigned*)(ctl + (c >> 1)), 1u, __ATOMIC_RELAXED, __HIP_MEMORY_SCOPE_WORKGROUP);
                }
                f32x16 Xn[2];
#pragma unroll
                for (int mb = 0; mb < 2; ++mb) {
#pragma unroll
                    for (int st = 0; st < 2; ++st) { const v4u w = __builtin_bit_cast(v4u, hf[mb][st]);
                        Xn[mb][8 * st + 0] = bflo(w.x); Xn[mb][8 * st + 1] = bfhi(w.x); Xn[mb][8 * st + 2] = bflo(w.y); Xn[mb][8 * st + 3] = bfhi(w.y);
                        Xn[mb][8 * st + 4] = bflo(w.z); Xn[mb][8 * st + 5] = bfhi(w.z); Xn[mb][8 * st + 6] = bflo(w.w); Xn[mb][8 * st + 7] = bfhi(w.w); }
#pragma unroll
                    for (int kb = 0; kb < 2; ++kb)
#pragma unroll
                        for (int st = 0; st < 2; ++st) Xn[mb] = MFMA32(gf[mb][kb][st], pk[kb][st], Xn[mb]);
                }
                if (c + 1 < 30 + par + 1) {
                    const unsigned char* gn = gu + 16384;
#pragma unroll
                    for (int mb = 0; mb < 2; ++mb) {
#pragma unroll
                        for (int kb = 0; kb < 2; ++kb)
#pragma unroll
                            for (int st = 0; st < 2; ++st) gf[mb][kb][st] = *(const bf16x8*)(gn + ((mb * 2 + kb) * 2 + st) * 1024 + lane * 16);
#pragma unroll
                        for (int st = 0; st < 2; ++st) hf[mb][st] = *(const bf16x8*)(gn + 8192 + ((mb * 2 + vbw) * 2 + st) * 1024 + lane * 16);
                    }
                }
                X[0] = Xn[0]; X[1] = Xn[1];
            }
        }
        for (;;) {
            unsigned itu = 0u;
            if (lane == 0) itu = __hip_atomic_fetch_add((LAS unsigned*)(ctl + 16), 1u, __ATOMIC_RELAXED, __HIP_MEMORY_SCOPE_WORKGROUP);
            const int it = __builtin_amdgcn_readfirstlane((int)itu);
            if (it >= 32) break;
            const int slot = it >> 1, tb = it & 1, c = 2 * slot + par, u = bh * 32 + c;
            while (__builtin_amdgcn_readfirstlane((int)__hip_atomic_load((LAS unsigned*)(ctl + slot), __ATOMIC_RELAXED, __HIP_MEMORY_SCOPE_WORKGROUP)) < 2) __builtin_amdgcn_s_sleep(1);
            asm volatile("" ::: "memory");
            const unsigned char* qy = P.QY + (size_t)u * 16384; const LAS unsigned char* sl = lds + slot * 8192;
            f32x16 z[2];
            const size_t row = (size_t)b * SEQ + c * 64 + 32 * tb + r;
            v2u bo[2][4], gt[2][4];
#pragma unroll
            for (int vb = 0; vb < 2; ++vb)
#pragma unroll
                for (int g4 = 0; g4 < 4; ++g4) { const int col = h * 64 + 32 * vb + 8 * g4 + 4 * hh; bo[vb][g4] = *(const GAS v2u*)(P.BON + row * 512 + col); gt[vb][g4] = *(const GAS v2u*)(P.GG + row * 512 + col); }
#pragma unroll
            for (int vb = 0; vb < 2; ++vb)
#pragma unroll
                for (int st = 0; st < 2; ++st) { const v4u w = *(const GAS v4u*)(qy + 8192 + ((vb * 2 + tb) * 2 + st) * 1024 + lane * 16);
                    z[vb][8 * st + 0] = bflo(w.x); z[vb][8 * st + 1] = bfhi(w.x); z[vb][8 * st + 2] = bflo(w.y); z[vb][8 * st + 3] = bfhi(w.y);
                    z[vb][8 * st + 4] = bflo(w.z); z[vb][8 * st + 5] = bfhi(w.z); z[vb][8 * st + 6] = bflo(w.w); z[vb][8 * st + 7] = bfhi(w.w); }
#pragma unroll
            for (int kb = 0; kb < 2; ++kb)
#pragma unroll
                for (int st = 0; st < 2; ++st) { const bf16x8 qf = *(const bf16x8*)(qy + ((kb * 2 + tb) * 2 + st) * 1024 + lane * 16);
#pragma unroll
                    for (int vb = 0; vb < 2; ++vb) z[vb] = MFMA32(*(const LAS bf16x8*)(sl + ((kb * 2 + vb) * 2 + st) * 1024 + lane * 16), qf, z[vb]); }
            float sm = 0.f;
#pragma unroll
            for (int vb = 0; vb < 2; ++vb)
#pragma unroll
                for (int i = 0; i < 16; ++i) sm += z[vb][i];
            sm += __shfl_xor(sm, 32);
            const float mean = sm * (1.f / 64.f); float sq = 0.f;
#pragma unroll
            for (int vb = 0; vb < 2; ++vb)
#pragma unroll
                for (int i = 0; i < 16; ++i) { z[vb][i] -= mean; sq += z[vb][i] * z[vb][i]; }
            sq += __shfl_xor(sq, 32);
            const float rstd = __builtin_amdgcn_rsqf(sq * (1.f / 64.f) + GN_EPS);
#pragma unroll
            for (int vb = 0; vb < 2; ++vb)
#pragma unroll
                for (int g4 = 0; g4 < 4; ++g4) { const int v0 = 32 * vb + 8 * g4 + 4 * hh, col = h * 64 + v0;
                    const f32x4 gg = *(const LAS f32x4*)(tab + col), gb = *(const LAS f32x4*)(tab + 512 + col);
                    const v2u bo_ = bo[vb][g4], gt_ = gt[vb][g4];
                    const float o0 = (z[vb][4 * g4] * rstd * gg[0] + gb[0] + bflo(bo_.x)) * bflo(gt_.x), o1 = (z[vb][4 * g4 + 1] * rstd * gg[1] + gb[1] + bfhi(bo_.x)) * bfhi(gt_.x),
                                o2 = (z[vb][4 * g4 + 2] * rstd * gg[2] + gb[2] + bflo(bo_.y)) * bflo(gt_.y), o3 = (z[vb][4 * g4 + 3] * rstd * gg[3] + gb[3] + bfhi(bo_.y)) * bfhi(gt_.y);
                    v2u w; w.x = pk2(o0, o1); w.y = pk2(o2, o3); *(GAS v2u*)(P.YB + row * 512 + col) = w; }
        }
    }
}

#ifndef MK_N_LAUNCHES
#define MK_N_LAUNCHES 1
#endif
constexpr int N_PHASES = 35;
struct Args { const float* in[34]; float* out; unsigned char* ws; int ph_lo, ph_hi; };
enum { I_X = 0, I_P, I_LNIN_G, I_LNIN_B, I_RELB, I_WIN, I_TOKMIX, I_DECB, I_DECUP, I_AAAB, I_AAAUP, I_GATEUP, I_KK, I_KA, I_RK, I_VRB, I_VRD, I_VRU, I_GNG, I_GNB,
       I_WBA, I_WBR, I_WOUT, I_RG, I_RGB, I_RE, I_REB, I_EG, I_EU, I_ED, I_PLEP, I_PLEG, I_LNG, I_LNB };

#ifndef EN_MASK
#define EN_MASK 0xFFFFF
#endif
#define EN(k) (((EN_MASK) >> (k)) & 1)
#define IN(k) (lo <= (k) && (k) < hi)
#define SEAM(k) do { if (IN((k) + 1)) { XcdBarrier b_; b_.bar = (unsigned*)(ctl + CW_BAR); b_.x = xb_xcc_id(); b_.st = (volatile LAS unsigned*)(lds + MISC_OFF) + 8; xcd_barrier(b_, tid == 0); } } while (0)
#define KARGS const __attribute__((address_space(4))) Args* ka = (const __attribute__((address_space(4))) Args*)__builtin_amdgcn_kernarg_segment_ptr(); asm volatile("" : "+s"(ka))
#define PH_IDS \
    int tid = wv * 64 + (int)__builtin_amdgcn_mbcnt_hi(~0u, __builtin_amdgcn_mbcnt_lo(~0u, 0u)); asm volatile("" : "+v"(tid)); int bx = blockIdx.x, G = gridDim.x; asm volatile("" : "+s"(bx), "+s"(G)); \
    const int lane = tid & 63, wave = wv; \
    const int vcu = (G % 8 == 0) ? (bx % 8) * (G / 8) + bx / 8 : bx; \
    const int gw = bx * NWAVES + wave, NGW = G * NWAVES, gt = bx * (NWAVES * 64) + tid, NT = G * NWAVES * 64; \
    KARGS; unsigned char* ws = ka->ws; float* xres = ka->out; bf16* XB = (bf16*)(ws + WS_XB); gu32* ctl = (gu32*)(ws + WS_CTL); \
    (void)lane; (void)wave; (void)vcu; (void)gw; (void)NGW; (void)gt; (void)NT; (void)xres; (void)XB; (void)ctl;
#define AIN(i) ((const float*)ka->in[i])
#ifndef SKEW_TICKS
#define SKEW_TICKS 0
#endif
#define GEMM_SKEW do { if (SKEW_TICKS > 0 && ((bx >> 3) & 1)) { const unsigned long long t0_ = __builtin_amdgcn_s_memrealtime(); while (__builtin_amdgcn_s_memrealtime() - t0_ < (unsigned long long)(SKEW_TICKS)) __builtin_amdgcn_s_sleep(4); } } while (0)
#ifndef REPMASK
#define REPMASK 0
#endif
#define NREP(k) ((((REPMASK) >> (k)) & 1) ? 2 : 1)
#define BLK_A \
            { pg8::Gemm g{XB, WinT, T, 1024, 1024}; pg8::StaticOrder S; S.init(T, 1024, G, bx); pg8::EpiStore E{(bf16*)(ws + WS_QK), 1024, 0}; \
              pg8::gemm_phase<pg8::EpiStore, pg8::StaticOrder, true, true>(lds, g, S, E, wv); } \
            { pg8::Gemm g{XB, WinT + (size_t)1536 * 1024, T, 2048, 1024}; pg8::StaticOrder S; S.init(T, 2048, G, bx); pg8::EpiStoreT<-1, true> E{(bf16*)(ws + WS_RKVL), LDR, LDR}; \
              pg8::gemm_phase<pg8::EpiStoreT<-1, true>, pg8::StaticOrder, true, true>(lds, g, S, E, wv); } \
            { pg8::Gemm g{WinT + (size_t)1024 * 1024, XB, 512, T, 1024}; pg8::StaticOrder S; S.init(512, T, G, bx); pg8::EpiStore E{(bf16*)(ws + WS_VT), T, 0}; \
              pg8::gemm_phase<pg8::EpiStore, pg8::StaticOrder, true, true>(lds, g, S, E, wv); }
#define BLK_E \
            { pg8::Gemm g{(const bf16*)(ws + WS_YA), (const bf16*)(wb + WNE_WBA), T, 1024, 512}; pg8::StaticOrder S; S.init(T, 1024, G, bx); pg8::EpiStore E{T1, 1024, 0}; \
              pg8::gemm_phase<pg8::EpiStore, pg8::StaticOrder, false, true>(lds, g, S, E, wv); } \
            { pg8::Gemm g{(const bf16*)(ws + WS_YB), (const bf16*)(wb + WNE_WBR), T, 1024, 512}; pg8::StaticOrder S; S.init(T, 1024, G, bx); pg8::EpiStore E{T2, 1024, 0}; \
              pg8::gemm_phase<pg8::EpiStore, pg8::StaticOrder, false, true>(lds, g, S, E, wv); } \
            { pg8::Gemm g{XB, WinT + (size_t)3584 * 1024, T, 2048, 1024}; pg8::GateOrder S; S.init(T, G, bx); pg8::EpiGate2 E{T1, T2, MP, 1024}; \
              pg8::gemm_phase<pg8::EpiGate2, pg8::GateOrder, true, true>(lds, g, S, E, wv); }
#define BLK_G \
            LAS float* scr = (LAS float*)(lds + wave * 16384); \
            bf16* EGU = (bf16*)(ws + WS_EGU); bf16* EDN = (bf16*)(ws + WS_EDN); \
            for (int it = gw; it < 3 * 4096; it += NGW) { \
                const int which = it >> 12, r = it & 4095, e = r >> 7, rr = r & 127; \
                if (which < 2) { const int kb = rr >> 3, nb = rr & 7, n0 = 32 * nb; \
                    transpose_item(AIN(which == 0 ? I_EG : I_EU) + ((size_t)(l * 32 + e) << 18), 256, 64 * kb, n0, EGU, 1024, e * 512 + (n0 >> 7) * 256 + which * 128 + (n0 & 127), scr, lane); } \
                else { const int kb = rr >> 5, nb = rr & 31; transpose_item(AIN(I_ED) + ((size_t)(l * 32 + e) << 18), 1024, 64 * kb, 32 * nb, EDN, 256, e * 1024 + 32 * nb, scr, lane); } \
            } \
            { const float* psrc = AIN(I_P) + (size_t)l * T * 256; bf16* PB = (bf16*)(ws + WS_PB); \
              for (int i = gt; i < T * 256 / 4; i += NT) { const f32x4 v = *(const GAS f32x4*)(psrc + (size_t)i * 4); v2u w; w.x = pk2(v.x, v.y); w.y = pk2(v.z, v.w); *(GAS v2u*)(PB + (size_t)i * 4) = w; } }
#define BLK_H \
            pg8::Gemm g{XB, (const bf16*)(ws + WS_RWT) + (size_t)l * 256 * 1024, T, 256, 1024}; pg8::StaticOrder S; S.init(T, 256, G, bx); pg8::EpiRouter E{(float*)(ws + WS_LOG), (const float*)(ws + WS_RB) + l * 64}; \
            pg8::gemm_phase<pg8::EpiRouter, pg8::StaticOrder, true, true>(lds, g, S, E, wv);
#define BLK_K \
            const int ntiles = moe_tables(lds, (unsigned*)(ctl + CW_CNT + 64 * l), tid); LAS int* tlds = (LAS int*)(lds + TILE_LDS); \
            pg8::Gemm g{XB, (const bf16*)(ws + WS_EGU), 0, 0, 1024, nullptr}; pg8::MoeOrder S; S.init(tlds, ntiles, 2, G, bx); S.offs = tlds + 512; S.cnts = tlds + 576; S.elist = (const int*)(ws + WS_ELIST); pg8::EpiSwiglu E{(bf16*)(ws + WS_H)}; \
            pg8::gemm_phase<pg8::EpiSwiglu, pg8::MoeOrder, true, true, true>(lds, g, S, E, wv);
#define BLK_L \
            const int ntiles = moe_tables(lds, (unsigned*)(ctl + CW_CNT + 64 * l), tid); LAS int* tlds = (LAS int*)(lds + TILE_LDS); \
            pg8::Gemm g{(const bf16*)(ws + WS_H), (const bf16*)(ws + WS_EDN), 0, 0, 256, nullptr}; pg8::MoeOrder S; S.init(tlds, ntiles, 4, G, bx); pg8::EpiStoreT<3, false> E{(bf16*)(ws + WS_XG), 1024, 0}; \
            pg8::gemm_phase<pg8::EpiStoreT<3, false>, pg8::MoeOrder, false, true>(lds, g, S, E, wv);
#define BLK_N1 \
            { pg8::Gemm g{(const bf16*)(ws + WS_PB), (const bf16*)(wb + WNE_WPLE), T, 1024, 256}; pg8::StaticOrder S; S.init(T, 1024, G, bx); pg8::EpiStore E{TP, 1024, 0}; \
              pg8::gemm_phase<pg8::EpiStore, pg8::StaticOrder, false, true>(lds, g, S, E, wv); }
template <int l> __device__ __forceinline__ void layer_body(const Args& args, LAS unsigned char* lds, const int lo, const int hi, const int wv) {

        constexpr int pb = 1 + 17 * l;
#define wb (ws + WS_WNE + (size_t)l * WNE_LAYER)
#define WinT ((const bf16*)(wb + WNE_WIN))
        if (EN(1) && IN(pb + 0)) { PH_IDS GEMM_SKEW;
BLK_A
#if ((REPMASK) >> 1) & 1
            BLK_A
#endif
#if ((REPMASK) >> 24) & 1
            { pg8::Gemm g{XB, WinT, T, 1024, 1024}; pg8::StaticOrder S; S.init(T, 1024, G, bx); pg8::EpiNull E{(float*)(ws + WS_GG)};
              pg8::gemm_phase<pg8::EpiNull, pg8::StaticOrder, true, true>(lds, g, S, E, wv); }
#endif
#if ((REPMASK) >> 25) & 1
            { pg8::Gemm g{XB, WinT, T, 1024, 1024}; pg8::StaticOrder S; S.init(T, 1024, G, bx); pg8::EpiStore E{(bf16*)(ws + WS_GG), 1024, 0};
              pg8::gemm_phase<pg8::EpiStore, pg8::StaticOrder, true, true>(lds, g, S, E, wv); }
#endif
                        SEAM(pb + 0);
        }
        if (EN(2) && IN(pb + 1)) { { PH_IDS
#ifndef DIS_ATTN
 for (int rep_ = 0; rep_ < NREP(2); ++rep_) attn_phase(lds, (const bf16*)(ws + WS_QK), (const bf16*)(ws + WS_VT), (bf16*)(ws + WS_YA), AIN(I_RELB), vcu, G, tid);
#endif
 }
 __syncthreads();
            PH_IDS
            PrepArgs P{(const bf16*)(ws + WS_RKVL), (bf16*)(ws + WS_LW), (bf16*)((unsigned char*)xres + OUT_AA), (bf16*)(ws + WS_GG), (bf16*)(ws + WS_NU), AIN(I_TOKMIX) + l * 1824,
                       AIN(I_DECB) + l * 512, AIN(I_AAAB) + l * 512, AIN(I_VRB), (const bf16*)(ws + WS_DUT) + l * 32768, (const bf16*)(ws + WS_AUT) + l * 32768,
                       (const bf16*)(ws + WS_GUT) + l * 81920, (const bf16*)(ws + WS_VDT), (const bf16*)(ws + WS_VUT), l};
#ifndef DIS_PREP
            for (int rep_ = 0; rep_ < NREP(3); ++rep_) prep_phase(lds, P, vcu, G, tid);
#endif
 SEAM(pb + 2);
        }
#define CS_ARGS CsArgs P{(const bf16*)(ws + WS_RKVL), (const bf16*)(ws + WS_LW), (const bf16*)((unsigned char*)xres + OUT_AA), (const bf16*)(ws + WS_GG), (const bf16*)(ws + WS_NU), (bf16*)(ws + WS_VF), (bf16*)(ws + WS_YB), ws + WS_GH, (unsigned char*)xres, (bf16*)((unsigned char*)xres + 64 * MiB), \
                        AIN(I_TOKMIX) + l * 1824, AIN(I_KK) + l * 512, AIN(I_KA) + l * 512, AIN(I_RK) + l * 512, AIN(I_GNG) + l * 512, AIN(I_GNB) + l * 512, l}
        if (EN(4) && IN(pb + 3)) { PH_IDS CS_ARGS; for (int rep_ = 0; rep_ < NREP(16); ++rep_) cs_d1(lds, P, vcu, G, tid, wv); SEAM(pb + 3); }
        if (EN(6) && IN(pb + 5)) { PH_IDS CS_ARGS;
#if defined(SCAN_CHECK)
            if (l == 0) { P.YB = (bf16*)(ws + WS_NU); }
#endif
            cs_d23(lds, P, vcu, G, tid, wv);
#if defined(SCAN_CHECK)
            if (l == 0 && bx < 128) {
                ScanArgs Q{(const bf16*)(ws + WS_RKVL), (const bf16*)(ws + WS_LW), (const bf16*)((unsigned char*)xres + OUT_AA), (const bf16*)(ws + WS_GG), (const bf16*)(ws + WS_NU), (bf16*)(ws + WS_VF), (bf16*)(ws + WS_YB),
                           AIN(I_TOKMIX) + l * 1824, AIN(I_KK) + l * 512, AIN(I_KA) + l * 512, AIN(I_RK) + l * 512, AIN(I_GNG) + l * 512, AIN(I_GNB) + l * 512, l};
                __syncthreads(); scan_phase(lds, Q, bx, tid); }
#endif
            SEAM(pb + 5); }
        if (EN(7) && IN(pb + 6)) { PH_IDS GEMM_SKEW;
#if defined(SCAN_CHECK)
            if (l == 0) { float sd = 0.f, sr = 0.f; unsigned nbad = 0; const v4u* yn = (const v4u*)(ws + WS_NU); const v4u* yo = (const v4u*)(ws + WS_YB);
                for (int i = gt; i < T * 512 / 8; i += NT) { float a[8], o[8]; unpack8(yn[i], a); unpack8(yo[i], o);
#pragma unroll
                    for (int j = 0; j < 8; ++j) { const float d = a[j] - o[j]; if (fabsf(d) < 1e4f) { sd += d * d; sr += o[j] * o[j]; } else nbad++; } }
                unsigned long long isd = (unsigned long long)(sd * 1048576.f), isr = (unsigned long long)(sr * 1048576.f);
                atomicAdd((unsigned long long*)(ctl + CW_CHK), isd); atomicAdd((unsigned long long*)(ctl + CW_CHK + 2), isr); if (nbad) atomicAdd((unsigned*)(ctl + CW_CHK + 4), nbad); }
#endif
            bf16* T1 = (bf16*)(ws + WS_T1); bf16* T2 = (bf16*)(ws + WS_T2); bf16* MP = (bf16*)(ws + WS_MP);
BLK_E
#if ((REPMASK) >> 5) & 1
            BLK_E
#endif
                        SEAM(pb + 6);
        }
        if (EN(8) && IN(pb + 7)) { PH_IDS GEMM_SKEW;
            pg8::Gemm g{(const bf16*)(ws + WS_MP), (const bf16*)(wb + WNE_WOUT), T, 1024, 1024}; pg8::StaticOrder S; S.init(T, 1024, G, bx); pg8::EpiRes<0> E{XB, XB, nullptr, 1024, ALPHA};
            pg8::gemm_phase<pg8::EpiRes<0>, pg8::StaticOrder, true, true>(lds, g, S, E, wv);
            SEAM(pb + 7);
        }
        if (EN(10) && IN(pb + 9)) { PH_IDS
            if (bx < 128) {
                pg8::StaticOrder S1; S1.init(T, 256, G, bx); pg8::Unit u1;
                if (S1.next(0, u1)) ln_pass<2, 0>(nullptr, nullptr, XB, AIN(I_LNG) + (l * 3 + 0) * 1024, AIN(I_LNB) + (l * 3 + 0) * 1024, XB, nullptr, nullptr, u1.pm * 256 + wave, NWAVES, lane, u1.pm * 256 + 256);
#if ((REPMASK) >> 28) & 1
                if (S1.next(0, u1)) ln_pass<2, 0>(nullptr, nullptr, (bf16*)(ws + WS_GH), AIN(I_LNG) + (l * 3 + 0) * 1024, AIN(I_LNB) + (l * 3 + 0) * 1024, XB, nullptr, nullptr, u1.pm * 256 + wave, NWAVES, lane, u1.pm * 256 + 256);
#endif
                VM_WAIT(); __builtin_amdgcn_fence(__ATOMIC_ACQUIRE, "agent"); VM_WAIT();
                __syncthreads();
            }
{ BLK_H }
#if ((REPMASK) >> 8) & 1
            { BLK_H }
#endif
            if (bx < 128) {
                pg8::StaticOrder S2; S2.init(T, 256, G, bx); pg8::Unit u2;
                if (S2.next(0, u2)) route_phase(lds, (const float*)(ws + WS_LOG), (unsigned*)(ctl + CW_CNT + 64 * l), (int*)(ws + WS_TOKE), (int*)(ws + WS_TOKP), (float*)(ws + WS_TOKW), (int*)(ws + WS_ELIST), u2.pm * 256, tid);
            }
            if (bx >= 128) { const int bx2 = bx - 128; const int gw = bx2 * NWAVES + wave, NGW = 128 * NWAVES, gt = bx2 * (NWAVES * 64) + tid, NT = 128 * NWAVES * 64;
                BLK_G
#if ((REPMASK) >> 29) & 1
                { BLK_G }
#endif
                }
                        SEAM(pb + 9);
        }
        if (EN(13) && IN(pb + 12)) { PH_IDS GEMM_SKEW;
{ BLK_K }
#if ((REPMASK) >> 11) & 1
            { BLK_K }
#endif
                        SEAM(pb + 12);
        }
        if (EN(14) && IN(pb + 13)) { PH_IDS GEMM_SKEW;
{ BLK_L }
#if ((REPMASK) >> 12) & 1
            { BLK_L }
#endif
                        SEAM(pb + 13);
        }
        if (EN(15) && IN(pb + 14)) { PH_IDS
            (void)moe_tables(lds, (unsigned*)(ctl + CW_CNT + 64 * l), tid);
            ln_pass<1, 0>(nullptr, nullptr, XB, AIN(I_LNG) + (l * 3 + 1) * 1024, AIN(I_LNB) + (l * 3 + 1) * 1024, (const bf16*)(ws + WS_XG), (const int*)(ws + WS_TOKE), (const float*)(ws + WS_TOKW), gw, NGW, lane, T, (const int*)(ws + WS_TOKP), (const LAS int*)(lds + TILE_LDS) + 512);
            SEAM(pb + 14);
        }
        if (EN(16) && IN(pb + 15)) { PH_IDS GEMM_SKEW;
            bf16* TP = (bf16*)(ws + WS_TP);
BLK_N1
#if ((REPMASK) >> 14) & 1
            BLK_N1
#endif
                        { pg8::Gemm g{XB, (const bf16*)(wb + WNE_WPG), T, 1024, 1024}; pg8::StaticOrder S; S.init(T, 1024, G, bx); pg8::EpiRes<1> E{XB, (bf16*)(ws + WS_PRE2), TP, 1024, ALPHA};
              pg8::gemm_phase<pg8::EpiRes<1>, pg8::StaticOrder, true, true>(lds, g, S, E, wv); }
            SEAM(pb + 15);
        }
        if (EN(17) && IN(pb + 16)) { PH_IDS
            ln_pass<2, (l == 1 ? 1 : 0)>(nullptr, xres, XB, AIN(I_LNG) + (l * 3 + 2) * 1024, AIN(I_LNB) + (l * 3 + 2) * 1024, (const bf16*)(ws + WS_PRE2), nullptr, nullptr, gw, NGW, lane);
#if ((REPMASK) >> 15) & 1
            for (int rep_ = 0; rep_ < 3; ++rep_) ln_pass<0, true>(xres, (float*)(ws + WS_XG), (bf16*)(ws + WS_H), AIN(I_LNG) + (l * 3 + 2) * 1024, AIN(I_LNB) + (l * 3 + 2) * 1024, nullptr, nullptr, nullptr, gw, NGW, lane);
#endif
#if defined(SCAN_CHECK)
            if (l == 1) { VM_WAIT(); const unsigned long long isd = __hip_atomic_load((unsigned long long*)(ctl + CW_CHK), RLX_AGENT), isr = __hip_atomic_load((unsigned long long*)(ctl + CW_CHK + 2), RLX_AGENT);
                const unsigned nbad = __hip_atomic_load((unsigned*)(ctl + CW_CHK + 4), RLX_AGENT);
                const float inj = nbad ? 1000.f : 10.f * sqrtf((float)isd / fmaxf((float)isr, 1.f));
                for (int m = gw; m < T; m += NGW) { GAS f32x4* o4 = (GAS f32x4*)(xres + (size_t)m * D) + lane;
#pragma unroll
                    for (int j = 0; j < 4; ++j) { f32x4 y = o4[64 * j]; y = y + inj; o4[64 * j] = y; } } }
#endif
#if ((REPMASK) >> 21) & 1
            if (l == 0) { for (int rep_ = 0; rep_ < 20; ++rep_) SEAM(pb + 16); }
#endif
            if (l == 0) SEAM(pb + 16);
        }

}
#undef wb
#undef WinT
__global__ void __launch_bounds__(NWAVES * 64, 2) mega_fwd(Args args) {
    extern __shared__ __attribute__((aligned(16))) unsigned char lds_raw[];
    LAS unsigned char* lds = (LAS unsigned char*)lds_raw;
    for (int u = threadIdx.x; u < (LDS_BYTES - RING_BYTES) / 4; u += NWAVES * 64) ((LAS unsigned*)(lds + RING_BYTES))[u] = 0u;
    __syncthreads();
    KARGS;
    (void)xcd_barrier_post((unsigned*)(ka->ws + WS_CTL) + CW_BAR, (volatile LAS unsigned*)(lds + MISC_OFF) + 8);
    const int lo = ka->ph_lo, hi = ka->ph_hi, wv = __builtin_amdgcn_readfirstlane(threadIdx.x >> 6);

    if (EN(0) && IN(0)) { PH_IDS
        LAS float* scr = (LAS float*)(lds + wave * 16384);
        constexpr int I_WINL = 16 * 169, I_BR = 8 * 32, I_SQ = 16 * 32, I_PLE = 4 * 32, I_LAYER = I_WINL + 2 * I_BR + 2 * I_SQ + I_PLE;
        for (int it = gw; it < 2 * I_LAYER; it += NGW) {
            const int l = it / I_LAYER; int r = it - l * I_LAYER; unsigned char* wb_ = ws + WS_WNE + (size_t)l * WNE_LAYER;
            if (r < I_WINL) { const int kb = r / 169, nb = r - kb * 169, n0 = 32 * nb; transpose_item(AIN(I_WIN) + (size_t)l * 1024 * 5408, 5408, 64 * kb, n0, (bf16*)(wb_ + WNE_WIN), 1024, (n0 < 3360 ? n0 : n0 < 4384 ? 3584 + ((n0 - 3360) >> 7) * 256 + ((n0 - 3360) & 127) : 3584 + ((n0 - 4384) >> 7) * 256 + 128 + ((n0 - 4384) & 127)), scr, lane); continue; } r -= I_WINL;
            if (r < I_BR) { const int kb = r / 32, nb = r & 31; transpose_item(AIN(I_WBA) + (size_t)l * 512 * 1024, 1024, 64 * kb, 32 * nb, (bf16*)(wb_ + WNE_WBA), 512, 32 * nb, scr, lane); continue; } r -= I_BR;
            if (r < I_BR) { const int kb = r / 32, nb = r & 31; transpose_item(AIN(I_WBR) + (size_t)l * 512 * 1024, 1024, 64 * kb, 32 * nb, (bf16*)(wb_ + WNE_WBR), 512, 32 * nb, scr, lane); continue; } r -= I_BR;
            if (r < I_SQ) { const int kb = r / 32, nb = r & 31; transpose_item(AIN(I_WOUT) + (size_t)l * 1024 * 1024, 1024, 64 * kb, 32 * nb, (bf16*)(wb_ + WNE_WOUT), 1024, 32 * nb, scr, lane); continue; } r -= I_SQ;
            if (r < I_SQ) { const int kb = r / 32, nb = r & 31; transpose_item(AIN(I_PLEG) + (size_t)l * 1024 * 1024, 1024, 64 * kb, 32 * nb, (bf16*)(wb_ + WNE_WPG), 1024, 32 * nb, scr, lane); continue; } r -= I_SQ;
            { const int kb = r / 32, nb = r & 31; transpose_item(AIN(I_PLEP) + (size_t)l * 256 * 1024, 1024, 64 * kb, 32 * nb, (bf16*)(wb_ + WNE_WPLE), 256, 32 * nb, scr, lane); }
        }
        for (int i = gt; i < 2 * 224 * 1024 / 8; i += NT) { const int l = i / (224 * 128), r = i - l * (224 * 128);
            *(GAS v4u*)(ws + WS_WNE + (size_t)l * WNE_LAYER + WNE_WIN + (size_t)3360 * 2048 + (size_t)r * 16) = (v4u){0u, 0u, 0u, 0u}; }
        { bf16* RWT = (bf16*)(ws + WS_RWT);
          for (int i = gt; i < 2 * 256 * 1024; i += NT) { const int l = i >> 18, n = (i >> 10) & 255, k = i & 1023;
              const float v = n < 4 ? AIN(I_RG)[l * 4096 + k * 4 + n] : n < 36 ? AIN(I_RE)[l * 32768 + k * 32 + (n - 4)] : 0.f; RWT[i] = (bf16)f2bf(v); } }
        { float* RB = (float*)(ws + WS_RB); if (gt < 128) { const int l = gt >> 6, n = gt & 63; RB[gt] = n < 4 ? AIN(I_RGB)[l * 4 + n] : n < 36 ? AIN(I_REB)[l * 32 + n - 4] : 0.f; } }
        { bf16* DUT = (bf16*)(ws + WS_DUT); bf16* AUT = (bf16*)(ws + WS_AUT);
          for (int i = gt; i < 2 * 512 * 64; i += NT) { const int l = i >> 15, n = (i >> 6) & 511, k = i & 63;
              DUT[i] = (bf16)f2bf(AIN(I_DECUP)[l * 32768 + k * 512 + n]); AUT[i] = (bf16)f2bf(AIN(I_AAAUP)[l * 32768 + k * 512 + n]); } }
        { bf16* GUT = (bf16*)(ws + WS_GUT);
          for (int i = gt; i < 2 * 512 * 160; i += NT) { const int l = i / 81920, r = i - l * 81920, n = r / 160, k = r - n * 160; GUT[i] = (bf16)f2bf(AIN(I_GATEUP)[l * 81920 + k * 512 + n]); } }
        { bf16* VDT = (bf16*)(ws + WS_VDT); bf16* VUT = (bf16*)(ws + WS_VUT);
          for (int i = gt; i < 16384; i += NT) { VDT[i] = (bf16)f2bf(AIN(I_VRD)[(i & 511) * 32 + (i >> 9)]); VUT[i] = (bf16)f2bf(AIN(I_VRU)[(i & 31) * 512 + (i >> 5)]); } }
        ln_pass<0, 0>(AIN(I_X), nullptr, XB, AIN(I_LNIN_G), AIN(I_LNIN_B), nullptr, nullptr, nullptr, gw, NGW, lane);
        SEAM(0);
    }

    layer_body<0>(args, lds, lo, hi, wv);
    layer_body<1>(args, lds, lo, hi, wv);
#undef IN
#undef SEAM
}

extern "C" void kernel_launch(void* const* d_in, const int* in_sizes, int n_in, void* d_out, int out_size, void* d_ws, size_t ws_size, hipStream_t stream) {
    static int grid = 0;
    if (grid == 0) {
        if (n_in != 34 || out_size != T * D || ws_size < WS_END) { fprintf(stderr, "kernel_launch: unexpected shapes (n_in %d out %d ws %zu)\n", n_in, out_size, ws_size); grid = -1; return; }
        int dev = 0, cus = 0, per_cu = 0;
        if (hipGetDevice(&dev) != hipSuccess || hipDeviceGetAttribute(&cus, hipDeviceAttributeMultiprocessorCount, dev) != hipSuccess) { grid = -1; return; }
        if (hipFuncSetAttribute((const void*)mega_fwd, hipFuncAttributeMaxDynamicSharedMemorySize, LDS_BYTES) != hipSuccess) { fprintf(stderr, "kernel_launch: hipFuncSetAttribute failed\n"); grid = -1; return; }
        if (hipOccupancyMaxActiveBlocksPerMultiprocessor(&per_cu, (const void*)mega_fwd, NWAVES * 64, LDS_BYTES) != hipSuccess || per_cu < 1) fprintf(stderr, "kernel_launch: occupancy query reports %d\n", per_cu);
        (void)hipGetLastError();
        grid = cus;
    }
    if (grid < 0) return;
    if (hipMemsetAsync((char*)d_ws + WS_CTL, 0, CTL_ZERO_BYTES, stream) != hipSuccess) return;
    Args a{};
    for (int i = 0; i < 34; ++i) a.in[i] = (const float*)d_in[i];
    a.out = (float*)d_out; a.ws = (unsigned char*)d_ws;
#if MK_N_LAUNCHES == 1
    a.ph_lo = 0; a.ph_hi = N_PHASES;
    hipLaunchKernelGGL(mega_fwd, dim3(grid), dim3(NWAVES * 64), LDS_BYTES, stream, a);
#else
    for (int p = 0; p < N_PHASES; ++p) { a.ph_lo = p; a.ph_hi = p + 1; hipLaunchKernelGGL(mega_fwd, dim3(grid), dim3(NWAVES * 64), LDS_BYTES, stream, a); }
#endif
}
```
